# Optimizing an MI355X kernel written in HIP

```python
import math
import jax, jax.numpy as jnp
from jax import lax
import numpy as np

D_MODEL = 2048
BATCH = 1
SEQ = 16384
DEPTH = 4

ATT_QK_DIM = 64
ATT_V_DIM = 2 * ATT_QK_DIM
ATT_WIDTH = D_MODEL // 2
ATT_HEADS = ATT_WIDTH // ATT_V_DIM
Q_BLOCK = 128
ROPE_THETA = 10000.0

HGRN_WIDTH = D_MODEL - ATT_WIDTH
HGRN_HEADS = 8
HGRN_V_DIM = HGRN_WIDTH // HGRN_HEADS
HGRN_K_DIM = 128
HGRN_F_WIDTH = HGRN_HEADS * HGRN_K_DIM
CHUNK = 64

N_EXPERTS = 16
CAPACITY_FACTOR = 2
EXPERT_FF = D_MODEL // 2

EPS = 1e-6

COL_WIDTHS = (
    ATT_HEADS * 2 * ATT_QK_DIM,
    ATT_HEADS * 2 * ATT_QK_DIM,
    ATT_WIDTH,
    HGRN_F_WIDTH,
    HGRN_F_WIDTH,
    HGRN_F_WIDTH,
    HGRN_WIDTH,
    HGRN_WIDTH,
)
IN_COLS = sum(COL_WIDTHS)
SPLIT_IDX = tuple(int(v) for v in np.cumsum(COL_WIDTHS)[:-1])

kernel_name = "hybrid_diffattn_hgrn2_ecmoe_encoder"


def rmsnorm(x, g):
    xf = x.astype(jnp.float32)
    y = xf * lax.rsqrt(jnp.mean(xf * xf, axis=-1, keepdims=True) + EPS)
    return (y * g.astype(jnp.float32)).astype(x.dtype)


def rope_tables(positions):
    inv = ROPE_THETA ** (-jnp.arange(0, ATT_QK_DIM, 2, dtype=jnp.float32) / ATT_QK_DIM)
    ang = positions.astype(jnp.float32)[..., None] * inv
    return jnp.cos(ang), jnp.sin(ang)


def apply_rope(x, cos, sin):
    xf = x.astype(jnp.float32)
    x1, x2 = jnp.split(xf, 2, axis=-1)
    c = cos[:, :, None, None, :]
    s = sin[:, :, None, None, :]
    return jnp.concatenate([x1 * c - x2 * s, x2 * c + x1 * s], axis=-1).astype(x.dtype)


def diff_attention(q, k, v, lam, sub_g, lam_init):
    B, T = q.shape[0], q.shape[1]
    nb = T // Q_BLOCK
    qb = (q * (ATT_QK_DIM ** -0.5)).reshape(B, nb, Q_BLOCK, ATT_HEADS, 2, ATT_QK_DIM)
    qb = qb.transpose(1, 0, 2, 3, 4, 5)

    def block(qi):
        s = jnp.einsum('bqhmd,bkhmd->bhmqk', qi, k).astype(jnp.float32)
        p = jax.nn.softmax(s, axis=-1)
        w = p[:, :, 0] - lam * p[:, :, 1]
        return jnp.einsum('bhqk,bkhe->bqhe', w.astype(v.dtype), v)

    o = lax.map(block, qb)
    o = o.transpose(1, 0, 2, 3, 4).reshape(B, T, ATT_HEADS, ATT_V_DIM)
    o = rmsnorm(o, sub_g) * (1.0 - lam_init)
    return o.reshape(B, T, ATT_WIDTH)


def gated_linear_scan(q, k, v, logf):
    B, T, H, dk = q.shape
    dv = v.shape[-1]
    n = T // CHUNK

    def to_chunks(a):
        return a.reshape(B, n, CHUNK, H, a.shape[-1]).transpose(1, 0, 3, 2, 4)

    mask = jnp.tril(jnp.ones((CHUNK, CHUNK), dtype=bool))[:, :, None]

    def step(S, xs):
        qc, kc, vc, lc = xs
        b = jnp.cumsum(lc, axis=2)
        inter = jnp.einsum('bhtd,bhde->bhte', qc * jnp.exp(b), S)
        diff = b[:, :, :, None, :] - b[:, :, None, :, :]
        dec = jnp.exp(jnp.where(mask, diff, -jnp.inf))
        A = jnp.einsum('bhtd,bhtsd,bhsd->bhts', qc, dec, kc)
        o = inter + jnp.einsum('bhts,bhse->bhte', A, vc)
        b_last = b[:, :, -1:, :]
        S_new = jnp.exp(b_last[:, :, 0, :])[..., None] * S + jnp.einsum(
            'bhsd,bhse->bhde', kc * jnp.exp(b_last - b), vc)
        return S_new, o

    S0 = jnp.zeros((B, H, dk, dv), jnp.float32)
    _, o = lax.scan(step, S0, (to_chunks(q), to_chunks(k), to_chunks(v), to_chunks(logf)))
    return o.transpose(1, 0, 3, 2, 4).reshape(B, T, H, dv)


def hgrn2_bidirectional(q, z_fwd, z_bwd, i, g, lb_fwd, lb_bwd, norm_g):
    B, T = q.shape[0], q.shape[1]
    dt = i.dtype

    def gates(z, lb):
        zf = z.astype(jnp.float32)
        f = lb + (1.0 - lb) * jax.nn.sigmoid(zf)
        logf = jnp.log(f)
        kk = (1.0 - lb) * jax.nn.sigmoid(-zf)
        return (logf.reshape(B, T, HGRN_HEADS, HGRN_K_DIM),
                kk.reshape(B, T, HGRN_HEADS, HGRN_K_DIM))

    qh = (jax.nn.silu(q.astype(jnp.float32)) * (HGRN_K_DIM ** -0.5)).reshape(
        B, T, HGRN_HEADS, HGRN_K_DIM)
    vh = i.astype(jnp.float32).reshape(B, T, HGRN_HEADS, HGRN_V_DIM)
    lf_f, k_f = gates(z_fwd, lb_fwd)
    lf_b, k_b = gates(z_bwd, lb_bwd)
    flip = lambda a: jnp.flip(a, axis=1)
    Q = jnp.concatenate([qh, flip(qh)], axis=2)
    K = jnp.concatenate([k_f, flip(k_b)], axis=2)
    LF = jnp.concatenate([lf_f, flip(lf_b)], axis=2)
    V = jnp.concatenate([vh, flip(vh)], axis=2)
    o = gated_linear_scan(Q, K, V, LF)
    o = o[:, :, :HGRN_HEADS] + flip(o[:, :, HGRN_HEADS:])
    o = rmsnorm(o, norm_g) * jax.nn.silu(
        g.astype(jnp.float32).reshape(B, T, HGRN_HEADS, HGRN_V_DIM))
    return o.reshape(B, T, HGRN_WIDTH).astype(dt)


def expert_choice_ffn(x, router_w, w_gate, w_up, w_down):
    B, T, D = x.shape
    cap = CAPACITY_FACTOR * T // N_EXPERTS
    logits = jnp.einsum('btd,de->bte', x, router_w).astype(jnp.float32)
    aff = jax.nn.softmax(logits, axis=-1)
    gate, idx = lax.top_k(aff.transpose(0, 2, 1), cap)
    xg = jax.vmap(lambda xb, ib: xb[ib])(x, idx)
    h = jax.nn.silu(jnp.einsum('becd,edf->becf', xg, w_gate)) * jnp.einsum(
        'becd,edf->becf', xg, w_up)
    y = jnp.einsum('becf,efd->becd', h, w_down) * gate[..., None].astype(x.dtype)
    flat = (idx + (jnp.arange(B, dtype=jnp.int32) * T)[:, None, None]).reshape(-1)
    out = jax.ops.segment_sum(y.reshape(-1, D), flat, num_segments=B * T)
    return out.reshape(B, T, D).astype(x.dtype)


def setup_inputs(seed: int = 0) -> dict:
    key = jax.random.key(seed)
    ks = jax.random.split(key, 16)
    f32 = jnp.float32
    x = jax.random.normal(ks[0], (BATCH, SEQ, D_MODEL), f32)
    positions = jnp.broadcast_to(jnp.arange(SEQ, dtype=jnp.int32), (BATCH, SEQ))
    norm1_g = 1.0 + 0.02 * jax.random.normal(ks[1], (DEPTH, D_MODEL), f32)
    w_in = jax.random.normal(ks[2], (DEPTH, D_MODEL, IN_COLS), f32) * D_MODEL ** -0.5
    diff_lambda = 0.1 * jax.random.normal(ks[3], (DEPTH, 4, ATT_QK_DIM), f32)
    diff_subln_g = 1.0 + 0.02 * jax.random.normal(ks[4], (DEPTH, ATT_V_DIM), f32)
    hgrn_lb_logits = 0.5 * jax.random.normal(ks[5], (2, DEPTH, HGRN_F_WIDTH), f32)
    hgrn_norm_g = 1.0 + 0.02 * jax.random.normal(ks[6], (DEPTH, HGRN_V_DIM), f32)
    w_out = jax.random.normal(ks[7], (DEPTH, ATT_WIDTH + HGRN_WIDTH, D_MODEL), f32) * (
        (ATT_WIDTH + HGRN_WIDTH) ** -0.5)
    norm2_g = 1.0 + 0.02 * jax.random.normal(ks[8], (DEPTH, D_MODEL), f32)
    router_w = jax.random.normal(ks[9], (DEPTH, D_MODEL, N_EXPERTS), f32) * D_MODEL ** -0.5
    expert_w_gate = jax.random.normal(
        ks[10], (DEPTH, N_EXPERTS, D_MODEL, EXPERT_FF), f32) * D_MODEL ** -0.5
    expert_w_up = jax.random.normal(
        ks[11], (DEPTH, N_EXPERTS, D_MODEL, EXPERT_FF), f32) * D_MODEL ** -0.5
    expert_w_down = jax.random.normal(
        ks[12], (DEPTH, N_EXPERTS, EXPERT_FF, D_MODEL), f32) * EXPERT_FF ** -0.5
    final_norm_g = 1.0 + 0.02 * jax.random.normal(ks[13], (D_MODEL,), f32)
    return {"x": x, "positions": positions, "norm1_g": norm1_g, "w_in": w_in,
            "diff_lambda": diff_lambda, "diff_subln_g": diff_subln_g,
            "hgrn_lb_logits": hgrn_lb_logits, "hgrn_norm_g": hgrn_norm_g,
            "w_out": w_out, "norm2_g": norm2_g, "router_w": router_w,
            "expert_w_gate": expert_w_gate, "expert_w_up": expert_w_up,
            "expert_w_down": expert_w_down, "final_norm_g": final_norm_g}


def reference(x, positions, norm1_g, w_in, diff_lambda, diff_subln_g, hgrn_lb_logits,
              hgrn_norm_g, w_out, norm2_g, router_w, expert_w_gate, expert_w_up,
              expert_w_down, final_norm_g):
    B, T, _ = x.shape
    cos, sin = rope_tables(positions)
    lb_sm = jax.nn.softmax(hgrn_lb_logits.astype(jnp.float32), axis=1)
    lbs = jnp.cumsum(lb_sm, axis=1) - lb_sm[:, :1]
    for l in range(DEPTH):
        h = rmsnorm(x, norm1_g[l])
        proj = jnp.einsum('btd,dc->btc', h, w_in[l])
        aq, ak, av, hq, hzf, hzb, hi, hg = jnp.split(proj, SPLIT_IDX, axis=-1)
        aq = apply_rope(aq.reshape(B, T, ATT_HEADS, 2, ATT_QK_DIM), cos, sin)
        ak = apply_rope(ak.reshape(B, T, ATT_HEADS, 2, ATT_QK_DIM), cos, sin)
        av = av.reshape(B, T, ATT_HEADS, ATT_V_DIM)
        lam_init = 0.8 - 0.6 * math.exp(-0.3 * l)
        lv = diff_lambda[l].astype(jnp.float32)
        lam = jnp.exp(jnp.sum(lv[0] * lv[1])) - jnp.exp(jnp.sum(lv[2] * lv[3])) + lam_init
        att_out = diff_attention(aq, ak, av, lam, diff_subln_g[l], lam_init)
        hgrn_out = hgrn2_bidirectional(hq, hzf, hzb, hi, hg, lbs[0, l], lbs[1, l],
                                       hgrn_norm_g[l])
        mixed = jnp.concatenate([att_out, hgrn_out.astype(att_out.dtype)], axis=-1)
        x = x + jnp.einsum('btc,cd->btd', mixed, w_out[l])
        x = x + expert_choice_ffn(rmsnorm(x, norm2_g[l]), router_w[l], expert_w_gate[l],
                                  expert_w_up[l], expert_w_down[l])
    return rmsnorm(x, final_norm_g)
```

```cpp
#include <hip/hip_runtime.h>
#include <hip/hip_bf16.h>
#include <cstdio>
#include <cstdint>
__device__ __forceinline__ float shx(float v, int off, int lane) { return __int_as_float(__builtin_amdgcn_ds_bpermute((lane ^ off) << 2, __float_as_int(v))); }
__device__ __forceinline__ int shi(int v, int src) { return __builtin_amdgcn_ds_bpermute(src << 2, v); }
#ifndef EPI_WT_MODE
#define EPI_WT_MODE 1
#endif
namespace pg8 {
#define PG8_LAS __attribute__((address_space(3)))
typedef unsigned short bf16_t;
typedef short bf16x8 __attribute__((ext_vector_type(8)));
typedef float f32x4 __attribute__((ext_vector_type(4)));
typedef unsigned u32x4 __attribute__((ext_vector_type(4)));
constexpr int BM = 256, BK = 64, HALF = 128, HTB = HALF * BK * 2  , STAGE_BYTES = 8 * HTB, NXCD = 8, WGM = 8;

__host__ __device__ __forceinline__ int lds_byte(int r, int c) { const int st = (r >> 4) * 2 + (c >> 5), rr = r & 15, cc = c & 31, ob = rr * 64 + cc * 2; return st * 1024 + (ob ^ (((ob >> 9) & 1) << 5)); }
__host__ __device__ __forceinline__ void stage_rc(int b, int& R, int& C) { const int st = b / 1024, sb = b % 1024, swz = sb ^ (((sb >> 9) & 1) << 5); R = (st >> 1) * 16 + swz / 64; C = (st & 1) * 32 + (swz % 64) / 2; }
__host__ __device__ __forceinline__ int perm32(int rho) { const int n = rho >> 4, i = rho & 15; return 8 * (i >> 2) + 4 * n + (i & 3); }

struct Unit { int pm, pn; };
struct Gemm { const bf16_t* A; const bf16_t* Bt; int M, N, K; int gshift; size_t gstride; const int* gidx; };

struct StaticOrder {
    int nM, nN, nwg, G, c;
    __host__ __device__ void init(int M, int N, int G_, int c_) { nM = M / BM; nN = N / BM; nwg = nM * nN; G = G_; c = c_; }
    __host__ __device__ bool next(int i, Unit& u) const {
        const long L = (long)i * G + c; if (L >= nwg) return false;
        int wgid = (int)L; { const int q = nwg / NXCD, r = nwg % NXCD, xcd = wgid % NXCD, off = wgid / NXCD; wgid = (xcd < r ? xcd * (q + 1) : r * (q + 1) + (xcd - r) * q) + off; }
        const int nig = WGM * nN, gid = wgid / nig, fm = gid * WGM, gsz = (nM - fm) < WGM ? (nM - fm) : WGM;
        u.pm = fm + ((wgid % nig) % gsz); u.pn = (wgid % nig) / gsz; return true;
    }
    __device__ __forceinline__ void a_ready(const Unit&) const {}
    __device__ __forceinline__ void done(const Unit&) const {}
};

#define PG8_GAS __attribute__((address_space(1)))
typedef float f32x2 __attribute__((ext_vector_type(2)));
typedef __bf16 bf16x2_t __attribute__((ext_vector_type(2)));
__device__ __forceinline__ unsigned cvt_pk_bf16(float lo, float hi) { f32x2 v = {lo, hi}; bf16x2_t b = __builtin_convertvector(v, bf16x2_t); return __builtin_bit_cast(unsigned, b); }
__device__ __forceinline__ u32x4 pack8(const f32x4 v0, const f32x4 v1) { u32x4 w; w.x = cvt_pk_bf16(v0[0], v0[1]); w.y = cvt_pk_bf16(v0[2], v0[3]); w.z = cvt_pk_bf16(v1[0], v1[1]); w.w = cvt_pk_bf16(v1[2], v1[3]); return w; }
__device__ __forceinline__ float sigmoidf_(float x) { return __builtin_amdgcn_rcpf(1.0f + __expf(-x)); }
__device__ __forceinline__ f32x4 silu4(const f32x4 v) { f32x4 o; o[0] = v[0] * sigmoidf_(v[0]); o[1] = v[1] * sigmoidf_(v[1]); o[2] = v[2] * sigmoidf_(v[2]); o[3] = v[3] * sigmoidf_(v[3]); return o; }

__device__ __forceinline__ void st16(void* p, u32x4 v, bool wt) {
    if (wt) asm volatile("global_store_dwordx4 %0, %1, off sc1\n\ts_nop 1" :: "v"(p), "v"(v) : "memory");
    else *(PG8_GAS u32x4*)p = v;
}
struct EpiInProj {
    static constexpr bool PERM = true, AFTER_DRAIN = false;
    bf16_t *Q, *Kb, *V, *HQ, *KK, *HV, *HG; unsigned short* LF;   const float* rope; const float* lbs;
    float qscale; unsigned* kmax; int nostore; const float* rs;
    __device__ __forceinline__ void operator()(const f32x4 (&acc)[2][2][4][2], const Unit& u, int wr, int wc, int fr, int fq, bool wt) const {
        const int seg = u.pn >> 2, tp = u.pn & 3;
        const int row0 = u.pm * BM + wr * 64 + fr;
        if (seg < 2) {
            bf16_t* dst = seg == 0 ? Q : Kb; const float sc = seg == 0 ? qscale : 1.0f;
            const int col = (tp * 4 + wc) * 64 + 8 * fq;
            float kmx = 0.f;
#pragma unroll
            for (int ai = 0; ai < 2; ++ai)
#pragma unroll
                for (int m = 0; m < 4; ++m) { const int row = row0 + ai * HALF + m * 16;
                    const float* tb = rope + (size_t)row * 64 + 8 * fq;
                    const f32x4 c0 = *(const PG8_GAS f32x4*)(tb), c1 = *(const PG8_GAS f32x4*)(tb + 4), s0 = *(const PG8_GAS f32x4*)(tb + 32), s1 = *(const PG8_GAS f32x4*)(tb + 36);
                    const float r_ = ((const PG8_GAS float*)rs)[row]; const f32x4 xa = acc[ai][0][m][0] * r_, xb = acc[ai][0][m][1] * r_, ya = acc[ai][1][m][0] * r_, yb = acc[ai][1][m][1] * r_;
                    const f32x4 o1a = (xa * c0 - ya * s0) * sc, o1b = (xb * c1 - yb * s1) * sc, o2a = (ya * c0 + xa * s0) * sc, o2b = (yb * c1 + xb * s1) * sc;
                    bf16_t* rowp = dst + (size_t)row * 1024 + col;
                    if (!nostore) { st16(rowp, pack8(o1a, o1b), wt); st16(rowp + 32, pack8(o2a, o2b), wt); }
                    if (seg == 1) { const f32x4 q2 = xa * xa + xb * xb + ya * ya + yb * yb; float ss = (q2[0] + q2[1]) + (q2[2] + q2[3]);
                        ss += shx(ss, 16, fq * 16 + fr); ss += shx(ss, 32, fq * 16 + fr); kmx = fmaxf(kmx, ss); } }
            if (seg == 1) {
#pragma unroll
                for (int o_ = 1; o_ < 16; o_ <<= 1) kmx = fmaxf(kmx, shx(kmx, o_, fq * 16 + fr));
                if (fr == 0 && fq == 0) __hip_atomic_fetch_max(kmax + tp * 4 + wc, __float_as_uint(sqrtf(kmx)), __ATOMIC_RELAXED, __HIP_MEMORY_SCOPE_AGENT); }
        } else if (seg == 4 || seg == 5) {
            const int dir = seg - 4;
#pragma unroll
            for (int bj = 0; bj < 2; ++bj) { const int col = tp * 256 + bj * HALF + wc * 32 + 8 * fq;
                const f32x4 lb0 = *(const PG8_GAS f32x4*)(lbs + dir * 4096 + col), lb1 = *(const PG8_GAS f32x4*)(lbs + dir * 4096 + col + 4);
#pragma unroll
                for (int ai = 0; ai < 2; ++ai)
#pragma unroll
                    for (int m = 0; m < 4; ++m) { const int row = row0 + ai * HALF + m * 16;
                        f32x4 lf0, lf1, k0, k1; const float r_ = ((const PG8_GAS float*)rs)[row];
#pragma unroll
                        for (int q = 0; q < 4; ++q) { const float z0 = fminf(fmaxf(acc[ai][bj][m][0][q] * r_, -80.f), 80.f), z1 = fminf(fmaxf(acc[ai][bj][m][1][q] * r_, -80.f), 80.f);
                            const float e0 = __expf(-z0), e1 = __expf(-z1), sg0 = __builtin_amdgcn_rcpf(1.0f + e0), sg1 = __builtin_amdgcn_rcpf(1.0f + e1);
                            lf0[q] = __logf(lb0[q] + (1.0f - lb0[q]) * sg0); lf1[q] = __logf(lb1[q] + (1.0f - lb1[q]) * sg1);
                            k0[q] = (1.0f - lb0[q]) * (e0 * sg0); k1[q] = (1.0f - lb1[q]) * (e1 * sg1); }
                        unsigned short* lfp = LF + (size_t)row * 2048 + dir * 1024 + col; if (!nostore) { typedef _Float16 h2_t __attribute__((ext_vector_type(2))); u32x4 hw_;
                        hw_.x = __builtin_bit_cast(unsigned, __builtin_convertvector((f32x2){lf0[0], lf0[1]}, h2_t)); hw_.y = __builtin_bit_cast(unsigned, __builtin_convertvector((f32x2){lf0[2], lf0[3]}, h2_t));
                        hw_.z = __builtin_bit_cast(unsigned, __builtin_convertvector((f32x2){lf1[0], lf1[1]}, h2_t)); hw_.w = __builtin_bit_cast(unsigned, __builtin_convertvector((f32x2){lf1[2], lf1[3]}, h2_t)); st16(lfp, hw_, wt);
                        st16(KK + (size_t)row * 2048 + dir * 1024 + col, pack8(k0, k1), wt); } else if (lf0[0] + lf1[1] + k0[2] + k1[3] == 12345.678f) *lfp = 0; }
            }
        } else {
            bf16_t* dst = seg == 2 ? V : seg == 3 ? HQ : seg == 6 ? HV : HG;
#pragma unroll
            for (int bj = 0; bj < 2; ++bj) { const int col = tp * 256 + bj * HALF + wc * 32 + 8 * fq;
#pragma unroll
                for (int ai = 0; ai < 2; ++ai)
#pragma unroll
                    for (int m = 0; m < 4; ++m) { const int row = row0 + ai * HALF + m * 16;
                        const float r_ = ((const PG8_GAS float*)rs)[row]; f32x4 v0 = acc[ai][bj][m][0] * r_, v1 = acc[ai][bj][m][1] * r_;
                        if (seg == 3) { v0 = silu4(v0) * 0.08838834764831845f; v1 = silu4(v1) * 0.08838834764831845f; }
                        else if (seg == 7) { v0 = silu4(v0); v1 = silu4(v1); }
                        if (!nostore) st16(dst + (size_t)row * 1024 + col, pack8(v0, v1), wt); else if (v0[0] + v1[1] == 12345.678f) dst[0] = 0; }
            }
        }
    }
};
template <bool F32BASE> struct EpiResidBf {
    static constexpr bool PERM = true, AFTER_DRAIN = false;
    const float* xf; bf16_t* X;
    __device__ __forceinline__ void operator()(const f32x4 (&acc)[2][2][4][2], const Unit& u, int wr, int wc, int fr, int fq, bool wt) const {
#pragma unroll
        for (int ai = 0; ai < 2; ++ai)
#pragma unroll
            for (int m = 0; m < 4; ++m) { const size_t row = (size_t)(u.pm * BM + ai * HALF + wr * 64 + m * 16 + fr);
#pragma unroll
                for (int bj = 0; bj < 2; ++bj) { const size_t off = row * 2048 + u.pn * BM + bj * HALF + wc * 32 + 8 * fq;
                    f32x4 b0, b1;
                    if (F32BASE) { b0 = *(const PG8_GAS f32x4*)(xf + off); b1 = *(const PG8_GAS f32x4*)(xf + off + 4); }
                    else { const u32x4 w = *(const PG8_GAS u32x4*)(X + off); b0 = (f32x4){__uint_as_float(w.x << 16), __uint_as_float(w.x & 0xffff0000u), __uint_as_float(w.y << 16), __uint_as_float(w.y & 0xffff0000u)};
                           b1 = (f32x4){__uint_as_float(w.z << 16), __uint_as_float(w.z & 0xffff0000u), __uint_as_float(w.w << 16), __uint_as_float(w.w & 0xffff0000u)}; }
                    st16(X + off, pack8(b0 + acc[ai][bj][m][0], b1 + acc[ai][bj][m][1]), wt); } }
    }
};
struct EpiSwiGLU {
    static constexpr bool PERM = true, AFTER_DRAIN = false;
    bf16_t* H; const float* rsg;
    __device__ __forceinline__ void operator()(const f32x4 (&acc)[2][2][4][2], const Unit& u, int wr, int wc, int fr, int fq, bool wt) const {
        const int col = u.pn * HALF + wc * 32 + 8 * fq;
#pragma unroll
        for (int ai = 0; ai < 2; ++ai)
#pragma unroll
            for (int m = 0; m < 4; ++m) { const int row = u.pm * BM + ai * HALF + wr * 64 + m * 16 + fr; const float r_ = ((const PG8_GAS float*)rsg)[row];
                const f32x4 h0 = silu4(acc[ai][0][m][0] * r_) * (acc[ai][1][m][0] * r_), h1 = silu4(acc[ai][0][m][1] * r_) * (acc[ai][1][m][1] * r_);
                st16(H + (size_t)row * 1024 + col, pack8(h0, h1), wt); }
    }
};
struct EpiDown {
    static constexpr bool PERM = true, AFTER_DRAIN = false;
    bf16_t* Y; const float* gate;
    __device__ __forceinline__ void operator()(const f32x4 (&acc)[2][2][4][2], const Unit& u, int wr, int wc, int fr, int fq, bool wt) const {
#pragma unroll
        for (int ai = 0; ai < 2; ++ai)
#pragma unroll
            for (int m = 0; m < 4; ++m) { const int row = u.pm * BM + ai * HALF + wr * 64 + m * 16 + fr; const float g = ((const PG8_GAS float*)gate)[row];
#pragma unroll
                for (int bj = 0; bj < 2; ++bj) { const int col = u.pn * BM + bj * HALF + wc * 32 + 8 * fq;
                    st16(Y + (size_t)row * 2048 + col, pack8(acc[ai][bj][m][0] * g, acc[ai][bj][m][1] * g), wt); } }
    }
};
template <class Epi, class Sched, bool ALIGN_EPI = false, bool SP2 = false, bool GATHER = false>
__device__ __forceinline__ void gemm_phase(PG8_LAS unsigned char* lds, const Gemm g, const Sched& S, const Epi& E, const int tid) {
    const int wid = __builtin_amdgcn_readfirstlane(tid >> 6), lane = tid & 63, wr = wid >> 2, wc = wid & 3, fr = lane & 15, fq = lane >> 4;
    const int K = g.K, nt = K / BK;
    unsigned voffA[2], voffB[2];
#pragma unroll
    for (int i = 0; i < 2; ++i) { int R, C; stage_rc(tid * 16 + i * 8192, R, C); const int Rb = Epi::PERM ? ((R & ~31) + perm32(R & 31)) : R;
        voffA[i] = (unsigned)(R * K + C) * 2u; voffB[i] = (unsigned)(Rb * K + C) * 2u; }
    unsigned vgc[2][2], vgn[2][2];
#define PG8_GLOAD(u, v) do { _Pragma("unroll") for (int h_ = 0; h_ < 2; ++h_) _Pragma("unroll") for (int i_ = 0; i_ < 2; ++i_) { int R_, C_; stage_rc(tid * 16 + i_ * 8192, R_, C_); \
        v[h_][i_] = ((unsigned)g.gidx[(u).pm * BM + h_ * HALF + R_] * (unsigned)K + (unsigned)C_) * 2u; } } while (0)
#define PG8_STA(b, h, base, NX) do { if constexpr (GATHER) { const unsigned vv_[2] = {(NX) ? vgn[h][0] : vgc[h][0], (NX) ? vgn[h][1] : vgc[h][1]}; PG8_STAGE(PG8_SA(b, h), base, vv_); } \
        else { PG8_STAGE(PG8_SA(b, h), (base) + (h) * hstep, voffA); } } while (0)
    const size_t kstep = (size_t)(BK * 2);
    const size_t hstep = (size_t)HALF * K * 2;
    const size_t tstep = 2 * hstep;
    const unsigned ldsw = (unsigned)wid * 1024u;
    const int aoff = lds_byte(wr * 64 + fr, fq * 8), boff = lds_byte(wc * 32 + fr, fq * 8);
#define PG8_SA(b, h) (((b) * 2 + (h)) * HTB)
#define PG8_SB(b, h) ((4 + (b) * 2 + (h)) * HTB)
#define PG8_STAGE(bufoff, gbase, voff) do { _Pragma("unroll") for (int _i = 0; _i < 2; ++_i) \
        __builtin_amdgcn_global_load_lds((const unsigned*)((const char*)(gbase) + (voff)[_i]), (PG8_LAS unsigned*)(lds + (bufoff) + ldsw + _i * 8192), 16, 0, 0); } while (0)
#define PG8_LDA(dst, b, h) do { _Pragma("unroll") for (int m = 0; m < 4; ++m) _Pragma("unroll") for (int k = 0; k < 2; ++k) dst[m][k] = *(const PG8_LAS bf16x8*)(lds + PG8_SA(b, h) + aoff + m * 2048 + k * 1024); } while (0)
#define PG8_LDB(dst, b, h) do { _Pragma("unroll") for (int n = 0; n < 2; ++n) _Pragma("unroll") for (int k = 0; k < 2; ++k) dst[n][k] = *(const PG8_LAS bf16x8*)(lds + PG8_SB(b, h) + boff + n * 2048 + k * 1024); } while (0)
#define PG8_MMA(ai, bj, At, Bt) do { __builtin_amdgcn_s_setprio(1); _Pragma("unroll") for (int m = 0; m < 4; ++m) _Pragma("unroll") for (int n = 0; n < 2; ++n) _Pragma("unroll") for (int k = 0; k < 2; ++k) \
        acc[ai][bj][m][n] = __builtin_amdgcn_mfma_f32_16x16x32_bf16(Bt[n][k], At[m][k], acc[ai][bj][m][n], 0, 0, 0); __builtin_amdgcn_s_setprio(0); } while (0)
#define PG8_WAIT_V(n) asm volatile("s_waitcnt vmcnt(" #n ")" ::: "memory")
#define PG8_WAIT_L(n) asm volatile("s_waitcnt lgkmcnt(" #n ")" ::: "memory")
#define PG8_BAR __builtin_amdgcn_s_barrier()
#define PG8_SCHED __builtin_amdgcn_sched_barrier(0)
    Unit cur, nxt; int ui = 0;
    if (!S.next(0, cur)) return;
    f32x4 acc[2][2][4][2];
#pragma unroll
    for (int a = 0; a < 2; ++a)
#pragma unroll
        for (int b = 0; b < 2; ++b)
#pragma unroll
            for (int m = 0; m < 4; ++m)
#pragma unroll
                for (int n = 0; n < 2; ++n) acc[a][b][m][n] = (f32x4){0.f, 0.f, 0.f, 0.f};
    bf16x8 At[4][2], B0[2][2], B1[2][2];
    if constexpr (GATHER) PG8_GLOAD(cur, vgc);
    const char* cA = (const char*)g.A + (GATHER ? (size_t)0 : (size_t)cur.pm * tstep); const char* cB = (const char*)g.Bt + (size_t)(cur.pm >> g.gshift) * g.gstride + (size_t)cur.pn * tstep;
    S.a_ready(cur);
    if constexpr (SP2) {
        PG8_STAGE(PG8_SB(0, 0), cB, voffB); PG8_STAGE(PG8_SB(0, 1), cB + hstep, voffB); PG8_STA(0, 0, cA, false); PG8_STA(0, 1, cA, false);
        if (wr == 1) PG8_BAR;
        PG8_WAIT_V(2); PG8_BAR;
        PG8_STAGE(PG8_SB(1, 0), cB + kstep, voffB); PG8_STA(1, 0, cA + kstep, false); PG8_STAGE(PG8_SB(1, 1), cB + hstep + kstep, voffB);
        PG8_WAIT_V(6); PG8_BAR;
    } else {
        PG8_STAGE(PG8_SB(0, 0), cB, voffB); PG8_STA(0, 0, cA, false); PG8_STAGE(PG8_SB(0, 1), cB + hstep, voffB); PG8_STA(0, 1, cA, false);
        if (wr == 1) PG8_BAR;
        PG8_WAIT_V(4); PG8_BAR;
        PG8_STAGE(PG8_SB(1, 0), cB + kstep, voffB); PG8_STA(1, 0, cA + kstep, false); PG8_STAGE(PG8_SB(1, 1), cB + hstep + kstep, voffB);
        PG8_WAIT_V(6); PG8_BAR;
    }
    for (;;) {
        const bool has_next = S.next(ui + 1, nxt);
        if constexpr (GATHER) { if (has_next) PG8_GLOAD(nxt, vgn); else { vgn[0][0] = vgc[0][0]; vgn[0][1] = vgc[0][1]; vgn[1][0] = vgc[1][0]; vgn[1][1] = vgc[1][1]; } }
        const char* nA = (has_next && !GATHER) ? (const char*)g.A + (size_t)nxt.pm * tstep : cA; const char* nB = has_next ? (const char*)g.Bt + (size_t)(nxt.pm >> g.gshift) * g.gstride + (size_t)nxt.pn * tstep : cB;
        for (int t = 0; t < nt; t += 2) {
            const bool last = (t == nt - 2);
            const char* a1 = cA + (size_t)(t + 1) * kstep;
            const char* a2 = last ? nA : cA + (size_t)(t + 2) * kstep; const char* b2 = last ? nB : cB + (size_t)(t + 2) * kstep;
            const char* a3 = a2 + kstep; const char* b3 = b2 + kstep;
            if (last && has_next) S.a_ready(nxt);
            if constexpr (SP2) {
            PG8_LDB(B0, 0, 0); PG8_LDB(B1, 0, 1); PG8_SCHED; PG8_LDA(At, 0, 0); PG8_STA(1, 1, a1, false);
            PG8_WAIT_V(8); PG8_WAIT_L(0); PG8_BAR; PG8_MMA(0, 0, At, B0); PG8_MMA(0, 1, At, B1); PG8_BAR; PG8_SCHED;
            PG8_LDA(At, 0, 1); PG8_STAGE(PG8_SB(0, 0), b2, voffB); PG8_STAGE(PG8_SB(0, 1), b2 + hstep, voffB); PG8_STA(0, 0, a2, last);
            PG8_WAIT_V(8); PG8_WAIT_L(0); PG8_BAR; PG8_MMA(1, 0, At, B0); PG8_MMA(1, 1, At, B1); PG8_BAR; PG8_SCHED;
            PG8_LDB(B0, 1, 0); PG8_LDB(B1, 1, 1); PG8_SCHED; PG8_LDA(At, 1, 0); PG8_STA(0, 1, a2, last);
            PG8_WAIT_V(8); PG8_WAIT_L(0); PG8_BAR; PG8_MMA(0, 0, At, B0); PG8_MMA(0, 1, At, B1); PG8_BAR; PG8_SCHED;
            PG8_LDA(At, 1, 1); PG8_STAGE(PG8_SB(1, 0), b3, voffB); PG8_STAGE(PG8_SB(1, 1), b3 + hstep, voffB); PG8_STA(1, 0, a3, last);
            PG8_WAIT_V(8); PG8_WAIT_L(0); PG8_BAR; PG8_MMA(1, 0, At, B0); PG8_MMA(1, 1, At, B1); PG8_BAR; PG8_SCHED;
            } else {
            PG8_LDB(B0, 0, 0); PG8_SCHED; PG8_LDA(At, 0, 0); PG8_STA(1, 1, a1, false);
            PG8_WAIT_L(8); PG8_BAR; PG8_WAIT_L(0); PG8_MMA(0, 0, At, B0); PG8_BAR; PG8_SCHED;
            PG8_LDB(B1, 0, 1); PG8_STAGE(PG8_SB(0, 0), b2, voffB);
            PG8_BAR; PG8_WAIT_L(0); PG8_MMA(0, 1, At, B1); PG8_BAR;
            PG8_LDA(At, 0, 1); PG8_STA(0, 0, a2, last);
            PG8_BAR; PG8_WAIT_L(0); PG8_MMA(1, 0, At, B0); PG8_BAR; PG8_SCHED;
            PG8_STAGE(PG8_SB(0, 1), b2 + hstep, voffB);
            PG8_WAIT_V(6); PG8_BAR; PG8_MMA(1, 1, At, B1); PG8_BAR;
            PG8_LDB(B0, 1, 0); PG8_SCHED; PG8_LDA(At, 1, 0); PG8_STA(0, 1, a2, last);
            PG8_WAIT_L(8); PG8_BAR; PG8_WAIT_L(0); PG8_MMA(0, 0, At, B0); PG8_BAR; PG8_SCHED;
            PG8_LDB(B1, 1, 1); PG8_STAGE(PG8_SB(1, 0), b3, voffB);
            PG8_BAR; PG8_WAIT_L(0); PG8_MMA(0, 1, At, B1); PG8_BAR;
            PG8_LDA(At, 1, 1); PG8_STA(1, 0, a3, last);
            PG8_BAR; PG8_WAIT_L(0); PG8_MMA(1, 0, At, B0); PG8_BAR; PG8_SCHED;
            PG8_STAGE(PG8_SB(1, 1), b3 + hstep, voffB);
            PG8_WAIT_V(6); PG8_BAR; PG8_MMA(1, 1, At, B1); PG8_BAR;
            }
        }
        if constexpr (ALIGN_EPI) { if (wr == 0) PG8_BAR; }
        if constexpr (!Epi::AFTER_DRAIN) { E(acc, cur, wr, wc, fr, fq, EPI_WT_MODE == 2 || (EPI_WT_MODE == 1 && !has_next)); S.done(cur); }
        if (!has_next) break;
#pragma unroll
        for (int a = 0; a < 2; ++a)
#pragma unroll
            for (int b = 0; b < 2; ++b)
#pragma unroll
                for (int m = 0; m < 4; ++m)
#pragma unroll
                    for (int n = 0; n < 2; ++n) acc[a][b][m][n] = (f32x4){0.f, 0.f, 0.f, 0.f};
        cur = nxt; cA = nA; cB = nB; ++ui;
        if constexpr (GATHER) { vgc[0][0] = vgn[0][0]; vgc[0][1] = vgn[0][1]; vgc[1][0] = vgn[1][0]; vgc[1][1] = vgn[1][1]; }
        if constexpr (ALIGN_EPI) { if (wr == 1) PG8_BAR; }
    }
    PG8_WAIT_V(0);
    if constexpr (!ALIGN_EPI) { if (wr == 0) PG8_BAR; }
    PG8_BAR;
    if constexpr (Epi::AFTER_DRAIN) { E.fused(acc, cur, wr, wc, fr, fq, lds, wid, lane); S.done(cur); }
#undef PG8_SA
#undef PG8_SB
#undef PG8_STAGE
#undef PG8_LDA
#undef PG8_LDB
#undef PG8_MMA
#undef PG8_WAIT_V
#undef PG8_WAIT_L
#undef PG8_BAR
#undef PG8_SCHED
#undef PG8_STA
#undef PG8_GLOAD
}
}

namespace att {
using bf16 = unsigned short;
using bf16x8 = __attribute__((ext_vector_type(8))) short;
using s16x4  = __attribute__((ext_vector_type(4))) short;
using f32x16 = __attribute__((ext_vector_type(16))) float;
using u32x4  = __attribute__((ext_vector_type(4))) unsigned;
constexpr int NW = 8, QBLK = 32, KVBLK = 64, SEQ = 16384, LDQ = 1024, LDMIX = 2048;
constexpr int SHM_V = KVBLK * 128 * 2, SHM_K = KVBLK * 64 * 2;
constexpr int OFF_V = 0, OFF_K = 2 * SHM_V, OFF_WS = OFF_K + 2 * SHM_K, LDS_BYTES = OFF_WS + NW * 64 * 4;
constexpr float THR2 = 11.0f;
#define AT_LAS __attribute__((address_space(3)))
#define AT_KSWZ(row, colB) ((row) * 128 + ((colB) ^ ((((row) >> 1) & 7) << 4)))
#define AT_SBAR() __builtin_amdgcn_sched_barrier(0)
__device__ __forceinline__ int crow(int r, int hi) { return (r & 3) + 8 * (r >> 2) + 4 * hi; }
__device__ __forceinline__ unsigned cvtpk(float lo, float hi) { unsigned r; asm volatile("v_cvt_pk_bf16_f32 %0, %1, %2" : "=v"(r) : "v"(lo), "v"(hi)); return r; }

__device__ __forceinline__ void partialSM(f32x16& p0, f32x16& p1, float& m_reg, float& alpha) {
  float pmax = p0[0];
#pragma unroll
  for (int r = 1; r < 16; ++r) pmax = fmaxf(pmax, p0[r]);
#pragma unroll
  for (int r = 0; r < 16; ++r) pmax = fmaxf(pmax, p1[r]);
  { auto rr = __builtin_amdgcn_permlane32_swap(__float_as_uint(pmax), __float_as_uint(pmax), false, false);
    pmax = fmaxf(__uint_as_float(rr[0]), __uint_as_float(rr[1])); }
  float mn;
  if (__builtin_expect(__all(pmax - m_reg <= THR2), 1)) { mn = m_reg; alpha = 1.f; }
  else { mn = fmaxf(m_reg, pmax); alpha = __builtin_amdgcn_exp2f(m_reg - mn); m_reg = mn; }
#pragma unroll
  for (int r = 0; r < 16; ++r) { p0[r] -= mn; p1[r] -= mn; }
#pragma unroll
  for (int r = 0; r < 16; ++r) p0[r] = __builtin_amdgcn_exp2f(p0[r]);
}
__device__ __forceinline__ void finishSM(f32x16& p0, f32x16& p1, float alpha, float& l_reg, bf16x8& pa0, bf16x8& pa1, bf16x8& pa2, bf16x8& pa3) {
#pragma unroll
  for (int r = 0; r < 16; ++r) p1[r] = __builtin_amdgcn_exp2f(p1[r]);
  float ps = 0;
#pragma unroll
  for (int r = 0; r < 16; ++r) ps += p0[r];
#pragma unroll
  for (int r = 0; r < 16; ++r) ps += p1[r];
  { auto rr = __builtin_amdgcn_permlane32_swap(__float_as_uint(ps), __float_as_uint(ps), false, false);
    ps = __uint_as_float(rr[0]) + __uint_as_float(rr[1]); }
  l_reg = l_reg * alpha + ps;
#define AT_PK4(P, BASE, OUT) do { unsigned a0 = cvtpk(P[BASE + 0], P[BASE + 1]), a1 = cvtpk(P[BASE + 2], P[BASE + 3]);   \
    unsigned b0 = cvtpk(P[BASE + 4], P[BASE + 5]), b1 = cvtpk(P[BASE + 6], P[BASE + 7]);                              \
    auto r0 = __builtin_amdgcn_permlane32_swap(a0, b0, false, false); auto r1 = __builtin_amdgcn_permlane32_swap(a1, b1, false, false); \
    u32x4 w = {r0[0], r1[0], r0[1], r1[1]}; OUT = __builtin_bit_cast(bf16x8, w); } while (0)
  AT_PK4(p0, 0, pa0); AT_PK4(p0, 8, pa1); AT_PK4(p1, 0, pa2); AT_PK4(p1, 8, pa3);
#undef AT_PK4
}
__device__ __forceinline__ void qkt(f32x16& p0, f32x16& p1, const AT_LAS char* Ks, const bf16x8 (&qr)[4], int r32, int hi) {
  p0 = f32x16{}; p1 = f32x16{};
#pragma unroll
  for (int d0 = 0; d0 < 4; ++d0) { const int cb = (d0 * 16 + hi * 8) * 2;
    const bf16x8 b0 = *(const AT_LAS bf16x8*)(Ks + AT_KSWZ(r32, cb));
    const bf16x8 b1 = *(const AT_LAS bf16x8*)(Ks + AT_KSWZ(32 + r32, cb));
    p0 = __builtin_amdgcn_mfma_f32_32x32x16_bf16(b0, qr[d0], p0, 0, 0, 0);
    p1 = __builtin_amdgcn_mfma_f32_32x32x16_bf16(b1, qr[d0], p1, 0, 0, 0); }
}
__device__ __forceinline__ int v_st(int k, int c) { const int kk = (k & ~0xC) | ((k & 4) << 1) | ((k & 8) >> 1); return ((kk >> 3) * 4 + (c >> 5)) * 512 + ((kk & 7) * 32 + (c & 31)) * 2; }
__device__ __forceinline__ int v_rd_base(int lane) { return ((lane & 3) << 3) | (((lane >> 2) & 3) << 6) | (((lane >> 4) & 1) << 5) | (((lane >> 5) & 1) << 8); }
constexpr int v_rd_off(int d0, int ks, int half) { return d0 * 512 + ks * 4096 + half * 2048; }
template <int OFF> __device__ __forceinline__ s16x4 tr_read(int vb) {
  s16x4 r; asm volatile("ds_read_b64_tr_b16 %0, %1 offset:%2" : "=&v"(r) : "v"(vb), "i"(OFF) : "memory"); return r;
}
template <int D0> __device__ __forceinline__ void pv_one(f32x16& od, int vb, bf16x8 pa0, bf16x8 pa1, bf16x8 pa2, bf16x8 pa3) {
  const s16x4 l0 = tr_read<v_rd_off(D0, 0, 0)>(vb), h0 = tr_read<v_rd_off(D0, 0, 1)>(vb), l1 = tr_read<v_rd_off(D0, 1, 0)>(vb), h1 = tr_read<v_rd_off(D0, 1, 1)>(vb);
  const s16x4 l2 = tr_read<v_rd_off(D0, 2, 0)>(vb), h2 = tr_read<v_rd_off(D0, 2, 1)>(vb), l3 = tr_read<v_rd_off(D0, 3, 0)>(vb), h3 = tr_read<v_rd_off(D0, 3, 1)>(vb);
  asm volatile("s_waitcnt lgkmcnt(0)" ::: "memory"); AT_SBAR();
#define AT_PK(L, H) (bf16x8){L[0], L[1], L[2], L[3], H[0], H[1], H[2], H[3]}
  od = __builtin_amdgcn_mfma_f32_32x32x16_bf16(pa0, AT_PK(l0, h0), od, 0, 0, 0);
  od = __builtin_amdgcn_mfma_f32_32x32x16_bf16(pa1, AT_PK(l1, h1), od, 0, 0, 0);
  od = __builtin_amdgcn_mfma_f32_32x32x16_bf16(pa2, AT_PK(l2, h2), od, 0, 0, 0);
  od = __builtin_amdgcn_mfma_f32_32x32x16_bf16(pa3, AT_PK(l3, h3), od, 0, 0, 0);
#undef AT_PK
}
__device__ __forceinline__ void pv_d0(f32x16 (&o)[4], int vb, bf16x8 pa0, bf16x8 pa1, bf16x8 pa2, bf16x8 pa3) {
  pv_one<0>(o[0], vb, pa0, pa1, pa2, pa3); pv_one<1>(o[1], vb, pa0, pa1, pa2, pa3); pv_one<2>(o[2], vb, pa0, pa1, pa2, pa3); pv_one<3>(o[3], vb, pa0, pa1, pa2, pa3);
}

struct AttnArgs { const bf16* Q; const bf16* K; const bf16* V; const bf16* VT; float* AO1; bf16* MIX; const float* subg; const float* kmax; float lam; float outscale; };

#ifndef AT_STAGGER
#define AT_STAGGER 0
#endif
#ifndef AT_PF
#define AT_PF 2
#endif
constexpr int NBUF = 5, BUF_BYTES = SHM_K + SHM_V;
constexpr int OFF_WS2 = NBUF * BUF_BYTES, LDS_BYTES2 = OFF_WS2 + NW * 64 * 4;
__device__ __forceinline__ void glds16(const void* gsrc, unsigned lds_dst) { unsigned keep;
  asm volatile("s_mov_b32 %0, m0\n\ts_mov_b32 m0, %2\n\ts_nop 0\n\tglobal_load_lds_dwordx4 %1, off\n\ts_mov_b32 m0, %0" : "=&s"(keep) : "v"(gsrc), "s"(lds_dst) : "memory"); }
__device__ __forceinline__ void glds16s(const void* sbase, unsigned voff, unsigned lds_dst) { unsigned keep;
  asm volatile("s_mov_b32 %0, m0\n\ts_mov_b32 m0, %3\n\ts_nop 4\n\tglobal_load_lds_dwordx4 %1, %2\n\ts_mov_b32 m0, %0" : "=&s"(keep) : "v"(voff), "s"(sbase), "s"(lds_dst) : "memory"); }
#define AT_WAIT_BAR(N) asm volatile("s_waitcnt vmcnt(" #N ") lgkmcnt(0)\n\ts_barrier" ::: "memory")

template <int VAR>
__device__ __forceinline__ void attn_unit(const AttnArgs& A, int h, int qt, AT_LAS char* lds, const int tid) {
  const int q0 = qt * 256;
  const unsigned lds0 = (unsigned)(uintptr_t)lds;
  constexpr int NT = SEQ / KVBLK;
#pragma unroll 1
  for (int mp = 0; mp < 2; ++mp) {
    int tl = tid; asm volatile("" : "+v"(tl));
    const int lane = tl & 63, r32 = lane & 31, hi = lane >> 5; const int wid = __builtin_amdgcn_readfirstlane(tl >> 6);
    AT_LAS float* li_l = (AT_LAS float*)(lds + OFF_WS2) + wid * 64;
    int koff, voff0, voff1;
    { const int row = 8 * wid + (lane >> 3), cpos = lane & 7; koff = row * LDQ + 8 * (cpos ^ ((row >> 1) & 7)); }
    { const int B = (2 * wid) * 1024 + lane * 16, sub = B >> 9, wel = (B & 511) >> 1, kk = (sub >> 2) * 8 + (wel >> 5), k = (kk & ~0xC) | ((kk & 4) << 1) | ((kk & 8) >> 1); voff0 = k * LDQ + (sub & 3) * 32 + (wel & 31); }
    { const int B = (2 * wid + 1) * 1024 + lane * 16, sub = B >> 9, wel = (B & 511) >> 1, kk = (sub >> 2) * 8 + (wel >> 5), k = (kk & ~0xC) | ((kk & 4) << 1) | ((kk & 8) >> 1); voff1 = k * LDQ + (sub & 3) * 32 + (wel & 31); }
    const unsigned kdst = lds0 + wid * 1024, vdst = lds0 + SHM_K + wid * 2048;
    const int vrd = (int)lds0 + SHM_K + v_rd_base(lane);
    const bf16* Vh = A.V + h * 128;
    const bf16* Kh = A.K + (h * 2 + mp) * 64;
    const bf16* Qw = A.Q + (size_t)(q0 + wid * QBLK + r32) * LDQ + (h * 2 + mp) * 64 + hi * 8;
    const unsigned kob = (unsigned)koff * 2u, vob0 = (unsigned)voff0 * 2u, vob1 = (unsigned)voff1 * 2u;
#define AT_DMA(t, boff) do { const size_t to_ = (size_t)(t) * (KVBLK * LDQ); const unsigned bo_ = (unsigned)__builtin_amdgcn_readfirstlane(boff); \
    glds16s(Kh + to_, kob, (unsigned)__builtin_amdgcn_readfirstlane(kdst + bo_)); glds16s(Vh + to_, vob0, (unsigned)__builtin_amdgcn_readfirstlane(vdst + bo_)); glds16s(Vh + to_, vob1, (unsigned)__builtin_amdgcn_readfirstlane(vdst + bo_ + 1024u)); } while (0)
    __syncthreads();
    AT_DMA(0, 0); AT_DMA(1, BUF_BYTES); if (AT_PF == 3) AT_DMA(2, 2 * BUF_BYTES);
    bf16x8 qr[4];
#pragma unroll
    for (int d0 = 0; d0 < 4; ++d0) qr[d0] = *(const bf16x8*)(Qw + d0 * 16);
    float qss = 0.f;
#pragma unroll
    for (int d0 = 0; d0 < 4; ++d0)
#pragma unroll
      for (int e = 0; e < 8; ++e) { const float v = __uint_as_float(((unsigned)(unsigned short)qr[d0][e]) << 16); qss += v * v; }
    { auto rr = __builtin_amdgcn_permlane32_swap(__float_as_uint(qss), __float_as_uint(qss), false, false); qss = __uint_as_float(rr[0]) + __uint_as_float(rr[1]); }
    const float mref = sqrtf(qss) * A.kmax[h * 2 + mp] * 1.01f + 0.25f;
    f32x16 negm;
#pragma unroll
    for (int r = 0; r < 16; ++r) negm[r] = -mref;
    float l_reg = 0.f; f32x16 o[4]; o[0] = f32x16{}; o[1] = f32x16{}; o[2] = f32x16{}; o[3] = f32x16{};
    f32x16 sA0, sA1, sB0, sB1; bf16x8 pa0, pa1, pa2, pa3;
    if (VAR & 4) { sB0 = negm; sB1 = negm; }
    if (AT_PF == 3) AT_WAIT_BAR(3); else AT_WAIT_BAR(0);
#define AT_QKT_D(P0, P1, kb_, d0) do { const int cb = ((d0) * 16 + hi * 8) * 2; \
      const bf16x8 b0 = *(const AT_LAS bf16x8*)(kb_ + AT_KSWZ(r32, cb)); const bf16x8 b1 = *(const AT_LAS bf16x8*)(kb_ + AT_KSWZ(32 + r32, cb)); \
      if ((d0) == 0) { P0 = __builtin_amdgcn_mfma_f32_32x32x16_bf16(b0, qr[d0], negm, 0, 0, 0); P1 = __builtin_amdgcn_mfma_f32_32x32x16_bf16(b1, qr[d0], negm, 0, 0, 0); } \
      else { P0 = __builtin_amdgcn_mfma_f32_32x32x16_bf16(b0, qr[d0], P0, 0, 0, 0); P1 = __builtin_amdgcn_mfma_f32_32x32x16_bf16(b1, qr[d0], P1, 0, 0, 0); } } while (0)
#define AT_QKT(P0, P1, boff) do { const AT_LAS char* kb_ = lds + (boff); \
    AT_QKT_D(P0, P1, kb_, 0); AT_QKT_D(P0, P1, kb_, 1); AT_SBAR(); AT_QKT_D(P0, P1, kb_, 2); AT_QKT_D(P0, P1, kb_, 3); } while (0)
#define AT_SOFT(P0, P1) do { float ps = 0.f; \
    if (!(VAR & 1)) { _Pragma("unroll") for (int r = 0; r < 16; ++r) { P0[r] = __builtin_amdgcn_exp2f(P0[r]); P1[r] = __builtin_amdgcn_exp2f(P1[r]); } } \
    _Pragma("unroll") for (int r = 0; r < 16; ++r) ps += P0[r]; \
    _Pragma("unroll") for (int r = 0; r < 16; ++r) ps += P1[r]; \
    l_reg += ps; \
    AT_PK4(P0, 0, pa0); AT_PK4(P0, 8, pa1); AT_PK4(P1, 0, pa2); AT_PK4(P1, 8, pa3); } while (0)
#define AT_PK4(P, BASE, OUT) do { unsigned a0 = cvtpk(P[BASE + 0], P[BASE + 1]), a1 = cvtpk(P[BASE + 2], P[BASE + 3]);   \
    unsigned b0 = cvtpk(P[BASE + 4], P[BASE + 5]), b1 = cvtpk(P[BASE + 6], P[BASE + 7]);                              \
    auto r0 = __builtin_amdgcn_permlane32_swap(a0, b0, false, false); auto r1 = __builtin_amdgcn_permlane32_swap(a1, b1, false, false); \
    u32x4 w = {r0[0], r1[0], r0[1], r1[1]}; OUT = __builtin_bit_cast(bf16x8, w); } while (0)
#define AT_STEP(C0, C1, N0, N1, j) do { \
    if (!(VAR & 16) && (j) + AT_PF < NT) AT_DMA((j) + AT_PF, (AT_PF == 3 ? b4 : b3)); \
    AT_SBAR(); if (!(VAR & 2) && late && (j) > 0) pv_d0(o, vrd + b0, pa0, pa1, pa2, pa3); AT_SBAR(); \
    if (!(VAR & 4) && (j) + 1 < NT) AT_QKT(N0, N1, b2); AT_SBAR(); \
    AT_SOFT(C0, C1); AT_SBAR(); \
    if (!(VAR & 2) && !late) pv_d0(o, vrd + b1, pa0, pa1, pa2, pa3); \
    if (VAR & 32) asm volatile("s_waitcnt lgkmcnt(0)\n\ts_barrier" ::: "memory"); else if (AT_PF == 3 && (j) + 3 < NT) AT_WAIT_BAR(3); else AT_WAIT_BAR(0); \
    { const int t_ = b0; b0 = b1; b1 = b2; b2 = b3; b3 = b4; b4 = t_; } } while (0)

    const bool late = AT_STAGGER && wid >= 4;
    int b0 = 4 * BUF_BYTES, b1 = 0, b2 = BUF_BYTES, b3 = 2 * BUF_BYTES, b4 = 3 * BUF_BYTES;
    AT_QKT(sA0, sA1, b1);
    for (int j = 0; j < NT; j += 2) {
      AT_STEP(sA0, sA1, sB0, sB1, j);
      AT_STEP(sB0, sB1, sA0, sA1, j + 1);
    }
    if (late) pv_d0(o, vrd + b0, pa0, pa1, pa2, pa3);
#undef AT_STEP
#undef AT_PK4
#undef AT_SOFT
#undef AT_QKT
#undef AT_QKT_D
#undef AT_DMA
    { auto rr = __builtin_amdgcn_permlane32_swap(__float_as_uint(l_reg), __float_as_uint(l_reg), false, false); l_reg = __uint_as_float(rr[0]) + __uint_as_float(rr[1]); }
    if (hi == 0) li_l[r32] = l_reg; asm volatile("s_waitcnt lgkmcnt(0)" ::: "memory");
    int r32e = r32, hie = hi; asm volatile("" : "+v"(r32e), "+v"(hie));
    const unsigned ebase = (unsigned)((q0 + wid * QBLK + 4 * hie) * 1024 + h * 128 + r32e);
    if (mp == 0) {
#pragma unroll
      for (int r = 0; r < 16; ++r) { float* op = A.AO1 + (ebase + (unsigned)(((r & 3) + 8 * (r >> 2)) * 1024)); const float rl = __builtin_amdgcn_rcpf(li_l[crow(r, hi)]);
#pragma unroll
        for (int d0 = 0; d0 < 4; ++d0) op[d0 * 32] = o[d0][r] * rl;
        if ((r & 3) == 3) asm volatile("" ::: "memory"); }
    } else {
      float sg[4];
#pragma unroll
      for (int d0 = 0; d0 < 4; ++d0) sg[d0] = A.subg[d0 * 32 + r32e] * A.outscale;
#pragma unroll
      for (int r = 0; r < 16; ++r) { const unsigned eo = ebase + (unsigned)(((r & 3) + 8 * (r >> 2)) * 1024); const float* ip = A.AO1 + eo; const float rl = __builtin_amdgcn_rcpf(li_l[crow(r, hi)]) * A.lam;
        float v[4]; float ss = 0.f;
#pragma unroll
        for (int d0 = 0; d0 < 4; ++d0) { v[d0] = ip[d0 * 32] - o[d0][r] * rl; ss += v[d0] * v[d0]; }
#pragma unroll
        for (int off = 1; off < 32; off <<= 1) ss += shx(ss, off, lane);
        const float rs = rsqrtf(ss * (1.0f / 128.0f) + 1e-6f);
        bf16* mp_ = A.MIX + (eo + (eo & ~1023u));
#pragma unroll
        for (int d0 = 0; d0 < 4; ++d0) mp_[d0 * 32] = (bf16)(pg8::cvt_pk_bf16(v[d0] * rs * sg[d0], 0.f) & 0xffffu);
        if ((r & 3) == 3) asm volatile("" ::: "memory"); }
    }
  }
}
#undef AT_SBAR
}

namespace att {
#define A2_SBAR() __builtin_amdgcn_sched_barrier(0)
#ifndef A2_NVF
#define A2_NVF 6
#endif
#ifndef A2_PRIO
#define A2_PRIO 1
#endif
__device__ __forceinline__ void glds3(const void* kbase, unsigned kvo, unsigned kdst, const void* vbase, unsigned vo0, unsigned vo1, unsigned vdst) { unsigned keep;
  asm volatile("s_mov_b32 %0, m0\n\ts_mov_b32 m0, %3\n\ts_nop 4\n\tglobal_load_lds_dwordx4 %1, %2\n\t"
               "s_mov_b32 m0, %7\n\ts_nop 0\n\tglobal_load_lds_dwordx4 %4, %6\n\t"
               "s_add_u32 m0, %7, 0x400\n\ts_nop 0\n\tglobal_load_lds_dwordx4 %5, %6\n\ts_mov_b32 m0, %0"
               : "=&s"(keep) : "v"(kvo), "s"(kbase), "s"(kdst), "v"(vo0), "v"(vo1), "s"(vbase), "s"(vdst) : "memory", "scc"); }
typedef short v4i16_t __attribute__((ext_vector_type(4)));
__device__ __forceinline__ s16x4 vtr(const AT_LAS char* p) { return __builtin_bit_cast(s16x4, __builtin_amdgcn_ds_read_tr16_b64_v4i16((AT_LAS v4i16_t*)p)); }
constexpr int A2_KB = SHM_K, A2_VB = SHM_V, A2_OFF_V = 2 * A2_KB, A2_OFF_WS = A2_OFF_V + 2 * A2_VB, A2_LDS_BYTES = A2_OFF_WS + NW * 64 * 4;
struct NoMid { __device__ __forceinline__ void operator()() const {} };
template <int VAR = 0, class Mid = NoMid>
__device__ __forceinline__ void attn_unit2(const AttnArgs& A, int h, int qt, AT_LAS char* lds, const int tid, const Mid& mid = Mid()) {
  const int q0 = qt * 256;
  const unsigned lds0 = (unsigned)(uintptr_t)lds;
  constexpr int NT = SEQ / KVBLK;
  constexpr size_t TS = (size_t)KVBLK * LDQ;
#pragma unroll 1
  for (int mp = 0; mp < 2; ++mp) {
    if (mp == 1) mid();
    int tl = tid; asm volatile("" : "+v"(tl));
    const int lane = tl & 63, r32 = lane & 31, hi = lane >> 5; const int wid = __builtin_amdgcn_readfirstlane(tl >> 6);
    AT_LAS float* li_l = (AT_LAS float*)(lds + A2_OFF_WS) + wid * 64;
    int koff, voff0, voff1;
    { const int row = 8 * wid + (lane >> 3), cpos = lane & 7; koff = row * LDQ + 8 * (cpos ^ ((row >> 1) & 7)); }
    { const int row = 8 * (2 * wid) + (lane >> 3), cpos = lane & 7; voff0 = row * SEQ + 8 * (cpos ^ ((row >> 1) & 7)); }
    { const int row = 8 * (2 * wid + 1) + (lane >> 3), cpos = lane & 7; voff1 = row * SEQ + 8 * (cpos ^ ((row >> 1) & 7)); }
    const unsigned kob = (unsigned)koff * 2u, vob0 = (unsigned)voff0 * 2u, vob1 = (unsigned)voff1 * 2u;
    const unsigned kdst = lds0 + wid * 1024, vdst = lds0 + A2_OFF_V + wid * 2048;
    const bf16* Vh = A.VT + (size_t)h * 128 * SEQ;
    const bf16* Kh = A.K + (h * 2 + mp) * 64;
    const bf16* Qw = A.Q + (size_t)(q0 + wid * QBLK + r32) * LDQ + (h * 2 + mp) * 64 + hi * 8;
    const AT_LAS char* ksl = lds + r32 * 128;
    const int kswz = ((r32 >> 1) & 7) << 4;
    const AT_LAS char* vsl = lds + A2_OFF_V + r32 * 128;
#define A2_DMAK(t, s) glds16s(Kh + (size_t)(t) * TS, kob, (unsigned)__builtin_amdgcn_readfirstlane(kdst + (s) * A2_KB))
#define A2_DMAV(t, s) do { glds16s(Vh + (size_t)(t) * KVBLK, vob0, (unsigned)__builtin_amdgcn_readfirstlane(vdst + (s) * A2_VB)); glds16s(Vh + (size_t)(t) * KVBLK, vob1, (unsigned)__builtin_amdgcn_readfirstlane(vdst + (s) * A2_VB + 1024u)); } while (0)
#define A2_KRD(g, s) (*(const AT_LAS bf16x8*)(ksl + (s) * A2_KB + ((g) & 1) * 4096 + ((((g) >> 1) * 32 + hi * 16) ^ kswz)))
#define A2_VRD(m, s) do { vf[(m) % A2_NVF] = *(const AT_LAS bf16x8*)(vsl + (s) * A2_VB + ((m) & 3) * 4096 + ((((m) >> 2) * 32 + hi * 16) ^ kswz)); } while (0)
#define A2_VFR(m) vf[(m) % A2_NVF]
    __syncthreads();
    A2_DMAK(0, 0); A2_DMAK(1, 1);
    bf16x8 qr[4];
#pragma unroll
    for (int d0 = 0; d0 < 4; ++d0) qr[d0] = *(const __attribute__((address_space(1))) bf16x8*)(Qw + d0 * 16);
    float qss = 0.f;
#pragma unroll
    for (int d0 = 0; d0 < 4; ++d0)
#pragma unroll
      for (int e = 0; e < 8; ++e) { const float v = __uint_as_float(((unsigned)(unsigned short)qr[d0][e]) << 16); qss += v * v; }
    { auto rr = __builtin_amdgcn_permlane32_swap(__float_as_uint(qss), __float_as_uint(qss), false, false); qss = __uint_as_float(rr[0]) + __uint_as_float(rr[1]); }
    const float mref = sqrtf(qss) * A.kmax[h * 2 + mp] * 1.01f + 0.25f;
    f32x16 negm;
#pragma unroll
    for (int r = 0; r < 16; ++r) negm[r] = -mref;
    float l_reg = 0.f; f32x16 o[4]; o[0] = f32x16{}; o[1] = f32x16{}; o[2] = f32x16{}; o[3] = f32x16{};
    f32x16 cA0, cA1, cB0, cB1; bf16x8 pa[4]; bf16x8 kf[8]; bf16x8 vf[A2_NVF];
    if (VAR) { cA0 = negm; cA1 = negm; cB0 = negm; cB1 = negm; _Pragma("unroll") for (int i_ = 0; i_ < 4; ++i_) { pa[i_] = qr[i_]; vf[i_] = qr[i_]; } }
    AT_WAIT_BAR(0);
#pragma unroll
    for (int g = 0; g < 8; ++g) kf[g] = A2_KRD(g, 0);
    asm volatile("s_waitcnt lgkmcnt(0)\n\ts_barrier" ::: "memory");
#define A2_GA(g, N0, N1, P0, P1, DOQK, DOPREV, VS) do { \
    if ((DOQK) && !(VAR & 8)) { if ((g) & 1) N1 = __builtin_amdgcn_mfma_f32_32x32x16_bf16(kf[g], qr[(g) >> 1], (g) < 2 ? negm : N1, 0, 0, 0); \
                else         N0 = __builtin_amdgcn_mfma_f32_32x32x16_bf16(kf[g], qr[(g) >> 1], (g) < 2 ? negm : N0, 0, 0, 0); } \
    if ((DOPREV) && !(VAR & 128)) { \
        \
      if (((g) & 1) == 0) { pk0 = (g) < 4 ? cvtpk(P0[((g) & 2) * 4 + 0], P0[((g) & 2) * 4 + 1]) : cvtpk(P1[((g) & 2) * 4 + 0], P1[((g) & 2) * 4 + 1]); \
                            pk1 = (g) < 4 ? cvtpk(P0[((g) & 2) * 4 + 2], P0[((g) & 2) * 4 + 3]) : cvtpk(P1[((g) & 2) * 4 + 2], P1[((g) & 2) * 4 + 3]); } \
      else { const unsigned a1_ = (g) < 4 ? cvtpk(P0[((g) & 2) * 4 + 4], P0[((g) & 2) * 4 + 5]) : cvtpk(P1[((g) & 2) * 4 + 4], P1[((g) & 2) * 4 + 5]); \
             const unsigned b1_ = (g) < 4 ? cvtpk(P0[((g) & 2) * 4 + 6], P0[((g) & 2) * 4 + 7]) : cvtpk(P1[((g) & 2) * 4 + 6], P1[((g) & 2) * 4 + 7]); \
             const u32x4 w_ = {pk0, pk1, a1_, b1_}; pa[(g) >> 1] = __builtin_bit_cast(bf16x8, w_); } \
      } if ((DOPREV) && !(VAR & 4) && (g) >= 8 - A2_NVF) { A2_VRD((g) - (8 - A2_NVF), VS); } \
    A2_SBAR(); } while (0)
#define A2_GB(m, N0, N1, DOPREV, DOEXP, DOK, VS, KS) do { \
    if (DOPREV) { if (!(VAR & 2)) o[(m) & 3] = __builtin_amdgcn_mfma_f32_32x32x16_bf16(pa[(m) >> 2], A2_VFR(m), o[(m) & 3], 0, 0, 0); if (!(VAR & 4) && (m) + A2_NVF < 16) A2_VRD((m) + A2_NVF, VS); } \
    if ((DOEXP) && !(VAR & 1)) { if ((m) < 8) { N0[2 * (m)] = __builtin_amdgcn_exp2f(N0[2 * (m)]); N0[2 * (m) + 1] = __builtin_amdgcn_exp2f(N0[2 * (m) + 1]); l_reg += N0[2 * (m)]; l_reg += N0[2 * (m) + 1]; } \
                 else { N1[2 * (m) - 16] = __builtin_amdgcn_exp2f(N1[2 * (m) - 16]); N1[2 * (m) - 15] = __builtin_amdgcn_exp2f(N1[2 * (m) - 15]); l_reg += N1[2 * (m) - 16]; l_reg += N1[2 * (m) - 15]; } } \
    if ((DOK) && !(VAR & 64) && (m) >= 4 && (m) < 12) kf[(m) - 4] = A2_KRD((m) - 4, KS); \
    A2_SBAR(); } while (0)
#define A2_STEP(t, PAR, N0, N1, P0, P1, DOQK, DOPREV, DOEXP) do { unsigned pk0 = 0u, pk1 = 0u; \
    A2_GA(0, N0, N1, P0, P1, DOQK, DOPREV, (PAR) ^ 1); A2_GA(1, N0, N1, P0, P1, DOQK, DOPREV, (PAR) ^ 1); A2_GA(2, N0, N1, P0, P1, DOQK, DOPREV, (PAR) ^ 1); A2_GA(3, N0, N1, P0, P1, DOQK, DOPREV, (PAR) ^ 1); \
    A2_GA(4, N0, N1, P0, P1, DOQK, DOPREV, (PAR) ^ 1); A2_GA(5, N0, N1, P0, P1, DOQK, DOPREV, (PAR) ^ 1); A2_GA(6, N0, N1, P0, P1, DOQK, DOPREV, (PAR) ^ 1); A2_GA(7, N0, N1, P0, P1, DOQK, DOPREV, (PAR) ^ 1); \
    if (!(VAR & 16)) { if ((t) + 2 < NT) glds3(Kh + (size_t)((t) + 2) * TS, kob, (unsigned)__builtin_amdgcn_readfirstlane(kdst + (PAR) * A2_KB), Vh + (size_t)(t) * KVBLK, vob0, vob1, (unsigned)__builtin_amdgcn_readfirstlane(vdst + (PAR) * A2_VB)); \
                       else if ((t) < NT) A2_DMAV((t), PAR); } A2_SBAR(); \
    const bool dok_ = (t) + 1 < NT; \
    A2_GB(0, N0, N1, DOPREV, DOEXP, dok_, (PAR) ^ 1, (PAR) ^ 1); A2_GB(1, N0, N1, DOPREV, DOEXP, dok_, (PAR) ^ 1, (PAR) ^ 1); A2_GB(2, N0, N1, DOPREV, DOEXP, dok_, (PAR) ^ 1, (PAR) ^ 1); A2_GB(3, N0, N1, DOPREV, DOEXP, dok_, (PAR) ^ 1, (PAR) ^ 1); \
    A2_GB(4, N0, N1, DOPREV, DOEXP, dok_, (PAR) ^ 1, (PAR) ^ 1); A2_GB(5, N0, N1, DOPREV, DOEXP, dok_, (PAR) ^ 1, (PAR) ^ 1); A2_GB(6, N0, N1, DOPREV, DOEXP, dok_, (PAR) ^ 1, (PAR) ^ 1); A2_GB(7, N0, N1, DOPREV, DOEXP, dok_, (PAR) ^ 1, (PAR) ^ 1); \
    A2_GB(8, N0, N1, DOPREV, DOEXP, dok_, (PAR) ^ 1, (PAR) ^ 1); A2_GB(9, N0, N1, DOPREV, DOEXP, dok_, (PAR) ^ 1, (PAR) ^ 1); A2_GB(10, N0, N1, DOPREV, DOEXP, dok_, (PAR) ^ 1, (PAR) ^ 1); A2_GB(11, N0, N1, DOPREV, DOEXP, dok_, (PAR) ^ 1, (PAR) ^ 1); \
    A2_GB(12, N0, N1, DOPREV, DOEXP, dok_, (PAR) ^ 1, (PAR) ^ 1); A2_GB(13, N0, N1, DOPREV, DOEXP, dok_, (PAR) ^ 1, (PAR) ^ 1); A2_GB(14, N0, N1, DOPREV, DOEXP, dok_, (PAR) ^ 1, (PAR) ^ 1); A2_GB(15, N0, N1, DOPREV, DOEXP, dok_, (PAR) ^ 1, (PAR) ^ 1); \
    if (VAR & 32) asm volatile("s_waitcnt lgkmcnt(0)" ::: "memory"); else AT_WAIT_BAR(0); } while (0)
    if (A2_PRIO && wid >= 4) __builtin_amdgcn_s_setprio(1);
    A2_STEP(0, 0, cA0, cA1, cB0, cB1, true, false, true);
    for (int t = 1; t + 1 < NT; t += 2) {
      A2_STEP(t, 1, cB0, cB1, cA0, cA1, true, true, true);
      A2_STEP(t + 1, 0, cA0, cA1, cB0, cB1, true, true, true);
    }
    A2_STEP(NT - 1, 1, cB0, cB1, cA0, cA1, true, true, true);
    A2_STEP(NT, 0, cA0, cA1, cB0, cB1, false, true, false);
    if (A2_PRIO) __builtin_amdgcn_s_setprio(0);
#undef A2_STEP
#undef A2_GB
#undef A2_GA
#undef A2_VFR
#undef A2_VRD
#undef A2_KRD
#undef A2_DMAV
#undef A2_DMAK
    { auto rr = __builtin_amdgcn_permlane32_swap(__float_as_uint(l_reg), __float_as_uint(l_reg), false, false); l_reg = __uint_as_float(rr[0]) + __uint_as_float(rr[1]); }
    if (hi == 0) li_l[r32] = l_reg; asm volatile("s_waitcnt lgkmcnt(0)" ::: "memory");
    int r32e = r32, hie = hi; asm volatile("" : "+v"(r32e), "+v"(hie));
    const unsigned ebase = (unsigned)((q0 + wid * QBLK + 4 * hie) * 1024 + h * 128 + r32e);
    if (mp == 0) {
#pragma unroll
      for (int r = 0; r < 16; ++r) { __attribute__((address_space(1))) float* op = (__attribute__((address_space(1))) float*)A.AO1 + (ebase + (unsigned)(((r & 3) + 8 * (r >> 2)) * 1024)); const float rl = __builtin_amdgcn_rcpf(li_l[crow(r, hi)]);
#pragma unroll
        for (int d0 = 0; d0 < 4; ++d0) op[d0 * 32] = o[d0][r] * rl;
        if ((r & 3) == 3) asm volatile("" ::: "memory"); }
    } else {
      float sg[4];
#pragma unroll
      for (int d0 = 0; d0 < 4; ++d0) sg[d0] = A.subg[d0 * 32 + r32e] * A.outscale;
#pragma unroll
      for (int r = 0; r < 16; ++r) { const unsigned eo = ebase + (unsigned)(((r & 3) + 8 * (r >> 2)) * 1024); const __attribute__((address_space(1))) float* ip = (const __attribute__((address_space(1))) float*)A.AO1 + eo; const float rl = __builtin_amdgcn_rcpf(li_l[crow(r, hi)]) * A.lam;
        float v[4]; float ss = 0.f;
#pragma unroll
        for (int d0 = 0; d0 < 4; ++d0) { v[d0] = ip[d0 * 32] - o[d0][r] * rl; ss += v[d0] * v[d0]; }
#pragma unroll
        for (int off = 1; off < 32; off <<= 1) ss += shx(ss, off, lane);
        const float rs = rsqrtf(ss * (1.0f / 128.0f) + 1e-6f);
        __attribute__((address_space(1))) bf16* mp_ = (__attribute__((address_space(1))) bf16*)A.MIX + (eo + (eo & ~1023u));
#pragma unroll
        for (int d0 = 0; d0 < 4; ++d0) mp_[d0 * 32] = (bf16)(pg8::cvt_pk_bf16(v[d0] * rs * sg[d0], 0.f) & 0xffffu);
        if ((r & 3) == 3) asm volatile("" ::: "memory"); }
    }
  }
}
#undef A2_SBAR
}

namespace hg {
using bf16 = unsigned short;
using bf16x8 = __attribute__((ext_vector_type(8))) short;
using f32x16 = __attribute__((ext_vector_type(16))) float;
using u32x4  = __attribute__((ext_vector_type(4))) unsigned;
using u32x2  = __attribute__((ext_vector_type(2))) unsigned;
#define HG_LAS __attribute__((address_space(3)))
constexpr int P128 = 136, P64 = 72;
constexpr int L_QT = 0, L_KT = L_QT + 64 * P128 * 2, L_QB = L_KT + 64 * P128 * 2, L_KH = L_QB + 64 * P128 * 2, L_VT = L_KH + 128 * P64 * 2,
              L_ST = L_VT + 128 * P64 * 2, L_AM = L_ST + 128 * P128 * 2, L_EB = L_AM + 64 * P64 * 2, L_PS = L_EB + 512, L_SSQ = L_PS + 2048, LDS_BYTES = L_SSQ + 1024;
constexpr int SCT = 512, NSC = 32;
__device__ __forceinline__ int crow(int r, int hi) { return (r & 3) + 8 * (r >> 2) + 4 * hi; }
typedef float f32x2_t __attribute__((ext_vector_type(2))); typedef __bf16 bf16x2_t __attribute__((ext_vector_type(2)));
__device__ __forceinline__ unsigned cvtpk(float lo, float hi) { f32x2_t v = {lo, hi}; bf16x2_t b = __builtin_convertvector(v, bf16x2_t); return __builtin_bit_cast(unsigned, b); }
__device__ __forceinline__ float bf2f(unsigned short b) { return __uint_as_float((unsigned)b << 16); }
template <int CTRL> __device__ __forceinline__ float dppf(float v) { return __int_as_float(__builtin_amdgcn_update_dpp(0, __float_as_int(v), CTRL, 0xf, 0xf, true)); }
#define HG_EXP(x) ((VAR & 2) ? (x) : __expf(x))
#define HG_BAR() do { asm volatile("s_waitcnt lgkmcnt(0)" ::: "memory"); __builtin_amdgcn_s_barrier(); asm volatile("" ::: "memory"); } while (0)

struct HgArgs { const bf16* HQ; const bf16* KK; const unsigned short* LF; const bf16* HV; const bf16* HGt; float* HS; float* GS; float* HOF; bf16* MIX; const float* gn; };

template <bool OUT, int VAR = 0>
__device__ __forceinline__ void hgrn_unit(const HgArgs& A, int dir, int h, int sc, HG_LAS unsigned char* lds, const int tid) {
  const int lane = tid & 63, r32 = lane & 31, hi = lane >> 5; const int wid = __builtin_amdgcn_readfirstlane(tid >> 6);
  const int d = tid & 127, qt = tid >> 7;
  typedef __attribute__((address_space(1))) const unsigned short gcus; typedef __attribute__((address_space(1))) float gfl; typedef __attribute__((address_space(1))) unsigned short gus;
  gcus* gLF = (gcus*)A.LF; gcus* gKK = (gcus*)A.KK; gcus* gHV = (gcus*)A.HV; gcus* gHQ = (gcus*)A.HQ; gcus* gHG = (gcus*)A.HGt; gus* gHOF = (gus*)A.HOF;     gus* gMIX = (gus*)A.MIX; gfl* gHS = (gfl*)A.HS; gfl* gGS = (gfl*)A.GS;
  HG_LAS bf16* QT = (HG_LAS bf16*)(lds + L_QT); HG_LAS bf16* KT = (HG_LAS bf16*)(lds + L_KT); HG_LAS bf16* QB = (HG_LAS bf16*)(lds + L_QB);
  HG_LAS bf16* KH = (HG_LAS bf16*)(lds + L_KH); HG_LAS bf16* VT = (HG_LAS bf16*)(lds + L_VT); HG_LAS bf16* ST = (HG_LAS bf16*)(lds + L_ST);
  HG_LAS bf16* AM = (HG_LAS bf16*)(lds + L_AM); HG_LAS float* EB = (HG_LAS float*)(lds + L_EB); HG_LAS float* PS = (HG_LAS float*)(lds + L_PS);
  HG_LAS float* SSQ = (HG_LAS float*)(lds + L_SSQ);
  const int db = wid >> 1, eb0 = (wid & 1) * 2;
  const int jb = wid & 1, eb = wid >> 1;
  const size_t unit = (size_t)(dir * 8 + h) * NSC + sc;
  gfl* HSu = gHS + unit * 16384;
  f32x16 S0, S1;
  if (OUT) {
#pragma unroll
    for (int r = 0; r < 16; ++r) { const gfl* p = HSu + (32 * db + crow(r, hi)) * 128 + 32 * eb0 + r32; S0[r] = p[0]; S1[r] = p[32]; }
#pragma unroll
    for (int rg = 0; rg < 4; ++rg) { u32x2 w0, w1; w0.x = cvtpk(S0[4 * rg], S0[4 * rg + 1]); w0.y = cvtpk(S0[4 * rg + 2], S0[4 * rg + 3]); w1.x = cvtpk(S1[4 * rg], S1[4 * rg + 1]); w1.y = cvtpk(S1[4 * rg + 2], S1[4 * rg + 3]);
      *(HG_LAS u32x2*)(ST + (32 * eb0 + r32) * P128 + 32 * db + 8 * rg + 4 * hi) = w0; *(HG_LAS u32x2*)(ST + (32 * (eb0 + 1) + r32) * P128 + 32 * db + 8 * rg + 4 * hi) = w1; }
  } else { S0 = f32x16{}; S1 = f32x16{}; }
  float gtot = 0.f;
  const float gnv = (OUT && dir != 0) ? ((__attribute__((address_space(1))) const float*)A.gn)[32 * eb + r32] : 0.f;
  const int cofs = h * 128 + d;
  unsigned short rl[16]; unsigned short kkv[16], qv[16], vv[16];
#define HG_LOAD(cc) do { _Pragma("unroll") for (int jj = 0; jj < 16; ++jj) { const int p = (cc) * 64 + qt * 16 + jj; const size_t tok = (size_t)(dir ? sc * SCT + (SCT - 1) - p : sc * SCT + p); \
      rl[jj] = gLF[tok * 2048 + dir * 1024 + cofs]; kkv[jj] = gKK[tok * 2048 + dir * 1024 + cofs]; vv[jj] = gHV[tok * 1024 + cofs]; \
      if (OUT) qv[jj] = gHQ[tok * 1024 + cofs]; } } while (0)
  HG_LOAD(0);
#pragma unroll 1
  for (int c = 0; c < 8; ++c) {
    float lf[16]; unsigned short hofv[16]; unsigned short hgv[16];
    float run = 0.f;
#pragma unroll
    for (int jj = 0; jj < 16; ++jj) { run += (float)__builtin_bit_cast(_Float16, rl[jj]); lf[jj] = run; }
    PS[qt * 128 + d] = run;
    HG_BAR();
    const float p0 = PS[d], p1 = PS[128 + d], p2 = PS[256 + d], p3 = PS[384 + d];
    const float off = qt == 0 ? 0.f : qt == 1 ? p0 : qt == 2 ? p0 + p1 : p0 + p1 + p2;
    const float b63 = (p0 + p1) + (p2 + p3), rmid = p0 + p1;
    gtot += b63;
    if (qt == 0) EB[d] = HG_EXP(b63);
    unsigned kh[8];
#pragma unroll
    for (int jj = 0; jj < 16; jj += 2) {
      const float b0 = off + lf[jj], b1 = off + lf[jj + 1]; const float k0 = bf2f(kkv[jj]), k1 = bf2f(kkv[jj + 1]);
      kh[jj >> 1] = cvtpk(k0 * HG_EXP(b63 - b0), k1 * HG_EXP(b63 - b1));
      if (OUT) { const float q0 = bf2f(qv[jj]), q1 = bf2f(qv[jj + 1]);
        const unsigned qt_ = cvtpk(q0 * HG_EXP(b0 - rmid), q1 * HG_EXP(b1 - rmid)), kt_ = cvtpk(k0 * HG_EXP(rmid - b0), k1 * HG_EXP(rmid - b1)), qb_ = cvtpk(q0 * HG_EXP(b0), q1 * HG_EXP(b1));
        const int j0 = qt * 16 + jj;
        if (!(VAR & 1)) {
          const unsigned xq = (unsigned)__builtin_amdgcn_update_dpp(0, (int)qt_, 0xB1, 0xf, 0xf, true), xk = (unsigned)__builtin_amdgcn_update_dpp(0, (int)kt_, 0xB1, 0xf, 0xf, true), xb = (unsigned)__builtin_amdgcn_update_dpp(0, (int)qb_, 0xB1, 0xf, 0xf, true);
          const bool odd = d & 1; const int wofs = (odd ? (j0 + 1) * P128 + d - 1 : j0 * P128 + d);
          *(HG_LAS unsigned*)(QT + wofs) = odd ? ((xq >> 16) | (qt_ & 0xffff0000u)) : ((qt_ & 0xffffu) | (xq << 16));
          *(HG_LAS unsigned*)(KT + wofs) = odd ? ((xk >> 16) | (kt_ & 0xffff0000u)) : ((kt_ & 0xffffu) | (xk << 16));
          *(HG_LAS unsigned*)(QB + wofs) = odd ? ((xb >> 16) | (qb_ & 0xffff0000u)) : ((qb_ & 0xffffu) | (xb << 16)); } }
    }
    *(HG_LAS u32x4*)(KH + d * P64 + qt * 16) = (u32x4){kh[0], kh[1], kh[2], kh[3]}; *(HG_LAS u32x4*)(KH + d * P64 + qt * 16 + 8) = (u32x4){kh[4], kh[5], kh[6], kh[7]};
    { u32x4 w0, w1;
      w0.x = (unsigned)vv[0] | ((unsigned)vv[1] << 16); w0.y = (unsigned)vv[2] | ((unsigned)vv[3] << 16); w0.z = (unsigned)vv[4] | ((unsigned)vv[5] << 16); w0.w = (unsigned)vv[6] | ((unsigned)vv[7] << 16);
      w1.x = (unsigned)vv[8] | ((unsigned)vv[9] << 16); w1.y = (unsigned)vv[10] | ((unsigned)vv[11] << 16); w1.z = (unsigned)vv[12] | ((unsigned)vv[13] << 16); w1.w = (unsigned)vv[14] | ((unsigned)vv[15] << 16);
      *(HG_LAS u32x4*)(VT + d * P64 + qt * 16) = w0; *(HG_LAS u32x4*)(VT + d * P64 + qt * 16 + 8) = w1; }
    if (OUT && dir != 0) {
#pragma unroll
      for (int r = 0; r < 16; ++r) { const int p = c * 64 + 32 * jb + crow(r, hi); const size_t tok = (size_t)(sc * SCT + (SCT - 1) - p);
        hofv[r] = gHOF[tok * 1024 + h * 128 + 32 * eb + r32]; hgv[r] = gHG[tok * 1024 + h * 128 + 32 * eb + r32]; } }
    if (!(VAR & 16) && c + 1 < 8) HG_LOAD(c + 1);
    HG_BAR();
    f32x16 oacc = f32x16{};
    if (OUT) {
      if (!(VAR & 4)) {
#pragma unroll
      for (int ks = 0; ks < 8; ++ks) { const bf16x8 a = *(const HG_LAS bf16x8*)(QB + (32 * jb + r32) * P128 + 16 * ks + 8 * hi), b = *(const HG_LAS bf16x8*)(ST + (32 * eb + r32) * P128 + 16 * ks + 8 * hi);
        oacc = __builtin_amdgcn_mfma_f32_32x32x16_bf16(a, b, oacc, 0, 0, 0); }
      if (wid < 4) { const int jb2 = wid & 1, sb = wid >> 1;
        if (sb <= jb2) { f32x16 aacc = f32x16{};
#pragma unroll
          for (int ks = 0; ks < 8; ++ks) { const bf16x8 a = *(const HG_LAS bf16x8*)(QT + (32 * jb2 + r32) * P128 + 16 * ks + 8 * hi), b = *(const HG_LAS bf16x8*)(KT + (32 * sb + r32) * P128 + 16 * ks + 8 * hi);
            aacc = __builtin_amdgcn_mfma_f32_32x32x16_bf16(a, b, aacc, 0, 0, 0); }
#pragma unroll
          for (int r = 0; r < 16; ++r) { const int j = 32 * jb2 + crow(r, hi), s = 32 * sb + r32; AM[j * P64 + s] = (bf16)(cvtpk(s <= j ? aacc[r] : 0.f, 0.f) & 0xffffu); }
        } else {
#pragma unroll
          for (int r = 0; r < 16; ++r) AM[(32 * jb2 + crow(r, hi)) * P64 + 32 * sb + r32] = (bf16)0;
        }
      }
      }
      HG_BAR();
      if (!(VAR & 4))
#pragma unroll
      for (int ks = 0; ks < 4; ++ks) { const bf16x8 a = *(const HG_LAS bf16x8*)(AM + (32 * jb + r32) * P64 + 16 * ks + 8 * hi), b = *(const HG_LAS bf16x8*)(VT + (32 * eb + r32) * P64 + 16 * ks + 8 * hi);
        oacc = __builtin_amdgcn_mfma_f32_32x32x16_bf16(a, b, oacc, 0, 0, 0); }
    }
    if (!(VAR & 8)) {
#pragma unroll
    for (int r = 0; r < 16; ++r) { const float g = EB[32 * db + crow(r, hi)]; S0[r] *= g; S1[r] *= g; }
#pragma unroll
    for (int ks = 0; ks < 4; ++ks) { const bf16x8 a = *(const HG_LAS bf16x8*)(KH + (32 * db + r32) * P64 + 16 * ks + 8 * hi);
      const bf16x8 b0 = *(const HG_LAS bf16x8*)(VT + (32 * eb0 + r32) * P64 + 16 * ks + 8 * hi), b1 = *(const HG_LAS bf16x8*)(VT + (32 * (eb0 + 1) + r32) * P64 + 16 * ks + 8 * hi);
      S0 = __builtin_amdgcn_mfma_f32_32x32x16_bf16(a, b0, S0, 0, 0, 0); S1 = __builtin_amdgcn_mfma_f32_32x32x16_bf16(a, b1, S1, 0, 0, 0); }
    }
    if (OUT) {
      if (!(VAR & 8))
#pragma unroll
      for (int rg = 0; rg < 4; ++rg) { u32x2 w0, w1; w0.x = cvtpk(S0[4 * rg], S0[4 * rg + 1]); w0.y = cvtpk(S0[4 * rg + 2], S0[4 * rg + 3]); w1.x = cvtpk(S1[4 * rg], S1[4 * rg + 1]); w1.y = cvtpk(S1[4 * rg + 2], S1[4 * rg + 3]);
        *(HG_LAS u32x2*)(ST + (32 * eb0 + r32) * P128 + 32 * db + 8 * rg + 4 * hi) = w0; *(HG_LAS u32x2*)(ST + (32 * (eb0 + 1) + r32) * P128 + 32 * db + 8 * rg + 4 * hi) = w1; }
      const int ecol = h * 128 + 32 * eb + r32;
      if (VAR & 32) { if (oacc[0] == 123.456f) gHOF[ecol] = (bf16)1; }
      else if (dir == 0) {
#pragma unroll
        for (int r = 0; r < 16; ++r) { const int p = c * 64 + 32 * jb + crow(r, hi); gHOF[(size_t)(sc * SCT + p) * 1024 + ecol] = (bf16)(cvtpk(oacc[r], 0.f) & 0xffffu); }
      } else {
        float tot[16];
#pragma unroll
        for (int r = 0; r < 16; ++r) { const int p = c * 64 + 32 * jb + crow(r, hi); const size_t tok = (size_t)(sc * SCT + (SCT - 1) - p);
          tot[r] = oacc[r] + bf2f(hofv[r]); float ss = tot[r] * tot[r];
          ss += dppf<0xB1>(ss); ss += dppf<0x4E>(ss); ss += dppf<0x141>(ss); ss += dppf<0x140>(ss);
          ss += shx(ss, 16, lane);
          if (r32 == 0) SSQ[(32 * jb + crow(r, hi)) * 4 + eb] = ss; }
        HG_BAR();
#pragma unroll
        for (int r = 0; r < 16; ++r) { const int j = 32 * jb + crow(r, hi); const int p = c * 64 + j; const size_t tok = (size_t)(sc * SCT + (SCT - 1) - p);
          const float ssum = (SSQ[j * 4] + SSQ[j * 4 + 1]) + (SSQ[j * 4 + 2] + SSQ[j * 4 + 3]);
          const float rs = rsqrtf(ssum * (1.0f / 128.0f) + 1e-6f);
          const float g = bf2f(hgv[r]);
          gMIX[tok * 2048 + 1024 + ecol] = (bf16)(cvtpk(tot[r] * rs * gnv * g, 0.f) & 0xffffu); }
      }
    }
  }
  if (!OUT) {
#pragma unroll
    for (int r = 0; r < 16; ++r) { gfl* p = HSu + (32 * db + crow(r, hi)) * 128 + 32 * eb0 + r32; p[0] = S0[r]; p[32] = S1[r]; }
    if (qt == 0) gGS[unit * 128 + d] = gtot;
  }
  HG_BAR();
}

__device__ __forceinline__ void hgrn_scan(float* HS, const float* GS, int gtid, int nthr) {
  for (int p = gtid; p < 16 * 16384; p += nthr) { const int dh = p >> 14, idx = p & 16383, dd = idx >> 7, dir = dh >> 3;
    float* base = HS + (size_t)dh * NSC * 16384 + idx; const float* g = GS + dh * NSC * 128 + dd;
    float v[NSC], ge[NSC];
#pragma unroll
    for (int k = 0; k < NSC; ++k) { const int s = dir ? NSC - 1 - k : k; v[k] = base[(size_t)s * 16384]; ge[k] = g[s * 128]; }
    float carry = 0.f;
#pragma unroll
    for (int k = 0; k < NSC; ++k) { const int s = dir ? NSC - 1 - k : k; base[(size_t)s * 16384] = carry; carry = __expf(ge[k]) * carry + v[k]; }
  }
}
#undef HG_BAR
#undef HG_LOAD
}

constexpr int NWAVES = 8;
#ifndef MK_PER_PHASE
#define MK_PER_PHASE 0
#endif
#ifndef CVT_HOST
#define CVT_HOST 1
#endif
constexpr int T = 16384, DM = 2048, NL = 4, INC = 8192, NE = 16, CAP = 2048, FF = 1024, XR = NE * CAP;
constexpr float EPS = 1e-6f;
constexpr float QSCALE = 0.125f * 1.4426950408889634f;
constexpr size_t MiB = 1u << 20;
constexpr size_t WS_CTL = 0, CTL_ZERO_BYTES = 32 * 1024;
constexpr size_t WS_ROPE = 1 * MiB, WS_LBS = 5 * MiB, WS_AFF = 6 * MiB, WS_SLOT = 7 * MiB, WS_IDX = 8 * MiB, WS_GATE = 8 * MiB + 512 * 1024, WS_GS = 9 * MiB, WS_PAR = 10 * MiB;
constexpr int PAR_N1 = 0, PAR_N2 = PAR_N1 + NL * DM, PAR_FG = PAR_N2 + NL * DM, PAR_DLAM = PAR_FG + DM, PAR_SUBG = PAR_DLAM + NL * 256, PAR_HGN = PAR_SUBG + NL * 128, PAR_RW = PAR_HGN + NL * 128, PAR_END = PAR_RW + NL * DM * NE;
constexpr size_t WS_WIN = 16 * MiB, WS_WOUT = 144 * MiB, WS_WGU = 176 * MiB, WS_WDN = 688 * MiB;
constexpr size_t WS_X = 944 * MiB, WS_MIX = 1264 * MiB;
constexpr int RW_PITCH = 2056, RW_IMG = 2 * NE * RW_PITCH * 2;
constexpr size_t WS_RWS = 12 * MiB;
constexpr size_t WS_RS1 = 11 * MiB, WS_RS2 = 11 * MiB + 64 * 1024, WS_RSG = 11 * MiB + 128 * 1024;
constexpr size_t WS_Q = 1328 * MiB, WS_K = 1360 * MiB, WS_V = 1392 * MiB, WS_HQ = 1424 * MiB, WS_LF = 1456 * MiB, WS_KK = 1584 * MiB, WS_HV = 1648 * MiB, WS_HG = 1680 * MiB,
                 WS_AO1 = 1712 * MiB, WS_HS = 1776 * MiB, WS_HOF = 1808 * MiB;
constexpr size_t WS_VT = 1072 * MiB;
constexpr size_t WS_XG = 1328 * MiB, WS_HM = 1456 * MiB, WS_Y = 1520 * MiB;
constexpr size_t WS_END = 1872 * MiB;
constexpr int CW_BAR = 4096, CW_KMAX = 2048;
constexpr int RING_BYTES = 131072, LDS_BYTES = 147456, MISC_OFF = LDS_BYTES - 512;
static_assert(hg::LDS_BYTES <= MISC_OFF && att::LDS_BYTES2 <= RING_BYTES, "LDS map");

#define GAS __attribute__((address_space(1)))
#define LAS __attribute__((address_space(3)))
typedef unsigned short bf16;
typedef unsigned v4u __attribute__((ext_vector_type(4)));
typedef unsigned v2u __attribute__((ext_vector_type(2)));
typedef float f32x4 __attribute__((ext_vector_type(4)));
typedef GAS unsigned gu32;
#define RLX_AGENT __ATOMIC_RELAXED, __HIP_MEMORY_SCOPE_AGENT
#define LDS_WAIT() asm volatile("s_waitcnt lgkmcnt(0)" ::: "memory")
#define VM_WAIT() asm volatile("s_waitcnt vmcnt(0)" ::: "memory")
__device__ __forceinline__ unsigned pk2(float lo, float hi) { return pg8::cvt_pk_bf16(lo, hi); }
__device__ __forceinline__ float bf2f(unsigned short b) { return __uint_as_float((unsigned)b << 16); }

#define XB_TMO      128
#define XB_XCNT(j)  (256  + 64 * (j))
#define XB_XSUB(j)  (1280 + 64 * (j))
#define XB_XGEN(j)  (2304 + 64 * (j))
#define XB_TOP      3328
#define XB_TOPGEN   3392
#define XCD_BAR_WORDS 3456
#define XB_SPIN_CAP (1u << 18)

__device__ __forceinline__ unsigned xb_ld(unsigned* p)              { return __hip_atomic_load(p, __ATOMIC_RELAXED, __HIP_MEMORY_SCOPE_AGENT); }
__device__ __forceinline__ unsigned xb_add(unsigned* p, unsigned v) { return __hip_atomic_fetch_add(p, v, __ATOMIC_RELAXED, __HIP_MEMORY_SCOPE_AGENT); }
__device__ __forceinline__ unsigned xb_xcc_id() { return (unsigned)__builtin_amdgcn_s_getreg((3 << 11) | 20) & 0xFu; }
#define XB_SPIN(cond, bar) do { unsigned _sp = 0; while (cond) { __builtin_amdgcn_s_sleep(1); \
    if ((++_sp & 255u) == 0u) { if (xb_ld(&(bar)[XB_TMO])) break; if (_sp > XB_SPIN_CAP) { atomicAdd(&(bar)[XB_TMO], 1u); break; } } } } while (0)

__device__ __forceinline__ unsigned xb_lane() { unsigned z = 0u; asm volatile("" : "+s"(z)); return __builtin_amdgcn_mbcnt_hi(~0u, __builtin_amdgcn_mbcnt_lo(~0u, z)); }
struct XcdBarrier {
    int wv;
    unsigned* bar; unsigned x;
    volatile LAS unsigned* st;
};

__device__ __forceinline__ XcdBarrier xcd_barrier_post(unsigned* bar, volatile LAS unsigned* st, int wv) {
    XcdBarrier b; b.bar = bar; b.x = xb_xcc_id(); b.st = st; b.wv = wv;
    if (wv == 0 && xb_lane() == 0u) (void)xb_add(&bar[XB_XCNT(b.x)], 1u);
    return b;
}
__device__ __forceinline__ void xcd_barrier_complete(unsigned* bar, unsigned x, unsigned& nloc, unsigned& nx) {
    const unsigned G = gridDim.x * gridDim.y * gridDim.z;
    unsigned sum, cnt, mine, sp = 0u;
    for (;;) {
        sum = 0u; cnt = 0u; mine = 0u;
#pragma unroll
        for (unsigned j = 0; j < 16; ++j) { const unsigned c = xb_ld(&bar[XB_XCNT(j)]); sum += c; cnt += (c > 0u) ? 1u : 0u; mine = (j == x) ? c : mine; }
        if (sum == G) break;
        __builtin_amdgcn_s_sleep(1);
        if ((++sp & 255u) == 0u) { if (xb_ld(&bar[XB_TMO])) break; if (sp > XB_SPIN_CAP) { atomicAdd(&bar[XB_TMO], 1u); break; } }
    }
    nloc = mine > 0u ? mine : 1u; nx = cnt > 0u ? cnt : 1u;
}

__device__ __forceinline__ void xcd_barrier(const XcdBarrier& b) {
    asm volatile("s_waitcnt vmcnt(0)" ::: "memory");
    __syncthreads();
    if (b.wv == 0 && xb_lane() == 0u) {
        unsigned* bar = b.bar; unsigned bx = b.x; asm volatile("" : "+s"(bar), "+s"(bx));
        __builtin_amdgcn_s_waitcnt(0);
        unsigned nloc = b.st[0], nx = b.st[1];
        if (nloc == 0u) { xcd_barrier_complete(bar, bx, nloc, nx); b.st[0] = nloc; b.st[1] = nx; }
        const unsigned old = xb_add(&bar[XB_XSUB(bx)], 1u);
        const unsigned gen = old / nloc;
        if (old + 1u == (gen + 1u) * nloc) {
            __builtin_amdgcn_fence(__ATOMIC_RELEASE, "agent");
            asm volatile("s_waitcnt vmcnt(0)" ::: "memory");
            const unsigned og = xb_add(&bar[XB_TOP], 1u);
            const unsigned tg = og / nx;
            if (og + 1u == (tg + 1u) * nx) xb_add(&bar[XB_TOPGEN], 1u);
            else XB_SPIN(xb_ld(&bar[XB_TOPGEN]) == tg, bar);
            __builtin_amdgcn_fence(__ATOMIC_ACQUIRE, "agent");
            xb_add(&bar[XB_XGEN(bx)], 1u);
            asm volatile("s_waitcnt vmcnt(0)" ::: "memory");
        } else {
            XB_SPIN(xb_ld(&bar[XB_XGEN(bx)]) == gen, bar);
            __builtin_amdgcn_fence(__ATOMIC_ACQUIRE, "agent");
            asm volatile("s_waitcnt vmcnt(0)" ::: "memory");
        }
    }
    __syncthreads();
}


struct Args {
    const float* x; const int* pos; const float* norm1_g; const float* w_in; const float* dlam; const float* subg; const float* lblog; const float* hgn;
    const float* w_out; const float* norm2_g; const float* router_w; const float* w_gate; const float* w_up; const float* w_down; const float* final_g;
    float* out; unsigned char* ws; int ph_lo, ph_hi;
};
struct Frame { LAS unsigned char* lds; volatile LAS unsigned* MISC; int tid, lane, wave, vcu, G; };

__device__ __forceinline__ float wave_sum(float v, int lane) {
#pragma unroll
    for (int o = 1; o < 64; o <<= 1) v += shx(v, o, lane);
    return v;
}
__device__ __forceinline__ float wave_max(float v, int lane) {
#pragma unroll
    for (int o = 1; o < 64; o <<= 1) v = fmaxf(v, shx(v, o, lane));
    return v;
}
constexpr int I_IN = 32 * 256, I_OUT = 32 * 64, I_G = 32 * 32, I_D = 16 * 64, PER_LAYER = I_IN + I_OUT + 2 * NE * I_G + NE * I_D;
constexpr int CVT_LDS_OFF = 65536, CVT_SCR = 64 * 33 * 4;
#ifndef CVT_NS
#define CVT_NS 4
#endif
struct CvtItem { const float* src; bf16* dst; const float* gk; int N, K; };
struct CvtSrc { const float* w_in; const float* w_out; const float* w_gate; const float* w_up; const float* w_down; const float* norm1_g; const float* norm2_g; };
constexpr size_t WS_PTAB = 10 * MiB + 768 * 1024;
__device__ __forceinline__ size_t inproj_colmap(int n0);
__device__ __forceinline__ CvtItem cvt_item(const CvtSrc& a, unsigned char* ws, int l, int r) {
    CvtItem c;
    if (r < I_IN) { const int kb = r >> 8, nb = r & 255; c.N = INC; c.K = DM;
        c.src = a.w_in + (size_t)l * DM * INC + (size_t)(kb * 64) * INC + nb * 32; c.dst = (bf16*)(ws + WS_WIN) + (size_t)l * INC * DM + inproj_colmap(nb * 32) * DM + kb * 64; c.gk = a.norm1_g + l * DM + kb * 64; return c; }
    r -= I_IN;
    if (r < I_OUT) { const int kb = r >> 6, nb = r & 63; c.N = DM; c.K = DM;
        c.src = a.w_out + (size_t)l * DM * DM + (size_t)(kb * 64) * DM + nb * 32; c.dst = (bf16*)(ws + WS_WOUT) + (size_t)l * DM * DM + (size_t)(nb * 32) * DM + kb * 64; c.gk = nullptr; return c; }
    r -= I_OUT;
    if (r < 2 * NE * I_G) { const int up = r >= NE * I_G; if (up) r -= NE * I_G; const int le = l * NE + (r >> 10), i = r & 1023, kb = i >> 5, f0 = (i & 31) * 32; c.N = FF; c.K = DM;
        c.src = (up ? a.w_up : a.w_gate) + (size_t)le * DM * FF + (size_t)(kb * 64) * FF + f0; c.dst = (bf16*)(ws + WS_WGU) + (size_t)le * 2048 * DM + (size_t)((f0 >> 7) * 256 + up * 128 + (f0 & 127)) * DM + kb * 64;
        c.gk = a.norm2_g + l * DM + kb * 64; return c; }
    r -= 2 * NE * I_G;
    { const int le = l * NE + (r >> 10), i = r & 1023, kb = i >> 6, nb = i & 63; c.N = DM; c.K = FF;
        c.src = a.w_down + (size_t)le * FF * DM + (size_t)(kb * 64) * DM + nb * 32; c.dst = (bf16*)(ws + WS_WDN) + (size_t)le * DM * FF + (size_t)(nb * 32) * FF + kb * 64; c.gk = nullptr; }
    return c;
}
__device__ __forceinline__ void cvt_load(const CvtItem& c, float (&v)[32], f32x4& g0, f32x4& g1, int lane) {
#pragma unroll
    for (int i = 0; i < 32; ++i) v[i] = __builtin_nontemporal_load((const GAS float*)(c.src + (size_t)(2 * i) * c.N) + ((lane >> 5) * c.N + (lane & 31)));
    g0 = (f32x4){1.f, 1.f, 1.f, 1.f}; g1 = g0;
    if (c.gk) { g0 = *(const GAS f32x4*)(c.gk + 8 * (lane & 7)); g1 = *(const GAS f32x4*)(c.gk + 8 * (lane & 7) + 4); }
}
__device__ __forceinline__ void cvt_process(bf16* dst, int K, float (&v)[32], f32x4& g0, f32x4& g1, const CvtItem& cn, bool hn, LAS float* scr, int lane) {
#pragma unroll
    for (int i = 0; i < 32; ++i) scr[(2 * i + (lane >> 5)) * 33 + (lane & 31)] = v[i];
    const f32x4 h0 = g0, h1 = g1;
    if (hn) cvt_load(cn, v, g0, g1, lane);
    LDS_WAIT(); asm volatile("" ::: "memory");
    const int cc = lane & 7;
#pragma unroll
    for (int j = 0; j < 4; ++j) { const int n = (lane >> 3) + 8 * j; const LAS float* s = scr + (8 * cc) * 33 + n;
        v4u o; o.x = pk2(s[0 * 33] * h0.x, s[1 * 33] * h0.y); o.y = pk2(s[2 * 33] * h0.z, s[3 * 33] * h0.w); o.z = pk2(s[4 * 33] * h1.x, s[5 * 33] * h1.y); o.w = pk2(s[6 * 33] * h1.z, s[7 * 33] * h1.w);
        __builtin_nontemporal_store(o, (GAS v4u*)(dst + (size_t)n * K + 8 * cc)); }
    LDS_WAIT(); asm volatile("" ::: "memory");
}
template <bool FROM_ARGS>
__device__ __forceinline__ void p0_convert(Frame& F, const Args& args, unsigned char* ws_in, int l0, int r0, int count) {
    LAS float* scr = (LAS float*)(F.lds + CVT_LDS_OFF + F.wave * CVT_SCR);
    const int NGW = F.G * NWAVES; int lane = F.lane;
    int v = F.vcu * NWAVES + F.wave; unsigned char* ws = ws_in; asm volatile("" : "+s"(v), "+s"(ws), "+v"(lane));
    if (v >= count) return;
    CvtSrc a;
    if (FROM_ARGS) a = CvtSrc{args.w_in, args.w_out, args.w_gate, args.w_up, args.w_down, args.norm1_g, args.norm2_g};
    else { const int tv = (int)((const GAS unsigned*)(ws + WS_PTAB))[lane & 15];
#define CVT_PTR(i) ((const float*)(((unsigned long long)(unsigned)__builtin_amdgcn_readlane(tv, 2 * (i) + 1) << 32) | (unsigned long long)(unsigned)__builtin_amdgcn_readlane(tv, 2 * (i))))
        a = CvtSrc{CVT_PTR(0), CVT_PTR(1), CVT_PTR(2), CVT_PTR(3), CVT_PTR(4), CVT_PTR(5), CVT_PTR(6)};
#undef CVT_PTR
    }
#define CVT_ITEM(vv) cvt_item(a, ws, (r0 + (vv) >= PER_LAYER) ? l0 + 1 : l0, (r0 + (vv) >= PER_LAYER) ? r0 + (vv) - PER_LAYER : r0 + (vv))
    constexpr int NS = CVT_NS;
    float vv[NS][32]; f32x4 g0[NS], g1[NS]; bf16* dd[NS]; int kk[NS]; bool has[NS];
#pragma unroll
    for (int s_ = 0; s_ < NS; ++s_) { has[s_] = v + s_ * NGW < count; dd[s_] = nullptr; kk[s_] = 0;
        if (has[s_]) { const CvtItem c = CVT_ITEM(v + s_ * NGW); dd[s_] = c.dst; kk[s_] = c.K; cvt_load(c, vv[s_], g0[s_], g1[s_], lane); } }
#pragma unroll 1
    for (bool more = true; more; v += NS * NGW) {
#pragma unroll
        for (int s_ = 0; s_ < NS; ++s_) {
            if (more && has[s_]) {
                const bool hn = v + (s_ + NS) * NGW < count; CvtItem cn{}; if (hn) cn = CVT_ITEM(v + (s_ + NS) * NGW);
                cvt_process(dd[s_], kk[s_], vv[s_], g0[s_], g1[s_], cn, hn, scr, lane); dd[s_] = cn.dst; kk[s_] = cn.K; has[s_] = hn;
            } else more = false;
        }
    }
#undef CVT_ITEM
}
__device__ __forceinline__ void rms_row(const f32x4 (&v)[8], const float* g, bf16* obf, float* of32, int lane) {
    float s = 0.f;
#pragma unroll
    for (int j = 0; j < 8; ++j) s += (v[j].x * v[j].x + v[j].y * v[j].y) + (v[j].z * v[j].z + v[j].w * v[j].w);
    const float rstd = rsqrtf(wave_sum(s, lane) * (1.f / DM) + EPS);
#pragma unroll
    for (int j = 0; j < 8; ++j) { const f32x4 gv = *(const f32x4*)(g + j * 256 + lane * 4); const f32x4 y = v[j] * rstd * gv;
        if (obf) { v2u w; w.x = pk2(y.x, y.y); w.y = pk2(y.z, y.w); *(GAS v2u*)(obf + j * 256 + lane * 4) = w; }
        else *(GAS f32x4*)(of32 + j * 256 + lane * 4) = y; }
}

__device__ __forceinline__ size_t inproj_colmap(int n0) {
    const int seg = n0 >> 10;
    if (seg >= 2) return (size_t)n0;
    const int w = n0 & 1023, hm = w >> 6, half = (w >> 5) & 1;
    return (size_t)(seg * 1024 + (hm >> 2) * 256 + half * 128 + (hm & 3) * 32);
}
__device__ __forceinline__ void p0_prologue(Frame& F, const Args& a, unsigned char* ws) {
    const int gw = F.vcu * NWAVES + F.wave, NGW = F.G * NWAVES;
#if CVT_HOST
    p0_convert<true>(F, a, ws, 0, 0, I_IN);
    if (gw == 0 && F.lane < 7) { const float* pv = F.lane == 0 ? a.w_in : F.lane == 1 ? a.w_out : F.lane == 2 ? a.w_gate : F.lane == 3 ? a.w_up : F.lane == 4 ? a.w_down : F.lane == 5 ? a.norm1_g : a.norm2_g;
        ((GAS unsigned long long*)(ws + WS_PTAB))[F.lane] = (unsigned long long)(uintptr_t)pv; }
#else
    for (int l = 0; l < NL; ++l) p0_convert<true>(F, a, ws, l, 0, PER_LAYER);
#endif
    { float* rope = (float*)(ws + WS_ROPE); const int gt = F.vcu * 512 + F.tid, NGT = F.G * 512;
      for (int e = gt; e < T * 32; e += NGT) { const int t = e >> 5, i = e & 31;
          const double inv = exp2(-(double)i * (13.287712379549449 / 32.0));
          const double ang = (double)((float)a.pos[t] * (float)inv);
          const double n = rint(ang * 0.6366197723675814);
          const double f = (ang - n * 1.5707963267948966) - n * 6.123233995736766e-17;
          const double f2 = f * f;
          const double sn = f * (1.0 + f2 * (-1.0 / 6 + f2 * (1.0 / 120 + f2 * (-1.0 / 5040 + f2 * (1.0 / 362880 + f2 * (-1.0 / 39916800))))));
          const double cs = 1.0 + f2 * (-0.5 + f2 * (1.0 / 24 + f2 * (-1.0 / 720 + f2 * (1.0 / 40320 + f2 * (-1.0 / 3628800 + f2 * (1.0 / 479001600))))));
          const int q = ((int)(long long)n) & 3;
          const double c_ = (q == 0) ? cs : (q == 1) ? -sn : (q == 2) ? -cs : sn;
          const double s_ = (q == 0) ? sn : (q == 1) ? cs : (q == 2) ? -sn : -cs;
          rope[(size_t)t * 64 + i] = (float)c_; rope[(size_t)t * 64 + 32 + i] = (float)s_; }
      float* lbs = (float*)(ws + WS_LBS);
      for (int e = gt; e < 2 * 1024; e += NGT) { const int dir = e >> 10, c = e & 1023; const float* lg = a.lblog + (size_t)dir * NL * 1024 + c;
          const float l0 = lg[0], l1 = lg[1024], l2 = lg[2048], l3 = lg[3072]; const float mx = fmaxf(fmaxf(l0, l1), fmaxf(l2, l3));
          const float e0 = expf(l0 - mx), e1 = expf(l1 - mx), e2 = expf(l2 - mx), e3 = expf(l3 - mx); const float inv = 1.0f / (e0 + e1 + e2 + e3);
          float* o = lbs + (size_t)dir * NL * 1024 + c; o[0] = 0.f; o[1024] = e1 * inv; o[2048] = (e1 + e2) * inv; o[3072] = (e1 + e2 + e3) * inv; }
    }
    { float* par = (float*)(ws + WS_PAR); const int gt = F.vcu * 512 + F.tid, NGT = F.G * 512;
      for (int e = gt; e < PAR_END; e += NGT) { float v;
          if (e < PAR_N2) v = a.norm1_g[e - PAR_N1]; else if (e < PAR_FG) v = a.norm2_g[e - PAR_N2]; else if (e < PAR_DLAM) v = a.final_g[e - PAR_FG]; else if (e < PAR_SUBG) v = a.dlam[e - PAR_DLAM];
          else if (e < PAR_HGN) v = a.subg[e - PAR_SUBG]; else if (e < PAR_RW) v = a.hgn[e - PAR_HGN]; else v = a.router_w[e - PAR_RW];
          par[e] = v; } }
    { bf16* RWS = (bf16*)(ws + WS_RWS); const int gt = F.vcu * 512 + F.tid, NGT = F.G * 512;
      for (int i = gt; i < NL * DM * NE; i += NGT) { const int l = i / (DM * NE), r = i % (DM * NE), dd = r >> 4, e = r & 15;
          const float wv = a.router_w[i] * a.norm2_g[l * DM + dd]; const unsigned hi_ = pk2(wv, 0.f) & 0xffffu; const float lo_f = wv - __uint_as_float(hi_ << 16);
          bf16* img = RWS + (size_t)l * (RW_IMG / 2); img[e * RW_PITCH + dd] = (bf16)hi_; img[NE * RW_PITCH + e * RW_PITCH + dd] = (bf16)(pk2(lo_f, 0.f) & 0xffffu); } }
    { bf16* X = (bf16*)(ws + WS_X); float* RS1 = (float*)(ws + WS_RS1);
      for (int m = gw; m < T; m += NGW) { float ss = 0.f;
#pragma unroll
          for (int j = 0; j < 8; ++j) { const f32x4 v = *(const GAS f32x4*)(a.x + (size_t)m * DM + j * 256 + F.lane * 4); ss += (v.x * v.x + v.y * v.y) + (v.z * v.z + v.w * v.w);
              v2u w; w.x = pk2(v.x, v.y); w.y = pk2(v.z, v.w); *(GAS v2u*)(X + (size_t)m * DM + j * 256 + F.lane * 4) = w; }
          ss = wave_sum(ss, F.lane); if (F.lane == 0) RS1[m] = rsqrtf(ss * (1.f / DM) + EPS); } }
}

__device__ __forceinline__ void router_phase(Frame& F, const bf16* X, const bf16* RWimg, float* RS2, float* AFFT) {
    typedef short bf16x8r __attribute__((ext_vector_type(8)));
    { const GAS v4u* s = (const GAS v4u*)RWimg; LAS v4u* d = (LAS v4u*)F.lds;
      for (int i = F.tid; i < RW_IMG / 16; i += 512) d[i] = s[i]; }
    __syncthreads();
    const int lane = F.lane, r16 = lane & 15, q = lane >> 4;
    const LAS unsigned char* bhi = F.lds + (r16 * RW_PITCH + 512 * q) * 2; const LAS unsigned char* blo = bhi + NE * RW_PITCH * 2;
    if (F.wave < 4) {
        for (int tile = F.vcu * 4 + F.wave; tile < T / 16; tile += F.G * 4) {
            const bf16* xr = X + (size_t)(tile * 16 + r16) * DM + 512 * q;
            f32x4 acc = (f32x4){0.f, 0.f, 0.f, 0.f}; float ss = 0.f;
#pragma unroll 8
            for (int s = 0; s < 64; ++s) { const bf16x8r a = *(const GAS bf16x8r*)(xr + 8 * s);
                const bf16x8r b0 = *(const LAS bf16x8r*)(bhi + 16 * s), b1 = *(const LAS bf16x8r*)(blo + 16 * s);
                acc = __builtin_amdgcn_mfma_f32_16x16x32_bf16(a, b0, acc, 0, 0, 0); acc = __builtin_amdgcn_mfma_f32_16x16x32_bf16(a, b1, acc, 0, 0, 0);
#pragma unroll
                for (int j = 0; j < 8; ++j) { const float v = __uint_as_float(((unsigned)(unsigned short)a[j]) << 16); ss += v * v; } }
            ss += shx(ss, 16, lane); ss += shx(ss, 32, lane);
            const float rstd = rsqrtf(ss * (1.f / DM) + EPS);
            if (q == 0) RS2[tile * 16 + r16] = rstd;
#pragma unroll
            for (int r = 0; r < 4; ++r) { const float rr = __int_as_float(shi(__float_as_int(rstd), 4 * q + r)); float lg = acc[r] * rr; float mx = lg;
#pragma unroll
                for (int o = 1; o < 16; o <<= 1) mx = fmaxf(mx, shx(mx, o, lane));
                const float ex = expf(lg - mx); float sum = ex;
#pragma unroll
                for (int o = 1; o < 16; o <<= 1) sum += shx(sum, o, lane);
                AFFT[(size_t)r16 * T + tile * 16 + 4 * q + r] = ex / sum; }
        }
    }
    __syncthreads();
}

__device__ __forceinline__ unsigned topk_total(Frame& F, LAS unsigned* cnt, int par, unsigned wave_count) {
    if (F.lane == 0) cnt[par * 8 + F.wave] = wave_count;
    __syncthreads();
    unsigned tot = 0;
#pragma unroll
    for (int w_ = 0; w_ < 8; ++w_) tot += cnt[par * 8 + w_];
    return tot;
}
__device__ __forceinline__ void topk_expert(Frame& F, int e, const float* AFFT, const float* RS2, int* IDX, float* GATE, float* RSG, int* SLOTT) {
    LAS unsigned* cnt = (LAS unsigned*)F.lds;
    const int tid = F.tid, lane = F.lane, wid = F.wave;
    unsigned key[32];
#pragma unroll
    for (int i = 0; i < 8; ++i) { const v4u k4 = *(const GAS v4u*)(AFFT + (size_t)e * T + 32 * tid + 4 * i); key[4 * i] = k4.x; key[4 * i + 1] = k4.y; key[4 * i + 2] = k4.z; key[4 * i + 3] = k4.w; }
    unsigned tkey = 0u;
#pragma unroll 1
    for (int b = 30; b >= 0; --b) {
        const unsigned cand = tkey | (1u << b); unsigned c = 0u;
#pragma unroll
        for (int i = 0; i < 32; ++i) c += (unsigned)__popcll(__ballot(key[i] >= cand));
        if (topk_total(F, cnt, b & 1, c) >= (unsigned)CAP) tkey = cand;
    }
    unsigned gmask = 0u, emask = 0u, cgw = 0u;
#pragma unroll
    for (int i = 0; i < 32; ++i) { gmask |= (key[i] > tkey ? 1u : 0u) << i; emask |= (key[i] == tkey ? 1u : 0u) << i; cgw += (unsigned)__popcll(__ballot(key[i] > tkey)); }
    const int cg = __popc(gmask), ce = __popc(emask);
    const unsigned krem = (unsigned)CAP - topk_total(F, cnt, 1, cgw);
    int ig = cg, ie = ce;
#pragma unroll
    for (int off = 1; off < 64; off <<= 1) { const int tg = shi(ig, (lane - off) & 63), te = shi(ie, (lane - off) & 63); if (lane >= off) { ig += tg; ie += te; } }
    if (lane == 63) { cnt[16 + 2 * wid] = (unsigned)ig; cnt[17 + 2 * wid] = (unsigned)ie; }
    __syncthreads();
    int og = 0, oe = 0;
    for (int w_ = 0; w_ < wid; ++w_) { og += (int)cnt[16 + 2 * w_]; oe += (int)cnt[17 + 2 * w_]; }
    const int gbefore = og + ig - cg, ebefore = oe + ie - ce;
    const float* rs2p = RS2 + 32 * tid; int* idxp = IDX + e * CAP; float* gatep = GATE + e * CAP; float* rsgp = RSG + e * CAP;
    int sl[4];
#pragma unroll
    for (int i = 0; i < 32; ++i) { const unsigned low = (1u << i) - 1u;
        const int gb = gbefore + __popc(gmask & low), eb = ebefore + __popc(emask & low);
        const bool isg = (gmask >> i) & 1u, ise = (emask >> i) & 1u;
        const bool sel = isg || (ise && eb < (int)krem);
        const int slot = gb + (eb < (int)krem ? eb : (int)krem);
        sl[i & 3] = sel ? slot : -1;
        if (sel) { idxp[slot] = 32 * tid + i; gatep[slot] = __uint_as_float(key[i]); rsgp[slot] = rs2p[i]; }
        if ((i & 3) == 3) *(GAS v4u*)(SLOTT + (size_t)e * T + 32 * tid + (i - 3)) = (v4u){(unsigned)sl[0], (unsigned)sl[1], (unsigned)sl[2], (unsigned)sl[3]}; }
    __syncthreads();
}

__device__ __forceinline__ void combine_phase(Frame& F, bf16* X, const bf16* Y, const int* SLOT, float* RS1, const float* gfin, float* OUT) {
    const int gw = F.vcu * NWAVES + F.wave, NGW = F.G * NWAVES;
    v4u xn[4]; int slotn = -1;
    if (gw < T) {
#pragma unroll
        for (int j = 0; j < 4; ++j) xn[j] = *(const GAS v4u*)(X + (size_t)gw * DM + j * 512 + F.lane * 8);
        slotn = (F.lane < NE) ? SLOT[(size_t)F.lane * T + gw] : -1; }
    for (int row = gw; row < T; row += NGW) {
        float x[4][8];
#pragma unroll
        for (int j = 0; j < 4; ++j) { x[j][0] = __uint_as_float(xn[j].x << 16); x[j][1] = __uint_as_float(xn[j].x & 0xffff0000u); x[j][2] = __uint_as_float(xn[j].y << 16); x[j][3] = __uint_as_float(xn[j].y & 0xffff0000u);
            x[j][4] = __uint_as_float(xn[j].z << 16); x[j][5] = __uint_as_float(xn[j].z & 0xffff0000u); x[j][6] = __uint_as_float(xn[j].w << 16); x[j][7] = __uint_as_float(xn[j].w & 0xffff0000u); }
        const int myslot = slotn;
        if (row + NGW < T) {
#pragma unroll
            for (int j = 0; j < 4; ++j) xn[j] = *(const GAS v4u*)(X + (size_t)(row + NGW) * DM + j * 512 + F.lane * 8);
            slotn = (F.lane < NE) ? SLOT[(size_t)F.lane * T + row + NGW] : -1; }
#pragma unroll 1
        for (int e = 0; e < NE; ++e) { const int s = shi(myslot, e);
            if (s >= 0) { const bf16* yr = Y + ((size_t)e * CAP + s) * DM;
#pragma unroll
                for (int j = 0; j < 4; ++j) { const v4u w = *(const GAS v4u*)(yr + j * 512 + F.lane * 8);
                    x[j][0] += __uint_as_float(w.x << 16); x[j][1] += __uint_as_float(w.x & 0xffff0000u); x[j][2] += __uint_as_float(w.y << 16); x[j][3] += __uint_as_float(w.y & 0xffff0000u);
                    x[j][4] += __uint_as_float(w.z << 16); x[j][5] += __uint_as_float(w.z & 0xffff0000u); x[j][6] += __uint_as_float(w.w << 16); x[j][7] += __uint_as_float(w.w & 0xffff0000u); } } }
        float ss = 0.f;
#pragma unroll
        for (int j = 0; j < 4; ++j)
#pragma unroll
            for (int k = 0; k < 8; ++k) ss += x[j][k] * x[j][k];
        const float rstd = rsqrtf(wave_sum(ss, F.lane) * (1.f / DM) + EPS);
        if (OUT) {
#pragma unroll
            for (int j = 0; j < 4; ++j) { const f32x4 g0 = *(const f32x4*)(gfin + j * 512 + F.lane * 8), g1 = *(const f32x4*)(gfin + j * 512 + F.lane * 8 + 4);
                *(GAS f32x4*)(OUT + (size_t)row * DM + j * 512 + F.lane * 8) = (f32x4){x[j][0] * rstd * g0.x, x[j][1] * rstd * g0.y, x[j][2] * rstd * g0.z, x[j][3] * rstd * g0.w};
                *(GAS f32x4*)(OUT + (size_t)row * DM + j * 512 + F.lane * 8 + 4) = (f32x4){x[j][4] * rstd * g1.x, x[j][5] * rstd * g1.y, x[j][6] * rstd * g1.z, x[j][7] * rstd * g1.w}; }
        } else {
#pragma unroll
            for (int j = 0; j < 4; ++j) { v4u w; w.x = pk2(x[j][0], x[j][1]); w.y = pk2(x[j][2], x[j][3]); w.z = pk2(x[j][4], x[j][5]); w.w = pk2(x[j][6], x[j][7]); *(GAS v4u*)(X + (size_t)row * DM + j * 512 + F.lane * 8) = w; }
            if (F.lane == 0) RS1[row] = rstd; }
    }
}

__device__ __forceinline__ void vt_transpose(Frame& F, const bf16* V, bf16* VT) {
    LAS bf16* tile = (LAS bf16*)(F.lds + F.wave * 9216);
    const int gw = F.vcu * NWAVES + F.wave, NGW = F.G * NWAVES, lane = F.lane;
    for (int it = gw; it < (T / 64) * 16; it += NGW) { const int t0 = (it >> 4) * 64, c0 = (it & 15) * 64;
#pragma unroll
        for (int i = 0; i < 8; ++i) { const int r = (lane >> 3) + 8 * i; *(LAS v4u*)(tile + r * 72 + (lane & 7) * 8) = *(const GAS v4u*)(V + (size_t)(t0 + r) * 1024 + c0 + (lane & 7) * 8); }
        LDS_WAIT(); asm volatile("" ::: "memory");
        const int g = lane & 7;
#pragma unroll
        for (int i = 0; i < 8; ++i) { const int col = (lane >> 3) + 8 * i; const LAS bf16* s = tile + (8 * g) * 72 + col;
            const LAS bf16* s2 = tile + (16 * (g >> 1) + 4 * (g & 1)) * 72 + col;
            v4u o; o.x = (unsigned)s2[0] | ((unsigned)s2[72] << 16); o.y = (unsigned)s2[144] | ((unsigned)s2[216] << 16); o.z = (unsigned)s2[8 * 72] | ((unsigned)s2[9 * 72] << 16); o.w = (unsigned)s2[10 * 72] | ((unsigned)s2[11 * 72] << 16);
            *(GAS v4u*)(VT + (size_t)(c0 + col) * T + t0 + 8 * g) = o; }
        LDS_WAIT(); asm volatile("" ::: "memory");
    }
}

constexpr int PH_PER_LAYER = 11, N_PHASES = 1 + NL * PH_PER_LAYER;
#ifndef PHMASK
#define PHMASK 0xFFFF
#endif
#define PM(b) ((PHMASK >> (b)) & 1)
#ifndef PROBE_NOSTORE
#define PROBE_NOSTORE 0
#endif
#ifndef REPMASK
#define REPMASK 0
#endif
#define NREP(b) (((REPMASK >> (b)) & 1) ? 2 : 1)
#define PHASE_BEGIN() int wv_ = wave_s; asm volatile("" : "+s"(wv_)); int tid_ = wv_ * 64 + (int)xb_lane(); asm volatile("" : "+v"(tid_)); unsigned char* w = args.ws; asm volatile("" : "+s"(w)); \
    int bx_ = blockIdx.x, gx_ = gridDim.x; asm volatile("" : "+s"(bx_), "+s"(gx_)); \
    Frame F; F.lds = lds0; F.MISC = (volatile LAS unsigned*)(lds0 + MISC_OFF); F.tid = tid_; F.lane = tid_ & 63; F.wave = wv_; F.G = gx_; \
    F.vcu = (gx_ % 8 == 0) ? (bx_ % 8) * (gx_ / 8) + bx_ / 8 : bx_
__global__ void __launch_bounds__(NWAVES * 64, 2) mega_fwd(Args args) {
    extern __shared__ __attribute__((aligned(16))) unsigned char lds_raw[];
    LAS unsigned char* const lds0 = (LAS unsigned char*)lds_raw;
    const int wave_s = __builtin_amdgcn_readfirstlane((int)threadIdx.x >> 6);
    if (wave_s < 2) ((LAS unsigned*)(lds0 + MISC_OFF))[wave_s * 64 + (int)xb_lane()] = 0u;
    __syncthreads();
    XcdBarrier bar; bar.bar = (unsigned*)(args.ws + WS_CTL) + CW_BAR; bar.x = 0; bar.st = nullptr; bar.wv = wave_s;
    if (!MK_PER_PHASE) bar = xcd_barrier_post((unsigned*)(args.ws + WS_CTL) + CW_BAR, (volatile LAS unsigned*)(lds0 + MISC_OFF) + 8, wave_s);
    const int lo = args.ph_lo, hi = args.ph_hi;
#define IN(k) (lo <= (k) && (k) < hi)
#define SEAM(k) do { if (IN(k) && IN((k) + 1)) xcd_barrier(bar); } while (0)

    for (int rep_ = 0; rep_ < NREP(0); ++rep_) if (PM(0) && IN(0)) { if (rep_) xcd_barrier(bar); PHASE_BEGIN(); p0_prologue(F, args, w); }
    SEAM(0);

#pragma unroll 1
    for (int l = 0; l < NL; ++l) {
        const int pb = 1 + l * PH_PER_LAYER;
        for (int rep_ = 0; rep_ < NREP(1); ++rep_) if (PM(1) && IN(pb + 0)) { if (rep_) xcd_barrier(bar); PHASE_BEGIN();
            pg8::Gemm g{(bf16*)(w + WS_X), (bf16*)(w + WS_WIN) + (size_t)l * INC * DM, T, INC, DM, 31, 0, nullptr}; pg8::StaticOrder S; S.init(T, INC, F.G, bx_);
            pg8::EpiInProj E{(bf16*)(w + WS_Q), (bf16*)(w + WS_K), (bf16*)(w + WS_V), (bf16*)(w + WS_HQ), (bf16*)(w + WS_KK), (bf16*)(w + WS_HV), (bf16*)(w + WS_HG), (unsigned short*)(w + WS_LF),
                              (const float*)(w + WS_ROPE), (const float*)(w + WS_LBS) + l * 1024, QSCALE, (unsigned*)(w + WS_CTL) + CW_KMAX + l * 16, (PROBE_NOSTORE && rep_) ? 1 : 0, (const float*)(w + WS_RS1)};
            pg8::gemm_phase<pg8::EpiInProj, pg8::StaticOrder, true, true>(F.lds, g, S, E, F.tid);
        }
        SEAM(pb + 0);
        for (int rep_ = 0; rep_ < NREP(2); ++rep_) if (PM(2) && IN(pb + 1)) { if (rep_) xcd_barrier(bar); PHASE_BEGIN();
            const hg::HgArgs HA{(bf16*)(w + WS_HQ), (bf16*)(w + WS_KK), (unsigned short*)(w + WS_LF), (bf16*)(w + WS_HV), (bf16*)(w + WS_HG), (float*)(w + WS_HS), (float*)(w + WS_GS), (float*)(w + WS_HOF), (bf16*)(w + WS_MIX), (const float*)(w + WS_PAR) + PAR_HGN + l * 128};
            for (int n = F.vcu; n < 512; n += F.G) hg::hgrn_unit<false>(HA, n >> 8, (n >> 5) & 7, n & 31, F.lds, F.tid);
            __syncthreads(); vt_transpose(F, (const bf16*)(w + WS_V), (bf16*)(w + WS_VT));
        }
        SEAM(pb + 1);
        if (PM(3) && IN(pb + 2)) { PHASE_BEGIN(); hg::hgrn_scan((float*)(w + WS_HS), (const float*)(w + WS_GS), F.vcu * 512 + F.tid, F.G * 512); }
        SEAM(pb + 2);
        if (PM(4) && IN(pb + 3)) {
            for (int rep_ = 0; rep_ < NREP(13); ++rep_) if (PM(13)) { if (rep_) xcd_barrier(bar); PHASE_BEGIN();
                const float lam_init = 0.8f - 0.6f * expf(-0.3f * (float)l);
                const float* lv = (const float*)(w + WS_PAR) + PAR_DLAM + l * 256;
                const float s1 = wave_sum(lv[F.lane] * lv[64 + F.lane], F.lane), s2 = wave_sum(lv[128 + F.lane] * lv[192 + F.lane], F.lane);
                const float lam = expf(s1) - expf(s2) + lam_init;
                const att::AttnArgs AA{(bf16*)(w + WS_Q), (bf16*)(w + WS_K), (bf16*)(w + WS_V), (bf16*)(w + WS_VT), (float*)(w + WS_AO1), (bf16*)(w + WS_MIX), (const float*)(w + WS_PAR) + PAR_SUBG + l * 128, (const float*)(w + WS_CTL) + CW_KMAX + l * 16, lam, 1.0f - lam_init};
                #ifdef ATT_OLD_BODY
                for (int n = F.vcu; n < 512; n += F.G) att::attn_unit<0>(AA, (n & 255) >> 5, (n & 31) + 32 * (n >> 8), (AT_LAS char*)F.lds, F.tid);
#else
                { int slot_ = 0; const int cpos = (CVT_HOST && rep_ == 0) ? (int)((unsigned)F.vcu % 6u) : -1; const int ccnt = l < NL - 1 ? PER_LAYER : PER_LAYER - I_IN;
                  for (int n = F.vcu; n < 512; n += F.G, ++slot_) {
                    if (cpos == 2 * slot_) p0_convert<false>(F, args, w, l, I_IN, ccnt);
                    att::attn_unit2<0>(AA, (n & 255) >> 5, (n & 31) + 32 * (n >> 8), (AT_LAS char*)F.lds, F.tid, [&]() { if (cpos == 2 * slot_ + 1) p0_convert<false>(F, args, w, l, I_IN, ccnt); }); } }
#endif
                __syncthreads();
            }
#ifdef HG_PROBE
            { xcd_barrier(bar); PHASE_BEGIN();
                const hg::HgArgs HA{(bf16*)(w + WS_HQ), (bf16*)(w + WS_KK), (unsigned short*)(w + WS_LF), (bf16*)(w + WS_HV), (bf16*)(w + WS_HG), (float*)(w + WS_HS), (float*)(w + WS_GS), (float*)(w + WS_END), (bf16*)(w + WS_END + 64 * MiB), (const float*)(w + WS_PAR) + PAR_HGN + l * 128};
                for (int n = F.vcu; n < 256; n += F.G) { const int h = n >> 5, sc = n & 31;
                    hg::hgrn_unit<true, HG_PROBE>(HA, 0, h, sc, F.lds, F.tid);
                    __threadfence_block(); __syncthreads();
                    hg::hgrn_unit<true, HG_PROBE>(HA, 1, h, sc, F.lds, F.tid); }
            }
#endif
#ifdef ATT_PROBE
            { xcd_barrier(bar); PHASE_BEGIN();
                const att::AttnArgs AA{(bf16*)(w + WS_Q), (bf16*)(w + WS_K), (bf16*)(w + WS_V), (bf16*)(w + WS_VT), (float*)(w + WS_END), (bf16*)(w + WS_END + 64 * MiB), (const float*)(w + WS_PAR) + PAR_SUBG + l * 128, (const float*)(w + WS_CTL) + CW_KMAX + l * 16, 0.5f, 0.5f};
                for (int n = F.vcu; n < 512; n += F.G) att::attn_unit2<ATT_PROBE>(AA, (n & 255) >> 5, (n & 31) + 32 * (n >> 8), (AT_LAS char*)F.lds, F.tid);
                __syncthreads();
            }
#endif
            for (int rep_ = 0; rep_ < NREP(12); ++rep_) if (PM(12)) { if (rep_) xcd_barrier(bar); PHASE_BEGIN();
                const int cpos = (CVT_HOST && rep_ == 0) ? (int)((unsigned)F.vcu % 6u) : -1; const int ccnt = l < NL - 1 ? PER_LAYER : PER_LAYER - I_IN;
                if (cpos == 4) { p0_convert<false>(F, args, w, l, I_IN, ccnt); __syncthreads(); }
                const hg::HgArgs HA{(bf16*)(w + WS_HQ), (bf16*)(w + WS_KK), (unsigned short*)(w + WS_LF), (bf16*)(w + WS_HV), (bf16*)(w + WS_HG), (float*)(w + WS_HS), (float*)(w + WS_GS), (float*)(w + WS_HOF), (bf16*)(w + WS_MIX), (const float*)(w + WS_PAR) + PAR_HGN + l * 128};
                for (int n = F.vcu; n < 256; n += F.G) { const int h = n >> 5, sc = n & 31;
                    hg::hgrn_unit<true>(HA, 0, h, sc, F.lds, F.tid);
                    __threadfence_block(); __syncthreads();
                    hg::hgrn_unit<true>(HA, 1, h, sc, F.lds, F.tid); }
                if (cpos == 5) { __syncthreads(); p0_convert<false>(F, args, w, l, I_IN, ccnt); }
            }
        }
        SEAM(pb + 3);
        for (int rep_ = 0; rep_ < NREP(5); ++rep_) if (PM(5) && IN(pb + 4)) { if (rep_) xcd_barrier(bar); PHASE_BEGIN();
            pg8::Gemm g{(bf16*)(w + WS_MIX), (bf16*)(w + WS_WOUT) + (size_t)l * DM * DM, T, DM, DM, 31, 0, nullptr}; pg8::StaticOrder S; S.init(T, DM, F.G, bx_);
            if (l == 0) { pg8::EpiResidBf<true> E{args.x, (bf16*)(w + WS_X)}; pg8::gemm_phase<pg8::EpiResidBf<true>, pg8::StaticOrder, true, true>(F.lds, g, S, E, F.tid); }
            else { pg8::EpiResidBf<false> E{nullptr, (bf16*)(w + WS_X)}; pg8::gemm_phase<pg8::EpiResidBf<false>, pg8::StaticOrder, true, true>(F.lds, g, S, E, F.tid); }
        }
        SEAM(pb + 4);
        for (int rep_ = 0; rep_ < NREP(6); ++rep_) if (PM(6) && IN(pb + 5)) { if (rep_) xcd_barrier(bar); PHASE_BEGIN(); router_phase(F, (const bf16*)(w + WS_X), (const bf16*)(w + WS_RWS + (size_t)l * RW_IMG), (float*)(w + WS_RS2), (float*)(w + WS_AFF)); }
        SEAM(pb + 5);
        for (int rep_ = 0; rep_ < NREP(7); ++rep_) if (PM(7) && IN(pb + 6)) { if (rep_) xcd_barrier(bar); PHASE_BEGIN(); for (int e = bx_; e < NE; e += F.G) topk_expert(F, e, (const float*)(w + WS_AFF), (const float*)(w + WS_RS2), (int*)(w + WS_IDX), (float*)(w + WS_GATE), (float*)(w + WS_RSG), (int*)(w + WS_SLOT)); }
        SEAM(pb + 6);
        for (int rep_ = 0; rep_ < NREP(9); ++rep_) if (PM(9) && IN(pb + 8)) { if (rep_) xcd_barrier(bar); PHASE_BEGIN();
            pg8::Gemm g{(bf16*)(w + WS_X), (bf16*)(w + WS_WGU) + (size_t)l * NE * 2048 * DM, XR, 2048, DM, 3, (size_t)2048 * DM * 2, (const int*)(w + WS_IDX)}; pg8::StaticOrder S; S.init(XR, 2048, F.G, bx_);
            pg8::EpiSwiGLU E{(bf16*)(w + WS_HM), (const float*)(w + WS_RSG)};
            pg8::gemm_phase<pg8::EpiSwiGLU, pg8::StaticOrder, true, true, true>(F.lds, g, S, E, F.tid);
        }
        SEAM(pb + 8);
        for (int rep_ = 0; rep_ < NREP(10); ++rep_) if (PM(10) && IN(pb + 9)) { if (rep_) xcd_barrier(bar); PHASE_BEGIN();
            pg8::Gemm g{(bf16*)(w + WS_HM), (bf16*)(w + WS_WDN) + (size_t)l * NE * DM * FF, XR, DM, FF, 3, (size_t)DM * FF * 2, nullptr}; pg8::StaticOrder S; S.init(XR, DM, F.G, bx_);
            pg8::EpiDown E{(bf16*)(w + WS_Y), (const float*)(w + WS_GATE)};
            pg8::gemm_phase<pg8::EpiDown, pg8::StaticOrder, true, true>(F.lds, g, S, E, F.tid);
        }
        SEAM(pb + 9);
        for (int rep_ = 0; rep_ < NREP(11); ++rep_) if (PM(11) && IN(pb + 10)) { if (rep_) xcd_barrier(bar); PHASE_BEGIN();
            if (l < NL - 1) combine_phase(F, (bf16*)(w + WS_X), (const bf16*)(w + WS_Y), (const int*)(w + WS_SLOT), (float*)(w + WS_RS1), nullptr, nullptr);
            else combine_phase(F, (bf16*)(w + WS_X), (const bf16*)(w + WS_Y), (const int*)(w + WS_SLOT), nullptr, (const float*)(w + WS_PAR) + PAR_FG, args.out);
        }
        SEAM(pb + 10);
    }
#undef IN
#undef SEAM
}

extern "C" void kernel_launch(void* const* d_in, const int* in_sizes, int n_in, void* d_out, int out_size, void* d_ws, size_t ws_size, hipStream_t stream) {
    static int grid = 0;
    if (grid == 0) {
        if (n_in != 15 || in_sizes[0] != T * DM || out_size != T * DM || ws_size < WS_END) { fprintf(stderr, "kernel_launch: shape/workspace mismatch (n_in %d, ws %zu < %zu)\n", n_in, ws_size, (size_t)WS_END); grid = -1; return; }
        int dev = 0, cus = 0, per_cu = 0;
        if (hipGetDevice(&dev) != hipSuccess || hipDeviceGetAttribute(&cus, hipDeviceAttributeMultiprocessorCount, dev) != hipSuccess) { grid = -1; return; }
        if (hipFuncSetAttribute((const void*)mega_fwd, hipFuncAttributeMaxDynamicSharedMemorySize, LDS_BYTES) != hipSuccess) { fprintf(stderr, "kernel_launch: hipFuncSetAttribute failed\n"); grid = -1; return; }
        if (hipOccupancyMaxActiveBlocksPerMultiprocessor(&per_cu, (const void*)mega_fwd, NWAVES * 64, LDS_BYTES) != hipSuccess || per_cu < 1) fprintf(stderr, "kernel_launch: occupancy query reports %d\n", per_cu);
        (void)hipGetLastError();
        grid = cus;
    }
    if (grid < 0) return;
    if (hipMemsetAsync((char*)d_ws + WS_CTL, 0, CTL_ZERO_BYTES, stream) != hipSuccess) return;
    Args a{};
    a.x = (const float*)d_in[0]; a.pos = (const int*)d_in[1]; a.norm1_g = (const float*)d_in[2]; a.w_in = (const float*)d_in[3]; a.dlam = (const float*)d_in[4]; a.subg = (const float*)d_in[5];
    a.lblog = (const float*)d_in[6]; a.hgn = (const float*)d_in[7]; a.w_out = (const float*)d_in[8]; a.norm2_g = (const float*)d_in[9]; a.router_w = (const float*)d_in[10];
    a.w_gate = (const float*)d_in[11]; a.w_up = (const float*)d_in[12]; a.w_down = (const float*)d_in[13]; a.final_g = (const float*)d_in[14];
    a.out = (float*)d_out; a.ws = (unsigned char*)d_ws;
#if MK_PER_PHASE
    for (int p = 0; p < N_PHASES; ++p) { a.ph_lo = p; a.ph_hi = p + 1; hipLaunchKernelGGL(mega_fwd, dim3(grid), dim3(NWAVES * 64), LDS_BYTES, stream, a); }
#else
    a.ph_lo = 0; a.ph_hi = N_PHASES; hipLaunchKernelGGL(mega_fwd, dim3(grid), dim3(NWAVES * 64), LDS_BYTES, stream, a);
#endif
    const hipError_t le = hipPeekAtLastError();
    if (le != hipSuccess) fprintf(stderr, "kernel_launch: launch failed: %s\n", hipGetErrorName(le));
}
```

```cpp
#include <hip/hip_runtime.h>
#include <hip/hip_bf16.h>
#include <cstdio>
#include <cstdint>
__device__ __forceinline__ float shx(float v, int off, int lane) { return __int_as_float(__builtin_amdgcn_ds_bpermute((lane ^ off) << 2, __float_as_int(v))); }
__device__ __forceinline__ int shi(int v, int src) { return __builtin_amdgcn_ds_bpermute(src << 2, v); }
namespace pg8 {
#define PG8_LAS __attribute__((address_space(3)))
typedef unsigned short bf16_t;
typedef short bf16x8 __attribute__((ext_vector_type(8)));
typedef float f32x4 __attribute__((ext_vector_type(4)));
typedef unsigned u32x4 __attribute__((ext_vector_type(4)));
constexpr int BM = 256, BK = 64, HALF = 128, HTB = HALF * BK * 2  , STAGE_BYTES = 8 * HTB, NXCD = 8, WGM = 8;

__host__ __device__ __forceinline__ int lds_byte(int r, int c) { const int st = (r >> 4) * 2 + (c >> 5), rr = r & 15, cc = c & 31, ob = rr * 64 + cc * 2; return st * 1024 + (ob ^ (((ob >> 9) & 1) << 5)); }
__host__ __device__ __forceinline__ void stage_rc(int b, int& R, int& C) { const int st = b / 1024, sb = b % 1024, swz = sb ^ (((sb >> 9) & 1) << 5); R = (st >> 1) * 16 + swz / 64; C = (st & 1) * 32 + (swz % 64) / 2; }
__host__ __device__ __forceinline__ int perm32(int rho) { const int n = rho >> 4, i = rho & 15; return 8 * (i >> 2) + 4 * n + (i & 3); }

struct Unit { int pm, pn; };
struct Gemm { const bf16_t* A; const bf16_t* Bt; int M, N, K; int gshift; size_t gstride; const int* gidx; };

struct StaticOrder {
    int nM, nN, nwg, G, c;
    __host__ __device__ void init(int M, int N, int G_, int c_) { nM = M / BM; nN = N / BM; nwg = nM * nN; G = G_; c = c_; }
    __host__ __device__ bool next(int i, Unit& u) const {
        const long L = (long)i * G + c; if (L >= nwg) return false;
        int wgid = (int)L; { const int q = nwg / NXCD, r = nwg % NXCD, xcd = wgid % NXCD, off = wgid / NXCD; wgid = (xcd < r ? xcd * (q + 1) : r * (q + 1) + (xcd - r) * q) + off; }
        const int nig = WGM * nN, gid = wgid / nig, fm = gid * WGM, gsz = (nM - fm) < WGM ? (nM - fm) : WGM;
        u.pm = fm + ((wgid % nig) % gsz); u.pn = (wgid % nig) / gsz; return true;
    }
    __device__ __forceinline__ void a_ready(const Unit&) const {}
    __device__ __forceinline__ void done(const Unit&) const {}
};

#define PG8_GAS __attribute__((address_space(1)))
typedef float f32x2 __attribute__((ext_vector_type(2)));
typedef __bf16 bf16x2_t __attribute__((ext_vector_type(2)));
__device__ __forceinline__ unsigned cvt_pk_bf16(float lo, float hi) { f32x2 v = {lo, hi}; bf16x2_t b = __builtin_convertvector(v, bf16x2_t); return __builtin_bit_cast(unsigned, b); }
__device__ __forceinline__ u32x4 pack8(const f32x4 v0, const f32x4 v1) { u32x4 w; w.x = cvt_pk_bf16(v0[0], v0[1]); w.y = cvt_pk_bf16(v0[2], v0[3]); w.z = cvt_pk_bf16(v1[0], v1[1]); w.w = cvt_pk_bf16(v1[2], v1[3]); return w; }
__device__ __forceinline__ float sigmoidf_(float x) { return __builtin_amdgcn_rcpf(1.0f + __expf(-x)); }
__device__ __forceinline__ f32x4 silu4(const f32x4 v) { f32x4 o; o[0] = v[0] * sigmoidf_(v[0]); o[1] = v[1] * sigmoidf_(v[1]); o[2] = v[2] * sigmoidf_(v[2]); o[3] = v[3] * sigmoidf_(v[3]); return o; }

struct EpiInProj {
    static constexpr bool PERM = true, AFTER_DRAIN = false;
    bf16_t *Q, *Kb, *V, *HQ, *KK, *HV, *HG; unsigned short* LF;   const float* rope; const float* lbs;
    float qscale; unsigned* kmax; int nostore; const float* rs;
    __device__ __forceinline__ void operator()(const f32x4 (&acc)[2][2][4][2], const Unit& u, int wr, int wc, int fr, int fq) const {
        const int seg = u.pn >> 2, tp = u.pn & 3;
        const int row0 = u.pm * BM + wr * 64 + fr;
        if (seg < 2) {
            bf16_t* dst = seg == 0 ? Q : Kb; const float sc = seg == 0 ? qscale : 1.0f;
            const int col = (tp * 4 + wc) * 64 + 8 * fq;
            float kmx = 0.f;
#pragma unroll
            for (int ai = 0; ai < 2; ++ai)
#pragma unroll
                for (int m = 0; m < 4; ++m) { const int row = row0 + ai * HALF + m * 16;
                    const float* tb = rope + (size_t)row * 64 + 8 * fq;
                    const f32x4 c0 = *(const PG8_GAS f32x4*)(tb), c1 = *(const PG8_GAS f32x4*)(tb + 4), s0 = *(const PG8_GAS f32x4*)(tb + 32), s1 = *(const PG8_GAS f32x4*)(tb + 36);
                    const float r_ = ((const PG8_GAS float*)rs)[row]; const f32x4 xa = acc[ai][0][m][0] * r_, xb = acc[ai][0][m][1] * r_, ya = acc[ai][1][m][0] * r_, yb = acc[ai][1][m][1] * r_;
                    const f32x4 o1a = (xa * c0 - ya * s0) * sc, o1b = (xb * c1 - yb * s1) * sc, o2a = (ya * c0 + xa * s0) * sc, o2b = (yb * c1 + xb * s1) * sc;
                    bf16_t* rowp = dst + (size_t)row * 1024 + col;
                    if (!nostore) { *(PG8_GAS u32x4*)(rowp) = pack8(o1a, o1b); *(PG8_GAS u32x4*)(rowp + 32) = pack8(o2a, o2b); }
                    if (seg == 1) { const f32x4 q2 = xa * xa + xb * xb + ya * ya + yb * yb; float ss = (q2[0] + q2[1]) + (q2[2] + q2[3]);
                        ss += shx(ss, 16, fq * 16 + fr); ss += shx(ss, 32, fq * 16 + fr); kmx = fmaxf(kmx, ss); } }
            if (seg == 1) {
#pragma unroll
                for (int o_ = 1; o_ < 16; o_ <<= 1) kmx = fmaxf(kmx, shx(kmx, o_, fq * 16 + fr));
                if (fr == 0 && fq == 0) __hip_atomic_fetch_max(kmax + tp * 4 + wc, __float_as_uint(sqrtf(kmx)), __ATOMIC_RELAXED, __HIP_MEMORY_SCOPE_AGENT); }
        } else if (seg == 4 || seg == 5) {
            const int dir = seg - 4;
#pragma unroll
            for (int bj = 0; bj < 2; ++bj) { const int col = tp * 256 + bj * HALF + wc * 32 + 8 * fq;
                const f32x4 lb0 = *(const PG8_GAS f32x4*)(lbs + dir * 4096 + col), lb1 = *(const PG8_GAS f32x4*)(lbs + dir * 4096 + col + 4);
#pragma unroll
                for (int ai = 0; ai < 2; ++ai)
#pragma unroll
                    for (int m = 0; m < 4; ++m) { const int row = row0 + ai * HALF + m * 16;
                        f32x4 lf0, lf1, k0, k1; const float r_ = ((const PG8_GAS float*)rs)[row];
#pragma unroll
                        for (int q = 0; q < 4; ++q) { const float z0 = fminf(fmaxf(acc[ai][bj][m][0][q] * r_, -80.f), 80.f), z1 = fminf(fmaxf(acc[ai][bj][m][1][q] * r_, -80.f), 80.f);
                            const float e0 = __expf(-z0), e1 = __expf(-z1), sg0 = __builtin_amdgcn_rcpf(1.0f + e0), sg1 = __builtin_amdgcn_rcpf(1.0f + e1);
                            lf0[q] = __logf(lb0[q] + (1.0f - lb0[q]) * sg0); lf1[q] = __logf(lb1[q] + (1.0f - lb1[q]) * sg1);
                            k0[q] = (1.0f - lb0[q]) * (e0 * sg0); k1[q] = (1.0f - lb1[q]) * (e1 * sg1); }
                        unsigned short* lfp = LF + (size_t)row * 2048 + dir * 1024 + col; if (!nostore) { typedef _Float16 h2_t __attribute__((ext_vector_type(2))); u32x4 hw_;
                        hw_.x = __builtin_bit_cast(unsigned, __builtin_convertvector((f32x2){lf0[0], lf0[1]}, h2_t)); hw_.y = __builtin_bit_cast(unsigned, __builtin_convertvector((f32x2){lf0[2], lf0[3]}, h2_t));
                        hw_.z = __builtin_bit_cast(unsigned, __builtin_convertvector((f32x2){lf1[0], lf1[1]}, h2_t)); hw_.w = __builtin_bit_cast(unsigned, __builtin_convertvector((f32x2){lf1[2], lf1[3]}, h2_t)); *(u32x4*)lfp = hw_;
                        *(PG8_GAS u32x4*)(KK + (size_t)row * 2048 + dir * 1024 + col) = pack8(k0, k1); } else if (lf0[0] + lf1[1] + k0[2] + k1[3] == 12345.678f) *lfp = 0; }
            }
        } else {
            bf16_t* dst = seg == 2 ? V : seg == 3 ? HQ : seg == 6 ? HV : HG;
#pragma unroll
            for (int bj = 0; bj < 2; ++bj) { const int col = tp * 256 + bj * HALF + wc * 32 + 8 * fq;
#pragma unroll
                for (int ai = 0; ai < 2; ++ai)
#pragma unroll
                    for (int m = 0; m < 4; ++m) { const int row = row0 + ai * HALF + m * 16;
                        const float r_ = ((const PG8_GAS float*)rs)[row]; f32x4 v0 = acc[ai][bj][m][0] * r_, v1 = acc[ai][bj][m][1] * r_;
                        if (seg == 3) { v0 = silu4(v0) * 0.08838834764831845f; v1 = silu4(v1) * 0.08838834764831845f; }
                        else if (seg == 7) { v0 = silu4(v0); v1 = silu4(v1); }
                        if (!nostore) *(PG8_GAS u32x4*)(dst + (size_t)row * 1024 + col) = pack8(v0, v1); else if (v0[0] + v1[1] == 12345.678f) dst[0] = 0; }
            }
        }
    }
};
template <bool F32BASE> struct EpiResidBf {
    static constexpr bool PERM = true, AFTER_DRAIN = false;
    const float* xf; bf16_t* X;
    __device__ __forceinline__ void operator()(const f32x4 (&acc)[2][2][4][2], const Unit& u, int wr, int wc, int fr, int fq) const {
#pragma unroll
        for (int ai = 0; ai < 2; ++ai)
#pragma unroll
            for (int m = 0; m < 4; ++m) { const size_t row = (size_t)(u.pm * BM + ai * HALF + wr * 64 + m * 16 + fr);
#pragma unroll
                for (int bj = 0; bj < 2; ++bj) { const size_t off = row * 2048 + u.pn * BM + bj * HALF + wc * 32 + 8 * fq;
                    f32x4 b0, b1;
                    if (F32BASE) { b0 = *(const PG8_GAS f32x4*)(xf + off); b1 = *(const PG8_GAS f32x4*)(xf + off + 4); }
                    else { const u32x4 w = *(const PG8_GAS u32x4*)(X + off); b0 = (f32x4){__uint_as_float(w.x << 16), __uint_as_float(w.x & 0xffff0000u), __uint_as_float(w.y << 16), __uint_as_float(w.y & 0xffff0000u)};
                           b1 = (f32x4){__uint_as_float(w.z << 16), __uint_as_float(w.z & 0xffff0000u), __uint_as_float(w.w << 16), __uint_as_float(w.w & 0xffff0000u)}; }
                    *(PG8_GAS u32x4*)(X + off) = pack8(b0 + acc[ai][bj][m][0], b1 + acc[ai][bj][m][1]); } }
    }
};
struct EpiSwiGLU {
    static constexpr bool PERM = true, AFTER_DRAIN = false;
    bf16_t* H; const float* rsg;
    __device__ __forceinline__ void operator()(const f32x4 (&acc)[2][2][4][2], const Unit& u, int wr, int wc, int fr, int fq) const {
        const int col = u.pn * HALF + wc * 32 + 8 * fq;
#pragma unroll
        for (int ai = 0; ai < 2; ++ai)
#pragma unroll
            for (int m = 0; m < 4; ++m) { const int row = u.pm * BM + ai * HALF + wr * 64 + m * 16 + fr; const float r_ = ((const PG8_GAS float*)rsg)[row];
                const f32x4 h0 = silu4(acc[ai][0][m][0] * r_) * (acc[ai][1][m][0] * r_), h1 = silu4(acc[ai][0][m][1] * r_) * (acc[ai][1][m][1] * r_);
                *(PG8_GAS u32x4*)(H + (size_t)row * 1024 + col) = pack8(h0, h1); }
    }
};
struct EpiDown {
    static constexpr bool PERM = true, AFTER_DRAIN = false;
    bf16_t* Y; const float* gate;
    __device__ __forceinline__ void operator()(const f32x4 (&acc)[2][2][4][2], const Unit& u, int wr, int wc, int fr, int fq) const {
#pragma unroll
        for (int ai = 0; ai < 2; ++ai)
#pragma unroll
            for (int m = 0; m < 4; ++m) { const int row = u.pm * BM + ai * HALF + wr * 64 + m * 16 + fr; const float g = ((const PG8_GAS float*)gate)[row];
#pragma unroll
                for (int bj = 0; bj < 2; ++bj) { const int col = u.pn * BM + bj * HALF + wc * 32 + 8 * fq;
                    *(PG8_GAS u32x4*)(Y + (size_t)row * 2048 + col) = pack8(acc[ai][bj][m][0] * g, acc[ai][bj][m][1] * g); } }
    }
};
template <class Epi, class Sched, bool ALIGN_EPI = false, bool SP2 = false, bool GATHER = false>
__device__ __forceinline__ void gemm_phase(PG8_LAS unsigned char* lds, const Gemm g, const Sched& S, const Epi& E, const int tid) {
    const int wid = __builtin_amdgcn_readfirstlane(tid >> 6), lane = tid & 63, wr = wid >> 2, wc = wid & 3, fr = lane & 15, fq = lane >> 4;
    const int K = g.K, nt = K / BK;
    unsigned voffA[2], voffB[2];
#pragma unroll
    for (int i = 0; i < 2; ++i) { int R, C; stage_rc(tid * 16 + i * 8192, R, C); const int Rb = Epi::PERM ? ((R & ~31) + perm32(R & 31)) : R;
        voffA[i] = (unsigned)(R * K + C) * 2u; voffB[i] = (unsigned)(Rb * K + C) * 2u; }
    unsigned vgc[2][2], vgn[2][2];
#define PG8_GLOAD(u, v) do { _Pragma("unroll") for (int h_ = 0; h_ < 2; ++h_) _Pragma("unroll") for (int i_ = 0; i_ < 2; ++i_) { int R_, C_; stage_rc(tid * 16 + i_ * 8192, R_, C_); \
        v[h_][i_] = ((unsigned)g.gidx[(u).pm * BM + h_ * HALF + R_] * (unsigned)K + (unsigned)C_) * 2u; } } while (0)
#define PG8_STA(b, h, base, NX) do { if constexpr (GATHER) { const unsigned vv_[2] = {(NX) ? vgn[h][0] : vgc[h][0], (NX) ? vgn[h][1] : vgc[h][1]}; PG8_STAGE(PG8_SA(b, h), base, vv_); } \
        else { PG8_STAGE(PG8_SA(b, h), (base) + (h) * hstep, voffA); } } while (0)
    const size_t kstep = (size_t)(BK * 2);
    const size_t hstep = (size_t)HALF * K * 2;
    const size_t tstep = 2 * hstep;
    const unsigned ldsw = (unsigned)wid * 1024u;
    const int aoff = lds_byte(wr * 64 + fr, fq * 8), boff = lds_byte(wc * 32 + fr, fq * 8);
#define PG8_SA(b, h) (((b) * 2 + (h)) * HTB)
#define PG8_SB(b, h) ((4 + (b) * 2 + (h)) * HTB)
#define PG8_STAGE(bufoff, gbase, voff) do { _Pragma("unroll") for (int _i = 0; _i < 2; ++_i) \
        __builtin_amdgcn_global_load_lds((const unsigned*)((const char*)(gbase) + (voff)[_i]), (PG8_LAS unsigned*)(lds + (bufoff) + ldsw + _i * 8192), 16, 0, 0); } while (0)
#define PG8_LDA(dst, b, h) do { _Pragma("unroll") for (int m = 0; m < 4; ++m) _Pragma("unroll") for (int k = 0; k < 2; ++k) dst[m][k] = *(const PG8_LAS bf16x8*)(lds + PG8_SA(b, h) + aoff + m * 2048 + k * 1024); } while (0)
#define PG8_LDB(dst, b, h) do { _Pragma("unroll") for (int n = 0; n < 2; ++n) _Pragma("unroll") for (int k = 0; k < 2; ++k) dst[n][k] = *(const PG8_LAS bf16x8*)(lds + PG8_SB(b, h) + boff + n * 2048 + k * 1024); } while (0)
#define PG8_MMA(ai, bj, At, Bt) do { __builtin_amdgcn_s_setprio(1); _Pragma("unroll") for (int m = 0; m < 4; ++m) _Pragma("unroll") for (int n = 0; n < 2; ++n) _Pragma("unroll") for (int k = 0; k < 2; ++k) \
        acc[ai][bj][m][n] = __builtin_amdgcn_mfma_f32_16x16x32_bf16(Bt[n][k], At[m][k], acc[ai][bj][m][n], 0, 0, 0); __builtin_amdgcn_s_setprio(0); } while (0)
#define PG8_WAIT_V(n) asm volatile("s_waitcnt vmcnt(" #n ")" ::: "memory")
#define PG8_WAIT_L(n) asm volatile("s_waitcnt lgkmcnt(" #n ")" ::: "memory")
#define PG8_BAR __builtin_amdgcn_s_barrier()
#define PG8_SCHED __builtin_amdgcn_sched_barrier(0)
    Unit cur, nxt; int ui = 0;
    if (!S.next(0, cur)) return;
    f32x4 acc[2][2][4][2];
#pragma unroll
    for (int a = 0; a < 2; ++a)
#pragma unroll
        for (int b = 0; b < 2; ++b)
#pragma unroll
            for (int m = 0; m < 4; ++m)
#pragma unroll
                for (int n = 0; n < 2; ++n) acc[a][b][m][n] = (f32x4){0.f, 0.f, 0.f, 0.f};
    bf16x8 At[4][2], B0[2][2], B1[2][2];
    if constexpr (GATHER) PG8_GLOAD(cur, vgc);
    const char* cA = (const char*)g.A + (GATHER ? (size_t)0 : (size_t)cur.pm * tstep); const char* cB = (const char*)g.Bt + (size_t)(cur.pm >> g.gshift) * g.gstride + (size_t)cur.pn * tstep;
    S.a_ready(cur);
    if constexpr (SP2) {
        PG8_STAGE(PG8_SB(0, 0), cB, voffB); PG8_STAGE(PG8_SB(0, 1), cB + hstep, voffB); PG8_STA(0, 0, cA, false); PG8_STA(0, 1, cA, false);
        if (wr == 1) PG8_BAR;
        PG8_WAIT_V(2); PG8_BAR;
        PG8_STAGE(PG8_SB(1, 0), cB + kstep, voffB); PG8_STA(1, 0, cA + kstep, false); PG8_STAGE(PG8_SB(1, 1), cB + hstep + kstep, voffB);
        PG8_WAIT_V(6); PG8_BAR;
    } else {
        PG8_STAGE(PG8_SB(0, 0), cB, voffB); PG8_STA(0, 0, cA, false); PG8_STAGE(PG8_SB(0, 1), cB + hstep, voffB); PG8_STA(0, 1, cA, false);
        if (wr == 1) PG8_BAR;
        PG8_WAIT_V(4); PG8_BAR;
        PG8_STAGE(PG8_SB(1, 0), cB + kstep, voffB); PG8_STA(1, 0, cA + kstep, false); PG8_STAGE(PG8_SB(1, 1), cB + hstep + kstep, voffB);
        PG8_WAIT_V(6); PG8_BAR;
    }
    for (;;) {
        const bool has_next = S.next(ui + 1, nxt);
        if constexpr (GATHER) { if (has_next) PG8_GLOAD(nxt, vgn); else { vgn[0][0] = vgc[0][0]; vgn[0][1] = vgc[0][1]; vgn[1][0] = vgc[1][0]; vgn[1][1] = vgc[1][1]; } }
        const char* nA = (has_next && !GATHER) ? (const char*)g.A + (size_t)nxt.pm * tstep : cA; const char* nB = has_next ? (const char*)g.Bt + (size_t)(nxt.pm >> g.gshift) * g.gstride + (size_t)nxt.pn * tstep : cB;
        for (int t = 0; t < nt; t += 2) {
            const bool last = (t == nt - 2);
            const char* a1 = cA + (size_t)(t + 1) * kstep;
            const char* a2 = last ? nA : cA + (size_t)(t + 2) * kstep; const char* b2 = last ? nB : cB + (size_t)(t + 2) * kstep;
            const char* a3 = a2 + kstep; const char* b3 = b2 + kstep;
            if (last && has_next) S.a_ready(nxt);
            if constexpr (SP2) {
            PG8_LDB(B0, 0, 0); PG8_LDB(B1, 0, 1); PG8_SCHED; PG8_LDA(At, 0, 0); PG8_STA(1, 1, a1, false);
            PG8_WAIT_V(8); PG8_WAIT_L(0); PG8_BAR; PG8_MMA(0, 0, At, B0); PG8_MMA(0, 1, At, B1); PG8_BAR; PG8_SCHED;
            PG8_LDA(At, 0, 1); PG8_STAGE(PG8_SB(0, 0), b2, voffB); PG8_STAGE(PG8_SB(0, 1), b2 + hstep, voffB); PG8_STA(0, 0, a2, last);
            PG8_WAIT_V(8); PG8_WAIT_L(0); PG8_BAR; PG8_MMA(1, 0, At, B0); PG8_MMA(1, 1, At, B1); PG8_BAR; PG8_SCHED;
            PG8_LDB(B0, 1, 0); PG8_LDB(B1, 1, 1); PG8_SCHED; PG8_LDA(At, 1, 0); PG8_STA(0, 1, a2, last);
            PG8_WAIT_V(8); PG8_WAIT_L(0); PG8_BAR; PG8_MMA(0, 0, At, B0); PG8_MMA(0, 1, At, B1); PG8_BAR; PG8_SCHED;
            PG8_LDA(At, 1, 1); PG8_STAGE(PG8_SB(1, 0), b3, voffB); PG8_STAGE(PG8_SB(1, 1), b3 + hstep, voffB); PG8_STA(1, 0, a3, last);
            PG8_WAIT_V(8); PG8_WAIT_L(0); PG8_BAR; PG8_MMA(1, 0, At, B0); PG8_MMA(1, 1, At, B1); PG8_BAR; PG8_SCHED;
            } else {
            PG8_LDB(B0, 0, 0); PG8_SCHED; PG8_LDA(At, 0, 0); PG8_STA(1, 1, a1, false);
            PG8_WAIT_L(8); PG8_BAR; PG8_WAIT_L(0); PG8_MMA(0, 0, At, B0); PG8_BAR; PG8_SCHED;
            PG8_LDB(B1, 0, 1); PG8_STAGE(PG8_SB(0, 0), b2, voffB);
            PG8_BAR; PG8_WAIT_L(0); PG8_MMA(0, 1, At, B1); PG8_BAR;
            PG8_LDA(At, 0, 1); PG8_STA(0, 0, a2, last);
            PG8_BAR; PG8_WAIT_L(0); PG8_MMA(1, 0, At, B0); PG8_BAR; PG8_SCHED;
            PG8_STAGE(PG8_SB(0, 1), b2 + hstep, voffB);
            PG8_WAIT_V(6); PG8_BAR; PG8_MMA(1, 1, At, B1); PG8_BAR;
            PG8_LDB(B0, 1, 0); PG8_SCHED; PG8_LDA(At, 1, 0); PG8_STA(0, 1, a2, last);
            PG8_WAIT_L(8); PG8_BAR; PG8_WAIT_L(0); PG8_MMA(0, 0, At, B0); PG8_BAR; PG8_SCHED;
            PG8_LDB(B1, 1, 1); PG8_STAGE(PG8_SB(1, 0), b3, voffB);
            PG8_BAR; PG8_WAIT_L(0); PG8_MMA(0, 1, At, B1); PG8_BAR;
            PG8_LDA(At, 1, 1); PG8_STA(1, 0, a3, last);
            PG8_BAR; PG8_WAIT_L(0); PG8_MMA(1, 0, At, B0); PG8_BAR; PG8_SCHED;
            PG8_STAGE(PG8_SB(1, 1), b3 + hstep, voffB);
            PG8_WAIT_V(6); PG8_BAR; PG8_MMA(1, 1, At, B1); PG8_BAR;
            }
        }
        if constexpr (ALIGN_EPI) { if (wr == 0) PG8_BAR; }
        if constexpr (!Epi::AFTER_DRAIN) { E(acc, cur, wr, wc, fr, fq); S.done(cur); }
        if (!has_next) break;
#pragma unroll
        for (int a = 0; a < 2; ++a)
#pragma unroll
            for (int b = 0; b < 2; ++b)
#pragma unroll
                for (int m = 0; m < 4; ++m)
#pragma unroll
                    for (int n = 0; n < 2; ++n) acc[a][b][m][n] = (f32x4){0.f, 0.f, 0.f, 0.f};
        cur = nxt; cA = nA; cB = nB; ++ui;
        if constexpr (GATHER) { vgc[0][0] = vgn[0][0]; vgc[0][1] = vgn[0][1]; vgc[1][0] = vgn[1][0]; vgc[1][1] = vgn[1][1]; }
        if constexpr (ALIGN_EPI) { if (wr == 1) PG8_BAR; }
    }
    PG8_WAIT_V(0);
    if constexpr (!ALIGN_EPI) { if (wr == 0) PG8_BAR; }
    PG8_BAR;
    if constexpr (Epi::AFTER_DRAIN) { E.fused(acc, cur, wr, wc, fr, fq, lds, wid, lane); S.done(cur); }
#undef PG8_SA
#undef PG8_SB
#undef PG8_STAGE
#undef PG8_LDA
#undef PG8_LDB
#undef PG8_MMA
#undef PG8_WAIT_V
#undef PG8_WAIT_L
#undef PG8_BAR
#undef PG8_SCHED
#undef PG8_STA
#undef PG8_GLOAD
}
}

namespace att {
using bf16 = unsigned short;
using bf16x8 = __attribute__((ext_vector_type(8))) short;
using s16x4  = __attribute__((ext_vector_type(4))) short;
using f32x16 = __attribute__((ext_vector_type(16))) float;
using u32x4  = __attribute__((ext_vector_type(4))) unsigned;
constexpr int NW = 8, QBLK = 32, KVBLK = 64, SEQ = 16384, LDQ = 1024, LDMIX = 2048;
constexpr int SHM_V = KVBLK * 128 * 2, SHM_K = KVBLK * 64 * 2;
constexpr int OFF_V = 0, OFF_K = 2 * SHM_V, OFF_WS = OFF_K + 2 * SHM_K, LDS_BYTES = OFF_WS + NW * 64 * 4;
constexpr float THR2 = 11.0f;
#define AT_LAS __attribute__((address_space(3)))
#define AT_KSWZ(row, colB) ((row) * 128 + ((colB) ^ ((((row) >> 1) & 7) << 4)))
#define AT_SBAR() __builtin_amdgcn_sched_barrier(0)
__device__ __forceinline__ int crow(int r, int hi) { return (r & 3) + 8 * (r >> 2) + 4 * hi; }
__device__ __forceinline__ unsigned cvtpk(float lo, float hi) { unsigned r; asm volatile("v_cvt_pk_bf16_f32 %0, %1, %2" : "=v"(r) : "v"(lo), "v"(hi)); return r; }

__device__ __forceinline__ void partialSM(f32x16& p0, f32x16& p1, float& m_reg, float& alpha) {
  float pmax = p0[0];
#pragma unroll
  for (int r = 1; r < 16; ++r) pmax = fmaxf(pmax, p0[r]);
#pragma unroll
  for (int r = 0; r < 16; ++r) pmax = fmaxf(pmax, p1[r]);
  { auto rr = __builtin_amdgcn_permlane32_swap(__float_as_uint(pmax), __float_as_uint(pmax), false, false);
    pmax = fmaxf(__uint_as_float(rr[0]), __uint_as_float(rr[1])); }
  float mn;
  if (__builtin_expect(__all(pmax - m_reg <= THR2), 1)) { mn = m_reg; alpha = 1.f; }
  else { mn = fmaxf(m_reg, pmax); alpha = __builtin_amdgcn_exp2f(m_reg - mn); m_reg = mn; }
#pragma unroll
  for (int r = 0; r < 16; ++r) { p0[r] -= mn; p1[r] -= mn; }
#pragma unroll
  for (int r = 0; r < 16; ++r) p0[r] = __builtin_amdgcn_exp2f(p0[r]);
}
__device__ __forceinline__ void finishSM(f32x16& p0, f32x16& p1, float alpha, float& l_reg, bf16x8& pa0, bf16x8& pa1, bf16x8& pa2, bf16x8& pa3) {
#pragma unroll
  for (int r = 0; r < 16; ++r) p1[r] = __builtin_amdgcn_exp2f(p1[r]);
  float ps = 0;
#pragma unroll
  for (int r = 0; r < 16; ++r) ps += p0[r];
#pragma unroll
  for (int r = 0; r < 16; ++r) ps += p1[r];
  { auto rr = __builtin_amdgcn_permlane32_swap(__float_as_uint(ps), __float_as_uint(ps), false, false);
    ps = __uint_as_float(rr[0]) + __uint_as_float(rr[1]); }
  l_reg = l_reg * alpha + ps;
#define AT_PK4(P, BASE, OUT) do { unsigned a0 = cvtpk(P[BASE + 0], P[BASE + 1]), a1 = cvtpk(P[BASE + 2], P[BASE + 3]);   \
    unsigned b0 = cvtpk(P[BASE + 4], P[BASE + 5]), b1 = cvtpk(P[BASE + 6], P[BASE + 7]);                              \
    auto r0 = __builtin_amdgcn_permlane32_swap(a0, b0, false, false); auto r1 = __builtin_amdgcn_permlane32_swap(a1, b1, false, false); \
    u32x4 w = {r0[0], r1[0], r0[1], r1[1]}; OUT = __builtin_bit_cast(bf16x8, w); } while (0)
  AT_PK4(p0, 0, pa0); AT_PK4(p0, 8, pa1); AT_PK4(p1, 0, pa2); AT_PK4(p1, 8, pa3);
#undef AT_PK4
}
__device__ __forceinline__ void qkt(f32x16& p0, f32x16& p1, const AT_LAS char* Ks, const bf16x8 (&qr)[4], int r32, int hi) {
  p0 = f32x16{}; p1 = f32x16{};
#pragma unroll
  for (int d0 = 0; d0 < 4; ++d0) { const int cb = (d0 * 16 + hi * 8) * 2;
    const bf16x8 b0 = *(const AT_LAS bf16x8*)(Ks + AT_KSWZ(r32, cb));
    const bf16x8 b1 = *(const AT_LAS bf16x8*)(Ks + AT_KSWZ(32 + r32, cb));
    p0 = __builtin_amdgcn_mfma_f32_32x32x16_bf16(b0, qr[d0], p0, 0, 0, 0);
    p1 = __builtin_amdgcn_mfma_f32_32x32x16_bf16(b1, qr[d0], p1, 0, 0, 0); }
}
__device__ __forceinline__ int v_st(int k, int c) { const int kk = (k & ~0xC) | ((k & 4) << 1) | ((k & 8) >> 1); return ((kk >> 3) * 4 + (c >> 5)) * 512 + ((kk & 7) * 32 + (c & 31)) * 2; }
__device__ __forceinline__ int v_rd_base(int lane) { return ((lane & 3) << 3) | (((lane >> 2) & 3) << 6) | (((lane >> 4) & 1) << 5) | (((lane >> 5) & 1) << 8); }
constexpr int v_rd_off(int d0, int ks, int half) { return d0 * 512 + ks * 4096 + half * 2048; }
template <int OFF> __device__ __forceinline__ s16x4 tr_read(int vb) {
  s16x4 r; asm volatile("ds_read_b64_tr_b16 %0, %1 offset:%2" : "=&v"(r) : "v"(vb), "i"(OFF) : "memory"); return r;
}
template <int D0> __device__ __forceinline__ void pv_one(f32x16& od, int vb, bf16x8 pa0, bf16x8 pa1, bf16x8 pa2, bf16x8 pa3) {
  const s16x4 l0 = tr_read<v_rd_off(D0, 0, 0)>(vb), h0 = tr_read<v_rd_off(D0, 0, 1)>(vb), l1 = tr_read<v_rd_off(D0, 1, 0)>(vb), h1 = tr_read<v_rd_off(D0, 1, 1)>(vb);
  const s16x4 l2 = tr_read<v_rd_off(D0, 2, 0)>(vb), h2 = tr_read<v_rd_off(D0, 2, 1)>(vb), l3 = tr_read<v_rd_off(D0, 3, 0)>(vb), h3 = tr_read<v_rd_off(D0, 3, 1)>(vb);
  asm volatile("s_waitcnt lgkmcnt(0)" ::: "memory"); AT_SBAR();
#define AT_PK(L, H) (bf16x8){L[0], L[1], L[2], L[3], H[0], H[1], H[2], H[3]}
  od = __builtin_amdgcn_mfma_f32_32x32x16_bf16(pa0, AT_PK(l0, h0), od, 0, 0, 0);
  od = __builtin_amdgcn_mfma_f32_32x32x16_bf16(pa1, AT_PK(l1, h1), od, 0, 0, 0);
  od = __builtin_amdgcn_mfma_f32_32x32x16_bf16(pa2, AT_PK(l2, h2), od, 0, 0, 0);
  od = __builtin_amdgcn_mfma_f32_32x32x16_bf16(pa3, AT_PK(l3, h3), od, 0, 0, 0);
#undef AT_PK
}
__device__ __forceinline__ void pv_d0(f32x16 (&o)[4], int vb, bf16x8 pa0, bf16x8 pa1, bf16x8 pa2, bf16x8 pa3) {
  pv_one<0>(o[0], vb, pa0, pa1, pa2, pa3); pv_one<1>(o[1], vb, pa0, pa1, pa2, pa3); pv_one<2>(o[2], vb, pa0, pa1, pa2, pa3); pv_one<3>(o[3], vb, pa0, pa1, pa2, pa3);
}

struct AttnArgs { const bf16* Q; const bf16* K; const bf16* V; const bf16* VT; float* AO1; bf16* MIX; const float* subg; const float* kmax; float lam; float outscale; };

#ifndef AT_STAGGER
#define AT_STAGGER 0
#endif
#ifndef AT_PF
#define AT_PF 2
#endif
constexpr int NBUF = 5, BUF_BYTES = SHM_K + SHM_V;
constexpr int OFF_WS2 = NBUF * BUF_BYTES, LDS_BYTES2 = OFF_WS2 + NW * 64 * 4;
__device__ __forceinline__ void glds16(const void* gsrc, unsigned lds_dst) { unsigned keep;
  asm volatile("s_mov_b32 %0, m0\n\ts_mov_b32 m0, %2\n\ts_nop 0\n\tglobal_load_lds_dwordx4 %1, off\n\ts_mov_b32 m0, %0" : "=&s"(keep) : "v"(gsrc), "s"(lds_dst) : "memory"); }
__device__ __forceinline__ void glds16s(const void* sbase, unsigned voff, unsigned lds_dst) { unsigned keep;
  asm volatile("s_mov_b32 %0, m0\n\ts_mov_b32 m0, %3\n\ts_nop 4\n\tglobal_load_lds_dwordx4 %1, %2\n\ts_mov_b32 m0, %0" : "=&s"(keep) : "v"(voff), "s"(sbase), "s"(lds_dst) : "memory"); }
#define AT_WAIT_BAR(N) asm volatile("s_waitcnt vmcnt(" #N ") lgkmcnt(0)\n\ts_barrier" ::: "memory")

template <int VAR>
__device__ __forceinline__ void attn_unit(const AttnArgs& A, int h, int qt, AT_LAS char* lds, const int tid) {
  const int q0 = qt * 256;
  const unsigned lds0 = (unsigned)(uintptr_t)lds;
  constexpr int NT = SEQ / KVBLK;
#pragma unroll 1
  for (int mp = 0; mp < 2; ++mp) {
    int tl = tid; asm volatile("" : "+v"(tl));
    const int lane = tl & 63, r32 = lane & 31, hi = lane >> 5; const int wid = __builtin_amdgcn_readfirstlane(tl >> 6);
    AT_LAS float* li_l = (AT_LAS float*)(lds + OFF_WS2) + wid * 64;
    int koff, voff0, voff1;
    { const int row = 8 * wid + (lane >> 3), cpos = lane & 7; koff = row * LDQ + 8 * (cpos ^ ((row >> 1) & 7)); }
    { const int B = (2 * wid) * 1024 + lane * 16, sub = B >> 9, wel = (B & 511) >> 1, kk = (sub >> 2) * 8 + (wel >> 5), k = (kk & ~0xC) | ((kk & 4) << 1) | ((kk & 8) >> 1); voff0 = k * LDQ + (sub & 3) * 32 + (wel & 31); }
    { const int B = (2 * wid + 1) * 1024 + lane * 16, sub = B >> 9, wel = (B & 511) >> 1, kk = (sub >> 2) * 8 + (wel >> 5), k = (kk & ~0xC) | ((kk & 4) << 1) | ((kk & 8) >> 1); voff1 = k * LDQ + (sub & 3) * 32 + (wel & 31); }
    const unsigned kdst = lds0 + wid * 1024, vdst = lds0 + SHM_K + wid * 2048;
    const int vrd = (int)lds0 + SHM_K + v_rd_base(lane);
    const bf16* Vh = A.V + h * 128;
    const bf16* Kh = A.K + (h * 2 + mp) * 64;
    const bf16* Qw = A.Q + (size_t)(q0 + wid * QBLK + r32) * LDQ + (h * 2 + mp) * 64 + hi * 8;
    const unsigned kob = (unsigned)koff * 2u, vob0 = (unsigned)voff0 * 2u, vob1 = (unsigned)voff1 * 2u;
#define AT_DMA(t, boff) do { const size_t to_ = (size_t)(t) * (KVBLK * LDQ); const unsigned bo_ = (unsigned)__builtin_amdgcn_readfirstlane(boff); \
    glds16s(Kh + to_, kob, (unsigned)__builtin_amdgcn_readfirstlane(kdst + bo_)); glds16s(Vh + to_, vob0, (unsigned)__builtin_amdgcn_readfirstlane(vdst + bo_)); glds16s(Vh + to_, vob1, (unsigned)__builtin_amdgcn_readfirstlane(vdst + bo_ + 1024u)); } while (0)
    __syncthreads();
    AT_DMA(0, 0); AT_DMA(1, BUF_BYTES); if (AT_PF == 3) AT_DMA(2, 2 * BUF_BYTES);
    bf16x8 qr[4];
#pragma unroll
    for (int d0 = 0; d0 < 4; ++d0) qr[d0] = *(const bf16x8*)(Qw + d0 * 16);
    float qss = 0.f;
#pragma unroll
    for (int d0 = 0; d0 < 4; ++d0)
#pragma unroll
      for (int e = 0; e < 8; ++e) { const float v = __uint_as_float(((unsigned)(unsigned short)qr[d0][e]) << 16); qss += v * v; }
    { auto rr = __builtin_amdgcn_permlane32_swap(__float_as_uint(qss), __float_as_uint(qss), false, false); qss = __uint_as_float(rr[0]) + __uint_as_float(rr[1]); }
    const float mref = sqrtf(qss) * A.kmax[h * 2 + mp] * 1.01f + 0.25f;
    f32x16 negm;
#pragma unroll
    for (int r = 0; r < 16; ++r) negm[r] = -mref;
    float l_reg = 0.f; f32x16 o[4]; o[0] = f32x16{}; o[1] = f32x16{}; o[2] = f32x16{}; o[3] = f32x16{};
    f32x16 sA0, sA1, sB0, sB1; bf16x8 pa0, pa1, pa2, pa3;
    if (VAR & 4) { sB0 = negm; sB1 = negm; }
    if (AT_PF == 3) AT_WAIT_BAR(3); else AT_WAIT_BAR(0);
#define AT_QKT_D(P0, P1, kb_, d0) do { const int cb = ((d0) * 16 + hi * 8) * 2; \
      const bf16x8 b0 = *(const AT_LAS bf16x8*)(kb_ + AT_KSWZ(r32, cb)); const bf16x8 b1 = *(const AT_LAS bf16x8*)(kb_ + AT_KSWZ(32 + r32, cb)); \
      if ((d0) == 0) { P0 = __builtin_amdgcn_mfma_f32_32x32x16_bf16(b0, qr[d0], negm, 0, 0, 0); P1 = __builtin_amdgcn_mfma_f32_32x32x16_bf16(b1, qr[d0], negm, 0, 0, 0); } \
      else { P0 = __builtin_amdgcn_mfma_f32_32x32x16_bf16(b0, qr[d0], P0, 0, 0, 0); P1 = __builtin_amdgcn_mfma_f32_32x32x16_bf16(b1, qr[d0], P1, 0, 0, 0); } } while (0)
#define AT_QKT(P0, P1, boff) do { const AT_LAS char* kb_ = lds + (boff); \
    AT_QKT_D(P0, P1, kb_, 0); AT_QKT_D(P0, P1, kb_, 1); AT_SBAR(); AT_QKT_D(P0, P1, kb_, 2); AT_QKT_D(P0, P1, kb_, 3); } while (0)
#define AT_SOFT(P0, P1) do { float ps = 0.f; \
    if (!(VAR & 1)) { _Pragma("unroll") for (int r = 0; r < 16; ++r) { P0[r] = __builtin_amdgcn_exp2f(P0[r]); P1[r] = __builtin_amdgcn_exp2f(P1[r]); } } \
    _Pragma("unroll") for (int r = 0; r < 16; ++r) ps += P0[r]; \
    _Pragma("unroll") for (int r = 0; r < 16; ++r) ps += P1[r]; \
    l_reg += ps; \
    AT_PK4(P0, 0, pa0); AT_PK4(P0, 8, pa1); AT_PK4(P1, 0, pa2); AT_PK4(P1, 8, pa3); } while (0)
#define AT_PK4(P, BASE, OUT) do { unsigned a0 = cvtpk(P[BASE + 0], P[BASE + 1]), a1 = cvtpk(P[BASE + 2], P[BASE + 3]);   \
    unsigned b0 = cvtpk(P[BASE + 4], P[BASE + 5]), b1 = cvtpk(P[BASE + 6], P[BASE + 7]);                              \
    auto r0 = __builtin_amdgcn_permlane32_swap(a0, b0, false, false); auto r1 = __builtin_amdgcn_permlane32_swap(a1, b1, false, false); \
    u32x4 w = {r0[0], r1[0], r0[1], r1[1]}; OUT = __builtin_bit_cast(bf16x8, w); } while (0)
#define AT_STEP(C0, C1, N0, N1, j) do { \
    if (!(VAR & 16) && (j) + AT_PF < NT) AT_DMA((j) + AT_PF, (AT_PF == 3 ? b4 : b3)); \
    AT_SBAR(); if (!(VAR & 2) && late && (j) > 0) pv_d0(o, vrd + b0, pa0, pa1, pa2, pa3); AT_SBAR(); \
    if (!(VAR & 4) && (j) + 1 < NT) AT_QKT(N0, N1, b2); AT_SBAR(); \
    AT_SOFT(C0, C1); AT_SBAR(); \
    if (!(VAR & 2) && !late) pv_d0(o, vrd + b1, pa0, pa1, pa2, pa3); \
    if (VAR & 32) asm volatile("s_waitcnt lgkmcnt(0)\n\ts_barrier" ::: "memory"); else if (AT_PF == 3 && (j) + 3 < NT) AT_WAIT_BAR(3); else AT_WAIT_BAR(0); \
    { const int t_ = b0; b0 = b1; b1 = b2; b2 = b3; b3 = b4; b4 = t_; } } while (0)

    const bool late = AT_STAGGER && wid >= 4;
    int b0 = 4 * BUF_BYTES, b1 = 0, b2 = BUF_BYTES, b3 = 2 * BUF_BYTES, b4 = 3 * BUF_BYTES;
    AT_QKT(sA0, sA1, b1);
    for (int j = 0; j < NT; j += 2) {
      AT_STEP(sA0, sA1, sB0, sB1, j);
      AT_STEP(sB0, sB1, sA0, sA1, j + 1);
    }
    if (late) pv_d0(o, vrd + b0, pa0, pa1, pa2, pa3);
#undef AT_STEP
#undef AT_PK4
#undef AT_SOFT
#undef AT_QKT
#undef AT_QKT_D
#undef AT_DMA
    { auto rr = __builtin_amdgcn_permlane32_swap(__float_as_uint(l_reg), __float_as_uint(l_reg), false, false); l_reg = __uint_as_float(rr[0]) + __uint_as_float(rr[1]); }
    if (hi == 0) li_l[r32] = l_reg; asm volatile("s_waitcnt lgkmcnt(0)" ::: "memory");
    int r32e = r32, hie = hi; asm volatile("" : "+v"(r32e), "+v"(hie));
    const unsigned ebase = (unsigned)((q0 + wid * QBLK + 4 * hie) * 1024 + h * 128 + r32e);
    if (mp == 0) {
#pragma unroll
      for (int r = 0; r < 16; ++r) { float* op = A.AO1 + (ebase + (unsigned)(((r & 3) + 8 * (r >> 2)) * 1024)); const float rl = __builtin_amdgcn_rcpf(li_l[crow(r, hi)]);
#pragma unroll
        for (int d0 = 0; d0 < 4; ++d0) op[d0 * 32] = o[d0][r] * rl;
        if ((r & 3) == 3) asm volatile("" ::: "memory"); }
    } else {
      float sg[4];
#pragma unroll
      for (int d0 = 0; d0 < 4; ++d0) sg[d0] = A.subg[d0 * 32 + r32e] * A.outscale;
#pragma unroll
      for (int r = 0; r < 16; ++r) { const unsigned eo = ebase + (unsigned)(((r & 3) + 8 * (r >> 2)) * 1024); const float* ip = A.AO1 + eo; const float rl = __builtin_amdgcn_rcpf(li_l[crow(r, hi)]) * A.lam;
        float v[4]; float ss = 0.f;
#pragma unroll
        for (int d0 = 0; d0 < 4; ++d0) { v[d0] = ip[d0 * 32] - o[d0][r] * rl; ss += v[d0] * v[d0]; }
#pragma unroll
        for (int off = 1; off < 32; off <<= 1) ss += shx(ss, off, lane);
        const float rs = rsqrtf(ss * (1.0f / 128.0f) + 1e-6f);
        bf16* mp_ = A.MIX + (eo + (eo & ~1023u));
#pragma unroll
        for (int d0 = 0; d0 < 4; ++d0) mp_[d0 * 32] = (bf16)(pg8::cvt_pk_bf16(v[d0] * rs * sg[d0], 0.f) & 0xffffu);
        if ((r & 3) == 3) asm volatile("" ::: "memory"); }
    }
  }
}
#undef AT_SBAR
}

namespace att {
#define A2_SBAR() __builtin_amdgcn_sched_barrier(0)
#ifndef A2_NVF
#define A2_NVF 6
#endif
#ifndef A2_PRIO
#define A2_PRIO 1
#endif
__device__ __forceinline__ void glds3(const void* kbase, unsigned kvo, unsigned kdst, const void* vbase, unsigned vo0, unsigned vo1, unsigned vdst) { unsigned keep;
  asm volatile("s_mov_b32 %0, m0\n\ts_mov_b32 m0, %3\n\ts_nop 4\n\tglobal_load_lds_dwordx4 %1, %2\n\t"
               "s_mov_b32 m0, %7\n\ts_nop 0\n\tglobal_load_lds_dwordx4 %4, %6\n\t"
               "s_add_u32 m0, %7, 0x400\n\ts_nop 0\n\tglobal_load_lds_dwordx4 %5, %6\n\ts_mov_b32 m0, %0"
               : "=&s"(keep) : "v"(kvo), "s"(kbase), "s"(kdst), "v"(vo0), "v"(vo1), "s"(vbase), "s"(vdst) : "memory", "scc"); }
typedef short v4i16_t __attribute__((ext_vector_type(4)));
__device__ __forceinline__ s16x4 vtr(const AT_LAS char* p) { return __builtin_bit_cast(s16x4, __builtin_amdgcn_ds_read_tr16_b64_v4i16((AT_LAS v4i16_t*)p)); }
constexpr int A2_KB = SHM_K, A2_VB = SHM_V, A2_OFF_V = 2 * A2_KB, A2_OFF_WS = A2_OFF_V + 2 * A2_VB, A2_LDS_BYTES = A2_OFF_WS + NW * 64 * 4;
struct NoMid { __device__ __forceinline__ void operator()() const {} };
template <int VAR = 0, class Mid = NoMid>
__device__ __forceinline__ void attn_unit2(const AttnArgs& A, int h, int qt, AT_LAS char* lds, const int tid, const Mid& mid = Mid()) {
  const int q0 = qt * 256;
  const unsigned lds0 = (unsigned)(uintptr_t)lds;
  constexpr int NT = SEQ / KVBLK;
  constexpr size_t TS = (size_t)KVBLK * LDQ;
#pragma unroll 1
  for (int mp = 0; mp < 2; ++mp) {
    if (mp == 1) mid();
    int tl = tid; asm volatile("" : "+v"(tl));
    const int lane = tl & 63, r32 = lane & 31, hi = lane >> 5; const int wid = __builtin_amdgcn_readfirstlane(tl >> 6);
    AT_LAS float* li_l = (AT_LAS float*)(lds + A2_OFF_WS) + wid * 64;
    int koff, voff0, voff1;
    { const int row = 8 * wid + (lane >> 3), cpos = lane & 7; koff = row * LDQ + 8 * (cpos ^ ((row >> 1) & 7)); }
    { const int row = 8 * (2 * wid) + (lane >> 3), cpos = lane & 7; voff0 = row * SEQ + 8 * (cpos ^ ((row >> 1) & 7)); }
    { const int row = 8 * (2 * wid + 1) + (lane >> 3), cpos = lane & 7; voff1 = row * SEQ + 8 * (cpos ^ ((row >> 1) & 7)); }
    const unsigned kob = (unsigned)koff * 2u, vob0 = (unsigned)voff0 * 2u, vob1 = (unsigned)voff1 * 2u;
    const unsigned kdst = lds0 + wid * 1024, vdst = lds0 + A2_OFF_V + wid * 2048;
    const bf16* Vh = A.VT + (size_t)h * 128 * SEQ;
    const bf16* Kh = A.K + (h * 2 + mp) * 64;
    const bf16* Qw = A.Q + (size_t)(q0 + wid * QBLK + r32) * LDQ + (h * 2 + mp) * 64 + hi * 8;
    const AT_LAS char* ksl = lds + r32 * 128;
    const int kswz = ((r32 >> 1) & 7) << 4;
    const AT_LAS char* vsl = lds + A2_OFF_V + r32 * 128;
#define A2_DMAK(t, s) glds16s(Kh + (size_t)(t) * TS, kob, (unsigned)__builtin_amdgcn_readfirstlane(kdst + (s) * A2_KB))
#define A2_DMAV(t, s) do { glds16s(Vh + (size_t)(t) * KVBLK, vob0, (unsigned)__builtin_amdgcn_readfirstlane(vdst + (s) * A2_VB)); glds16s(Vh + (size_t)(t) * KVBLK, vob1, (unsigned)__builtin_amdgcn_readfirstlane(vdst + (s) * A2_VB + 1024u)); } while (0)
#define A2_KRD(g, s) (*(const AT_LAS bf16x8*)(ksl + (s) * A2_KB + ((g) & 1) * 4096 + ((((g) >> 1) * 32 + hi * 16) ^ kswz)))
#define A2_VRD(m, s) do { vf[(m) % A2_NVF] = *(const AT_LAS bf16x8*)(vsl + (s) * A2_VB + ((m) & 3) * 4096 + ((((m) >> 2) * 32 + hi * 16) ^ kswz)); } while (0)
#define A2_VFR(m) vf[(m) % A2_NVF]
    __syncthreads();
    A2_DMAK(0, 0); A2_DMAK(1, 1);
    bf16x8 qr[4];
#pragma unroll
    for (int d0 = 0; d0 < 4; ++d0) qr[d0] = *(const __attribute__((address_space(1))) bf16x8*)(Qw + d0 * 16);
    float qss = 0.f;
#pragma unroll
    for (int d0 = 0; d0 < 4; ++d0)
#pragma unroll
      for (int e = 0; e < 8; ++e) { const float v = __uint_as_float(((unsigned)(unsigned short)qr[d0][e]) << 16); qss += v * v; }
    { auto rr = __builtin_amdgcn_permlane32_swap(__float_as_uint(qss), __float_as_uint(qss), false, false); qss = __uint_as_float(rr[0]) + __uint_as_float(rr[1]); }
    const float mref = sqrtf(qss) * A.kmax[h * 2 + mp] * 1.01f + 0.25f;
    f32x16 negm;
#pragma unroll
    for (int r = 0; r < 16; ++r) negm[r] = -mref;
    float l_reg = 0.f; f32x16 o[4]; o[0] = f32x16{}; o[1] = f32x16{}; o[2] = f32x16{}; o[3] = f32x16{};
    f32x16 cA0, cA1, cB0, cB1; bf16x8 pa[4]; bf16x8 kf[8]; bf16x8 vf[A2_NVF];
    if (VAR) { cA0 = negm; cA1 = negm; cB0 = negm; cB1 = negm; _Pragma("unroll") for (int i_ = 0; i_ < 4; ++i_) { pa[i_] = qr[i_]; vf[i_] = qr[i_]; } }
    AT_WAIT_BAR(0);
#pragma unroll
    for (int g = 0; g < 8; ++g) kf[g] = A2_KRD(g, 0);
    asm volatile("s_waitcnt lgkmcnt(0)\n\ts_barrier" ::: "memory");
#define A2_GA(g, N0, N1, P0, P1, DOQK, DOPREV, VS) do { \
    if ((DOQK) && !(VAR & 8)) { if ((g) & 1) N1 = __builtin_amdgcn_mfma_f32_32x32x16_bf16(kf[g], qr[(g) >> 1], (g) < 2 ? negm : N1, 0, 0, 0); \
                else         N0 = __builtin_amdgcn_mfma_f32_32x32x16_bf16(kf[g], qr[(g) >> 1], (g) < 2 ? negm : N0, 0, 0, 0); } \
    if ((DOPREV) && !(VAR & 128)) { \
        \
      if (((g) & 1) == 0) { pk0 = (g) < 4 ? cvtpk(P0[((g) & 2) * 4 + 0], P0[((g) & 2) * 4 + 1]) : cvtpk(P1[((g) & 2) * 4 + 0], P1[((g) & 2) * 4 + 1]); \
                            pk1 = (g) < 4 ? cvtpk(P0[((g) & 2) * 4 + 2], P0[((g) & 2) * 4 + 3]) : cvtpk(P1[((g) & 2) * 4 + 2], P1[((g) & 2) * 4 + 3]); } \
      else { const unsigned a1_ = (g) < 4 ? cvtpk(P0[((g) & 2) * 4 + 4], P0[((g) & 2) * 4 + 5]) : cvtpk(P1[((g) & 2) * 4 + 4], P1[((g) & 2) * 4 + 5]); \
             const unsigned b1_ = (g) < 4 ? cvtpk(P0[((g) & 2) * 4 + 6], P0[((g) & 2) * 4 + 7]) : cvtpk(P1[((g) & 2) * 4 + 6], P1[((g) & 2) * 4 + 7]); \
             const u32x4 w_ = {pk0, pk1, a1_, b1_}; pa[(g) >> 1] = __builtin_bit_cast(bf16x8, w_); } \
      } if ((DOPREV) && !(VAR & 4) && (g) >= 8 - A2_NVF) { A2_VRD((g) - (8 - A2_NVF), VS); } \
    A2_SBAR(); } while (0)
#define A2_GB(m, N0, N1, DOPREV, DOEXP, DOK, VS, KS) do { \
    if (DOPREV) { if (!(VAR & 2)) o[(m) & 3] = __builtin_amdgcn_mfma_f32_32x32x16_bf16(pa[(m) >> 2], A2_VFR(m), o[(m) & 3], 0, 0, 0); if (!(VAR & 4) && (m) + A2_NVF < 16) A2_VRD((m) + A2_NVF, VS); } \
    if ((DOEXP) && !(VAR & 1)) { if ((m) < 8) { N0[2 * (m)] = __builtin_amdgcn_exp2f(N0[2 * (m)]); N0[2 * (m) + 1] = __builtin_amdgcn_exp2f(N0[2 * (m) + 1]); l_reg += N0[2 * (m)]; l_reg += N0[2 * (m) + 1]; } \
                 else { N1[2 * (m) - 16] = __builtin_amdgcn_exp2f(N1[2 * (m) - 16]); N1[2 * (m) - 15] = __builtin_amdgcn_exp2f(N1[2 * (m) - 15]); l_reg += N1[2 * (m) - 16]; l_reg += N1[2 * (m) - 15]; } } \
    if ((DOK) && !(VAR & 64) && (m) >= 4 && (m) < 12) kf[(m) - 4] = A2_KRD((m) - 4, KS); \
    A2_SBAR(); } while (0)
#define A2_STEP(t, PAR, N0, N1, P0, P1, DOQK, DOPREV, DOEXP) do { unsigned pk0 = 0u, pk1 = 0u; \
    A2_GA(0, N0, N1, P0, P1, DOQK, DOPREV, (PAR) ^ 1); A2_GA(1, N0, N1, P0, P1, DOQK, DOPREV, (PAR) ^ 1); A2_GA(2, N0, N1, P0, P1, DOQK, DOPREV, (PAR) ^ 1); A2_GA(3, N0, N1, P0, P1, DOQK, DOPREV, (PAR) ^ 1); \
    A2_GA(4, N0, N1, P0, P1, DOQK, DOPREV, (PAR) ^ 1); A2_GA(5, N0, N1, P0, P1, DOQK, DOPREV, (PAR) ^ 1); A2_GA(6, N0, N1, P0, P1, DOQK, DOPREV, (PAR) ^ 1); A2_GA(7, N0, N1, P0, P1, DOQK, DOPREV, (PAR) ^ 1); \
    if (!(VAR & 16)) { if ((t) + 2 < NT) glds3(Kh + (size_t)((t) + 2) * TS, kob, (unsigned)__builtin_amdgcn_readfirstlane(kdst + (PAR) * A2_KB), Vh + (size_t)(t) * KVBLK, vob0, vob1, (unsigned)__builtin_amdgcn_readfirstlane(vdst + (PAR) * A2_VB)); \
                       else if ((t) < NT) A2_DMAV((t), PAR); } A2_SBAR(); \
    const bool dok_ = (t) + 1 < NT; \
    A2_GB(0, N0, N1, DOPREV, DOEXP, dok_, (PAR) ^ 1, (PAR) ^ 1); A2_GB(1, N0, N1, DOPREV, DOEXP, dok_, (PAR) ^ 1, (PAR) ^ 1); A2_GB(2, N0, N1, DOPREV, DOEXP, dok_, (PAR) ^ 1, (PAR) ^ 1); A2_GB(3, N0, N1, DOPREV, DOEXP, dok_, (PAR) ^ 1, (PAR) ^ 1); \
    A2_GB(4, N0, N1, DOPREV, DOEXP, dok_, (PAR) ^ 1, (PAR) ^ 1); A2_GB(5, N0, N1, DOPREV, DOEXP, dok_, (PAR) ^ 1, (PAR) ^ 1); A2_GB(6, N0, N1, DOPREV, DOEXP, dok_, (PAR) ^ 1, (PAR) ^ 1); A2_GB(7, N0, N1, DOPREV, DOEXP, dok_, (PAR) ^ 1, (PAR) ^ 1); \
    A2_GB(8, N0, N1, DOPREV, DOEXP, dok_, (PAR) ^ 1, (PAR) ^ 1); A2_GB(9, N0, N1, DOPREV, DOEXP, dok_, (PAR) ^ 1, (PAR) ^ 1); A2_GB(10, N0, N1, DOPREV, DOEXP, dok_, (PAR) ^ 1, (PAR) ^ 1); A2_GB(11, N0, N1, DOPREV, DOEXP, dok_, (PAR) ^ 1, (PAR) ^ 1); \
    A2_GB(12, N0, N1, DOPREV, DOEXP, dok_, (PAR) ^ 1, (PAR) ^ 1); A2_GB(13, N0, N1, DOPREV, DOEXP, dok_, (PAR) ^ 1, (PAR) ^ 1); A2_GB(14, N0, N1, DOPREV, DOEXP, dok_, (PAR) ^ 1, (PAR) ^ 1); A2_GB(15, N0, N1, DOPREV, DOEXP, dok_, (PAR) ^ 1, (PAR) ^ 1); \
    if (VAR & 32) asm volatile("s_waitcnt lgkmcnt(0)" ::: "memory"); else AT_WAIT_BAR(0); } while (0)
    if (A2_PRIO && wid >= 4) __builtin_amdgcn_s_setprio(1);
    A2_STEP(0, 0, cA0, cA1, cB0, cB1, true, false, true);
    for (int t = 1; t + 1 < NT; t += 2) {
      A2_STEP(t, 1, cB0, cB1, cA0, cA1, true, true, true);
      A2_STEP(t + 1, 0, cA0, cA1, cB0, cB1, true, true, true);
    }
    A2_STEP(NT - 1, 1, cB0, cB1, cA0, cA1, true, true, true);
    A2_STEP(NT, 0, cA0, cA1, cB0, cB1, false, true, false);
    if (A2_PRIO) __builtin_amdgcn_s_setprio(0);
#undef A2_STEP
#undef A2_GB
#undef A2_GA
#undef A2_VFR
#undef A2_VRD
#undef A2_KRD
#undef A2_DMAV
#undef A2_DMAK
    { auto rr = __builtin_amdgcn_permlane32_swap(__float_as_uint(l_reg), __float_as_uint(l_reg), false, false); l_reg = __uint_as_float(rr[0]) + __uint_as_float(rr[1]); }
    if (hi == 0) li_l[r32] = l_reg; asm volatile("s_waitcnt lgkmcnt(0)" ::: "memory");
    int r32e = r32, hie = hi; asm volatile("" : "+v"(r32e), "+v"(hie));
    const unsigned ebase = (unsigned)((q0 + wid * QBLK + 4 * hie) * 1024 + h * 128 + r32e);
    if (mp == 0) {
#pragma unroll
      for (int r = 0; r < 16; ++r) { __attribute__((address_space(1))) float* op = (__attribute__((address_space(1))) float*)A.AO1 + (ebase + (unsigned)(((r & 3) + 8 * (r >> 2)) * 1024)); const float rl = __builtin_amdgcn_rcpf(li_l[crow(r, hi)]);
#pragma unroll
        for (int d0 = 0; d0 < 4; ++d0) op[d0 * 32] = o[d0][r] * rl;
        if ((r & 3) == 3) asm volatile("" ::: "memory"); }
    } else {
      float sg[4];
#pragma unroll
      for (int d0 = 0; d0 < 4; ++d0) sg[d0] = A.subg[d0 * 32 + r32e] * A.outscale;
#pragma unroll
      for (int r = 0; r < 16; ++r) { const unsigned eo = ebase + (unsigned)(((r & 3) + 8 * (r >> 2)) * 1024); const __attribute__((address_space(1))) float* ip = (const __attribute__((address_space(1))) float*)A.AO1 + eo; const float rl = __builtin_amdgcn_rcpf(li_l[crow(r, hi)]) * A.lam;
        float v[4]; float ss = 0.f;
#pragma unroll
        for (int d0 = 0; d0 < 4; ++d0) { v[d0] = ip[d0 * 32] - o[d0][r] * rl; ss += v[d0] * v[d0]; }
#pragma unroll
        for (int off = 1; off < 32; off <<= 1) ss += shx(ss, off, lane);
        const float rs = rsqrtf(ss * (1.0f / 128.0f) + 1e-6f);
        __attribute__((address_space(1))) bf16* mp_ = (__attribute__((address_space(1))) bf16*)A.MIX + (eo + (eo & ~1023u));
#pragma unroll
        for (int d0 = 0; d0 < 4; ++d0) mp_[d0 * 32] = (bf16)(pg8::cvt_pk_bf16(v[d0] * rs * sg[d0], 0.f) & 0xffffu);
        if ((r & 3) == 3) asm volatile("" ::: "memory"); }
    }
  }
}
#undef A2_SBAR
}

namespace hg {
using bf16 = unsigned short;
using bf16x8 = __attribute__((ext_vector_type(8))) short;
using f32x16 = __attribute__((ext_vector_type(16))) float;
using u32x4  = __attribute__((ext_vector_type(4))) unsigned;
using u32x2  = __attribute__((ext_vector_type(2))) unsigned;
#define HG_LAS __attribute__((address_space(3)))
constexpr int P128 = 136, P64 = 72;
constexpr int L_QT = 0, L_KT = L_QT + 64 * P128 * 2, L_QB = L_KT + 64 * P128 * 2, L_KH = L_QB + 64 * P128 * 2, L_VT = L_KH + 128 * P64 * 2,
              L_ST = L_VT + 128 * P64 * 2, L_AM = L_ST + 128 * P128 * 2, L_EB = L_AM + 64 * P64 * 2, L_PS = L_EB + 512, L_SSQ = L_PS + 2048, LDS_BYTES = L_SSQ + 1024;
constexpr int SCT = 512, NSC = 32;
__device__ __forceinline__ int crow(int r, int hi) { return (r & 3) + 8 * (r >> 2) + 4 * hi; }
typedef float f32x2_t __attribute__((ext_vector_type(2))); typedef __bf16 bf16x2_t __attribute__((ext_vector_type(2)));
__device__ __forceinline__ unsigned cvtpk(float lo, float hi) { f32x2_t v = {lo, hi}; bf16x2_t b = __builtin_convertvector(v, bf16x2_t); return __builtin_bit_cast(unsigned, b); }
__device__ __forceinline__ float bf2f(unsigned short b) { return __uint_as_float((unsigned)b << 16); }
template <int CTRL> __device__ __forceinline__ float dppf(float v) { return __int_as_float(__builtin_amdgcn_update_dpp(0, __float_as_int(v), CTRL, 0xf, 0xf, true)); }
#define HG_EXP(x) ((VAR & 2) ? (x) : __expf(x))
#define HG_BAR() do { asm volatile("s_waitcnt lgkmcnt(0)" ::: "memory"); __builtin_amdgcn_s_barrier(); asm volatile("" ::: "memory"); } while (0)

struct HgArgs { const bf16* HQ; const bf16* KK; const unsigned short* LF; const bf16* HV; const bf16* HGt; float* HS; float* GS; float* HOF; bf16* MIX; const float* gn; };

template <bool OUT, int VAR = 0>
__device__ __forceinline__ void hgrn_unit(const HgArgs& A, int dir, int h, int sc, HG_LAS unsigned char* lds, const int tid) {
  const int lane = tid & 63, r32 = lane & 31, hi = lane >> 5; const int wid = __builtin_amdgcn_readfirstlane(tid >> 6);
  const int d = tid & 127, qt = tid >> 7;
  typedef __attribute__((address_space(1))) const unsigned short gcus; typedef __attribute__((address_space(1))) float gfl; typedef __attribute__((address_space(1))) unsigned short gus;
  gcus* gLF = (gcus*)A.LF; gcus* gKK = (gcus*)A.KK; gcus* gHV = (gcus*)A.HV; gcus* gHQ = (gcus*)A.HQ; gcus* gHG = (gcus*)A.HGt; gus* gHOF = (gus*)A.HOF;     gus* gMIX = (gus*)A.MIX; gfl* gHS = (gfl*)A.HS; gfl* gGS = (gfl*)A.GS;
  HG_LAS bf16* QT = (HG_LAS bf16*)(lds + L_QT); HG_LAS bf16* KT = (HG_LAS bf16*)(lds + L_KT); HG_LAS bf16* QB = (HG_LAS bf16*)(lds + L_QB);
  HG_LAS bf16* KH = (HG_LAS bf16*)(lds + L_KH); HG_LAS bf16* VT = (HG_LAS bf16*)(lds + L_VT); HG_LAS bf16* ST = (HG_LAS bf16*)(lds + L_ST);
  HG_LAS bf16* AM = (HG_LAS bf16*)(lds + L_AM); HG_LAS float* EB = (HG_LAS float*)(lds + L_EB); HG_LAS float* PS = (HG_LAS float*)(lds + L_PS);
  HG_LAS float* SSQ = (HG_LAS float*)(lds + L_SSQ);
  const int db = wid >> 1, eb0 = (wid & 1) * 2;
  const int jb = wid & 1, eb = wid >> 1;
  const size_t unit = (size_t)(dir * 8 + h) * NSC + sc;
  gfl* HSu = gHS + unit * 16384;
  f32x16 S0, S1;
  if (OUT) {
#pragma unroll
    for (int r = 0; r < 16; ++r) { const gfl* p = HSu + (32 * db + crow(r, hi)) * 128 + 32 * eb0 + r32; S0[r] = p[0]; S1[r] = p[32]; }
#pragma unroll
    for (int rg = 0; rg < 4; ++rg) { u32x2 w0, w1; w0.x = cvtpk(S0[4 * rg], S0[4 * rg + 1]); w0.y = cvtpk(S0[4 * rg + 2], S0[4 * rg + 3]); w1.x = cvtpk(S1[4 * rg], S1[4 * rg + 1]); w1.y = cvtpk(S1[4 * rg + 2], S1[4 * rg + 3]);
      *(HG_LAS u32x2*)(ST + (32 * eb0 + r32) * P128 + 32 * db + 8 * rg + 4 * hi) = w0; *(HG_LAS u32x2*)(ST + (32 * (eb0 + 1) + r32) * P128 + 32 * db + 8 * rg + 4 * hi) = w1; }
  } else { S0 = f32x16{}; S1 = f32x16{}; }
  float gtot = 0.f;
  const float gnv = (OUT && dir != 0) ? ((__attribute__((address_space(1))) const float*)A.gn)[32 * eb + r32] : 0.f;
  const int cofs = h * 128 + d;
  unsigned short rl[16]; unsigned short kkv[16], qv[16], vv[16];
#define HG_LOAD(cc) do { _Pragma("unroll") for (int jj = 0; jj < 16; ++jj) { const int p = (cc) * 64 + qt * 16 + jj; const size_t tok = (size_t)(dir ? sc * SCT + (SCT - 1) - p : sc * SCT + p); \
      rl[jj] = gLF[tok * 2048 + dir * 1024 + cofs]; kkv[jj] = gKK[tok * 2048 + dir * 1024 + cofs]; vv[jj] = gHV[tok * 1024 + cofs]; \
      if (OUT) qv[jj] = gHQ[tok * 1024 + cofs]; } } while (0)
  HG_LOAD(0);
#pragma unroll 1
  for (int c = 0; c < 8; ++c) {
    float lf[16]; unsigned short hofv[16]; unsigned short hgv[16];
    float run = 0.f;
#pragma unroll
    for (int jj = 0; jj < 16; ++jj) { run += (float)__builtin_bit_cast(_Float16, rl[jj]); lf[jj] = run; }
    PS[qt * 128 + d] = run;
    HG_BAR();
    const float p0 = PS[d], p1 = PS[128 + d], p2 = PS[256 + d], p3 = PS[384 + d];
    const float off = qt == 0 ? 0.f : qt == 1 ? p0 : qt == 2 ? p0 + p1 : p0 + p1 + p2;
    const float b63 = (p0 + p1) + (p2 + p3), rmid = p0 + p1;
    gtot += b63;
    if (qt == 0) EB[d] = HG_EXP(b63);
    unsigned kh[8];
#pragma unroll
    for (int jj = 0; jj < 16; jj += 2) {
      const float b0 = off + lf[jj], b1 = off + lf[jj + 1]; const float k0 = bf2f(kkv[jj]), k1 = bf2f(kkv[jj + 1]);
      kh[jj >> 1] = cvtpk(k0 * HG_EXP(b63 - b0), k1 * HG_EXP(b63 - b1));
      if (OUT) { const float q0 = bf2f(qv[jj]), q1 = bf2f(qv[jj + 1]);
        const unsigned qt_ = cvtpk(q0 * HG_EXP(b0 - rmid), q1 * HG_EXP(b1 - rmid)), kt_ = cvtpk(k0 * HG_EXP(rmid - b0), k1 * HG_EXP(rmid - b1)), qb_ = cvtpk(q0 * HG_EXP(b0), q1 * HG_EXP(b1));
        const int j0 = qt * 16 + jj;
        if (!(VAR & 1)) {
          const unsigned xq = (unsigned)__builtin_amdgcn_update_dpp(0, (int)qt_, 0xB1, 0xf, 0xf, true), xk = (unsigned)__builtin_amdgcn_update_dpp(0, (int)kt_, 0xB1, 0xf, 0xf, true), xb = (unsigned)__builtin_amdgcn_update_dpp(0, (int)qb_, 0xB1, 0xf, 0xf, true);
          const bool odd = d & 1; const int wofs = (odd ? (j0 + 1) * P128 + d - 1 : j0 * P128 + d);
          *(HG_LAS unsigned*)(QT + wofs) = odd ? ((xq >> 16) | (qt_ & 0xffff0000u)) : ((qt_ & 0xffffu) | (xq << 16));
          *(HG_LAS unsigned*)(KT + wofs) = odd ? ((xk >> 16) | (kt_ & 0xffff0000u)) : ((kt_ & 0xffffu) | (xk << 16));
          *(HG_LAS unsigned*)(QB + wofs) = odd ? ((xb >> 16) | (qb_ & 0xffff0000u)) : ((qb_ & 0xffffu) | (xb << 16)); } }
    }
    *(HG_LAS u32x4*)(KH + d * P64 + qt * 16) = (u32x4){kh[0], kh[1], kh[2], kh[3]}; *(HG_LAS u32x4*)(KH + d * P64 + qt * 16 + 8) = (u32x4){kh[4], kh[5], kh[6], kh[7]};
    { u32x4 w0, w1;
      w0.x = (unsigned)vv[0] | ((unsigned)vv[1] << 16); w0.y = (unsigned)vv[2] | ((unsigned)vv[3] << 16); w0.z = (unsigned)vv[4] | ((unsigned)vv[5] << 16); w0.w = (unsigned)vv[6] | ((unsigned)vv[7] << 16);
      w1.x = (unsigned)vv[8] | ((unsigned)vv[9] << 16); w1.y = (unsigned)vv[10] | ((unsigned)vv[11] << 16); w1.z = (unsigned)vv[12] | ((unsigned)vv[13] << 16); w1.w = (unsigned)vv[14] | ((unsigned)vv[15] << 16);
      *(HG_LAS u32x4*)(VT + d * P64 + qt * 16) = w0; *(HG_LAS u32x4*)(VT + d * P64 + qt * 16 + 8) = w1; }
    if (OUT && dir != 0) {
#pragma unroll
      for (int r = 0; r < 16; ++r) { const int p = c * 64 + 32 * jb + crow(r, hi); const size_t tok = (size_t)(sc * SCT + (SCT - 1) - p);
        hofv[r] = gHOF[tok * 1024 + h * 128 + 32 * eb + r32]; hgv[r] = gHG[tok * 1024 + h * 128 + 32 * eb + r32]; } }
    if (!(VAR & 16) && c + 1 < 8) HG_LOAD(c + 1);
    HG_BAR();
    f32x16 oacc = f32x16{};
    if (OUT) {
      if (!(VAR & 4)) {
#pragma unroll
      for (int ks = 0; ks < 8; ++ks) { const bf16x8 a = *(const HG_LAS bf16x8*)(QB + (32 * jb + r32) * P128 + 16 * ks + 8 * hi), b = *(const HG_LAS bf16x8*)(ST + (32 * eb + r32) * P128 + 16 * ks + 8 * hi);
        oacc = __builtin_amdgcn_mfma_f32_32x32x16_bf16(a, b, oacc, 0, 0, 0); }
      if (wid < 4) { const int jb2 = wid & 1, sb = wid >> 1;
        if (sb <= jb2) { f32x16 aacc = f32x16{};
#pragma unroll
          for (int ks = 0; ks < 8; ++ks) { const bf16x8 a = *(const HG_LAS bf16x8*)(QT + (32 * jb2 + r32) * P128 + 16 * ks + 8 * hi), b = *(const HG_LAS bf16x8*)(KT + (32 * sb + r32) * P128 + 16 * ks + 8 * hi);
            aacc = __builtin_amdgcn_mfma_f32_32x32x16_bf16(a, b, aacc, 0, 0, 0); }
#pragma unroll
          for (int r = 0; r < 16; ++r) { const int j = 32 * jb2 + crow(r, hi), s = 32 * sb + r32; AM[j * P64 + s] = (bf16)(cvtpk(s <= j ? aacc[r] : 0.f, 0.f) & 0xffffu); }
        } else {
#pragma unroll
          for (int r = 0; r < 16; ++r) AM[(32 * jb2 + crow(r, hi)) * P64 + 32 * sb + r32] = (bf16)0;
        }
      }
      }
      HG_BAR();
      if (!(VAR & 4))
#pragma unroll
      for (int ks = 0; ks < 4; ++ks) { const bf16x8 a = *(const HG_LAS bf16x8*)(AM + (32 * jb + r32) * P64 + 16 * ks + 8 * hi), b = *(const HG_LAS bf16x8*)(VT + (32 * eb + r32) * P64 + 16 * ks + 8 * hi);
        oacc = __builtin_amdgcn_mfma_f32_32x32x16_bf16(a, b, oacc, 0, 0, 0); }
    }
    if (!(VAR & 8)) {
#pragma unroll
    for (int r = 0; r < 16; ++r) { const float g = EB[32 * db + crow(r, hi)]; S0[r] *= g; S1[r] *= g; }
#pragma unroll
    for (int ks = 0; ks < 4; ++ks) { const bf16x8 a = *(const HG_LAS bf16x8*)(KH + (32 * db + r32) * P64 + 16 * ks + 8 * hi);
      const bf16x8 b0 = *(const HG_LAS bf16x8*)(VT + (32 * eb0 + r32) * P64 + 16 * ks + 8 * hi), b1 = *(const HG_LAS bf16x8*)(VT + (32 * (eb0 + 1) + r32) * P64 + 16 * ks + 8 * hi);
      S0 = __builtin_amdgcn_mfma_f32_32x32x16_bf16(a, b0, S0, 0, 0, 0); S1 = __builtin_amdgcn_mfma_f32_32x32x16_bf16(a, b1, S1, 0, 0, 0); }
    }
    if (OUT) {
      if (!(VAR & 8))
#pragma unroll
      for (int rg = 0; rg < 4; ++rg) { u32x2 w0, w1; w0.x = cvtpk(S0[4 * rg], S0[4 * rg + 1]); w0.y = cvtpk(S0[4 * rg + 2], S0[4 * rg + 3]); w1.x = cvtpk(S1[4 * rg], S1[4 * rg + 1]); w1.y = cvtpk(S1[4 * rg + 2], S1[4 * rg + 3]);
        *(HG_LAS u32x2*)(ST + (32 * eb0 + r32) * P128 + 32 * db + 8 * rg + 4 * hi) = w0; *(HG_LAS u32x2*)(ST + (32 * (eb0 + 1) + r32) * P128 + 32 * db + 8 * rg + 4 * hi) = w1; }
      const int ecol = h * 128 + 32 * eb + r32;
      if (VAR & 32) { if (oacc[0] == 123.456f) gHOF[ecol] = (bf16)1; }
      else if (dir == 0) {
#pragma unroll
        for (int r = 0; r < 16; ++r) { const int p = c * 64 + 32 * jb + crow(r, hi); gHOF[(size_t)(sc * SCT + p) * 1024 + ecol] = (bf16)(cvtpk(oacc[r], 0.f) & 0xffffu); }
      } else {
        float tot[16];
#pragma unroll
        for (int r = 0; r < 16; ++r) { const int p = c * 64 + 32 * jb + crow(r, hi); const size_t tok = (size_t)(sc * SCT + (SCT - 1) - p);
          tot[r] = oacc[r] + bf2f(hofv[r]); float ss = tot[r] * tot[r];
          ss += dppf<0xB1>(ss); ss += dppf<0x4E>(ss); ss += dppf<0x141>(ss); ss += dppf<0x140>(ss);
          ss += shx(ss, 16, lane);
          if (r32 == 0) SSQ[(32 * jb + crow(r, hi)) * 4 + eb] = ss; }
        HG_BAR();
#pragma unroll
        for (int r = 0; r < 16; ++r) { const int j = 32 * jb + crow(r, hi); const int p = c * 64 + j; const size_t tok = (size_t)(sc * SCT + (SCT - 1) - p);
          const float ssum = (SSQ[j * 4] + SSQ[j * 4 + 1]) + (SSQ[j * 4 + 2] + SSQ[j * 4 + 3]);
          const float rs = rsqrtf(ssum * (1.0f / 128.0f) + 1e-6f);
          const float g = bf2f(hgv[r]);
          gMIX[tok * 2048 + 1024 + ecol] = (bf16)(cvtpk(tot[r] * rs * gnv * g, 0.f) & 0xffffu); }
      }
    }
  }
  if (!OUT) {
#pragma unroll
    for (int r = 0; r < 16; ++r) { gfl* p = HSu + (32 * db + crow(r, hi)) * 128 + 32 * eb0 + r32; p[0] = S0[r]; p[32] = S1[r]; }
    if (qt == 0) gGS[unit * 128 + d] = gtot;
  }
  HG_BAR();
}

__device__ __forceinline__ void hgrn_scan(float* HS, const float* GS, int gtid, int nthr) {
  for (int p = gtid; p < 16 * 16384; p += nthr) { const int dh = p >> 14, idx = p & 16383, dd = idx >> 7, dir = dh >> 3;
    float* base = HS + (size_t)dh * NSC * 16384 + idx; const float* g = GS + dh * NSC * 128 + dd;
    float v[NSC], ge[NSC];
#pragma unroll
    for (int k = 0; k < NSC; ++k) { const int s = dir ? NSC - 1 - k : k; v[k] = base[(size_t)s * 16384]; ge[k] = g[s * 128]; }
    float carry = 0.f;
#pragma unroll
    for (int k = 0; k < NSC; ++k) { const int s = dir ? NSC - 1 - k : k; base[(size_t)s * 16384] = carry; carry = __expf(ge[k]) * carry + v[k]; }
  }
}
#undef HG_BAR
#undef HG_LOAD
}

constexpr int NWAVES = 8;
#ifndef MK_PER_PHASE
#define MK_PER_PHASE 0
#endif
#ifndef CVT_HOST
#define CVT_HOST 1
#endif
constexpr int T = 16384, DM = 2048, NL = 4, INC = 8192, NE = 16, CAP = 2048, FF = 1024, XR = NE * CAP;
constexpr float EPS = 1e-6f;
constexpr float QSCALE = 0.125f * 1.4426950408889634f;
constexpr size_t MiB = 1u << 20;
constexpr size_t WS_CTL = 0, CTL_ZERO_BYTES = 32 * 1024;
constexpr size_t WS_ROPE = 1 * MiB, WS_LBS = 5 * MiB, WS_AFF = 6 * MiB, WS_SLOT = 7 * MiB, WS_IDX = 8 * MiB, WS_GATE = 8 * MiB + 512 * 1024, WS_GS = 9 * MiB, WS_PAR = 10 * MiB;
constexpr int PAR_N1 = 0, PAR_N2 = PAR_N1 + NL * DM, PAR_FG = PAR_N2 + NL * DM, PAR_DLAM = PAR_FG + DM, PAR_SUBG = PAR_DLAM + NL * 256, PAR_HGN = PAR_SUBG + NL * 128, PAR_RW = PAR_HGN + NL * 128, PAR_END = PAR_RW + NL * DM * NE;
constexpr size_t WS_WIN = 16 * MiB, WS_WOUT = 144 * MiB, WS_WGU = 176 * MiB, WS_WDN = 688 * MiB;
constexpr size_t WS_X = 944 * MiB, WS_MIX = 1264 * MiB;
constexpr int RW_PITCH = 2056, RW_IMG = 2 * NE * RW_PITCH * 2;
constexpr size_t WS_RWS = 12 * MiB;
constexpr size_t WS_RS1 = 11 * MiB, WS_RS2 = 11 * MiB + 64 * 1024, WS_RSG = 11 * MiB + 128 * 1024;
constexpr size_t WS_Q = 1328 * MiB, WS_K = 1360 * MiB, WS_V = 1392 * MiB, WS_HQ = 1424 * MiB, WS_LF = 1456 * MiB, WS_KK = 1584 * MiB, WS_HV = 1648 * MiB, WS_HG = 1680 * MiB,
                 WS_AO1 = 1712 * MiB, WS_HS = 1776 * MiB, WS_HOF = 1808 * MiB;
constexpr size_t WS_VT = 1072 * MiB;
constexpr size_t WS_XG = 1328 * MiB, WS_HM = 1456 * MiB, WS_Y = 1520 * MiB;
constexpr size_t WS_END = 1872 * MiB;
constexpr int CW_BAR = 4096, CW_KMAX = 2048;
constexpr int RING_BYTES = 131072, LDS_BYTES = 147456, MISC_OFF = LDS_BYTES - 512;
static_assert(hg::LDS_BYTES <= MISC_OFF && att::LDS_BYTES2 <= RING_BYTES, "LDS map");

#define GAS __attribute__((address_space(1)))
#define LAS __attribute__((address_space(3)))
typedef unsigned short bf16;
typedef unsigned v4u __attribute__((ext_vector_type(4)));
typedef unsigned v2u __attribute__((ext_vector_type(2)));
typedef float f32x4 __attribute__((ext_vector_type(4)));
typedef GAS unsigned gu32;
#define RLX_AGENT __ATOMIC_RELAXED, __HIP_MEMORY_SCOPE_AGENT
#define LDS_WAIT() asm volatile("s_waitcnt lgkmcnt(0)" ::: "memory")
#define VM_WAIT() asm volatile("s_waitcnt vmcnt(0)" ::: "memory")
__device__ __forceinline__ unsigned pk2(float lo, float hi) { return pg8::cvt_pk_bf16(lo, hi); }
__device__ __forceinline__ float bf2f(unsigned short b) { return __uint_as_float((unsigned)b << 16); }

#define XB_TMO      128
#define XB_XCNT(j)  (256  + 64 * (j))
#define XB_XSUB(j)  (1280 + 64 * (j))
#define XB_XGEN(j)  (2304 + 64 * (j))
#define XB_TOP      3328
#define XB_TOPGEN   3392
#define XCD_BAR_WORDS 3456
#define XB_SPIN_CAP (1u << 18)

__device__ __forceinline__ unsigned xb_ld(unsigned* p)              { return __hip_atomic_load(p, __ATOMIC_RELAXED, __HIP_MEMORY_SCOPE_AGENT); }
__device__ __forceinline__ unsigned xb_add(unsigned* p, unsigned v) { return __hip_atomic_fetch_add(p, v, __ATOMIC_RELAXED, __HIP_MEMORY_SCOPE_AGENT); }
__device__ __forceinline__ unsigned xb_xcc_id() { return (unsigned)__builtin_amdgcn_s_getreg((3 << 11) | 20) & 0xFu; }
#define XB_SPIN(cond, bar) do { unsigned _sp = 0; while (cond) { __builtin_amdgcn_s_sleep(1); \
    if ((++_sp & 255u) == 0u) { if (xb_ld(&(bar)[XB_TMO])) break; if (_sp > XB_SPIN_CAP) { atomicAdd(&(bar)[XB_TMO], 1u); break; } } } } while (0)

__device__ __forceinline__ unsigned xb_lane() { unsigned z = 0u; asm volatile("" : "+s"(z)); return __builtin_amdgcn_mbcnt_hi(~0u, __builtin_amdgcn_mbcnt_lo(~0u, z)); }
struct XcdBarrier {
    int wv;
    unsigned* bar; unsigned x;
    volatile LAS unsigned* st;
};

__device__ __forceinline__ XcdBarrier xcd_barrier_post(unsigned* bar, volatile LAS unsigned* st, int wv) {
    XcdBarrier b; b.bar = bar; b.x = xb_xcc_id(); b.st = st; b.wv = wv;
    if (wv == 0 && xb_lane() == 0u) (void)xb_add(&bar[XB_XCNT(b.x)], 1u);
    return b;
}
__device__ __forceinline__ void xcd_barrier_complete(unsigned* bar, unsigned x, unsigned& nloc, unsigned& nx) {
    const unsigned G = gridDim.x * gridDim.y * gridDim.z;
    unsigned sum, cnt, mine, sp = 0u;
    for (;;) {
        sum = 0u; cnt = 0u; mine = 0u;
#pragma unroll
        for (unsigned j = 0; j < 16; ++j) { const unsigned c = xb_ld(&bar[XB_XCNT(j)]); sum += c; cnt += (c > 0u) ? 1u : 0u; mine = (j == x) ? c : mine; }
        if (sum == G) break;
        __builtin_amdgcn_s_sleep(1);
        if ((++sp & 255u) == 0u) { if (xb_ld(&bar[XB_TMO])) break; if (sp > XB_SPIN_CAP) { atomicAdd(&bar[XB_TMO], 1u); break; } }
    }
    nloc = mine > 0u ? mine : 1u; nx = cnt > 0u ? cnt : 1u;
}

__device__ __forceinline__ void xcd_barrier(const XcdBarrier& b) {
    asm volatile("s_waitcnt vmcnt(0)" ::: "memory");
    __syncthreads();
    if (b.wv == 0 && xb_lane() == 0u) {
        unsigned* bar = b.bar; unsigned bx = b.x; asm volatile("" : "+s"(bar), "+s"(bx));
        __builtin_amdgcn_s_waitcnt(0);
        unsigned nloc = b.st[0], nx = b.st[1];
        if (nloc == 0u) { xcd_barrier_complete(bar, bx, nloc, nx); b.st[0] = nloc; b.st[1] = nx; }
        const unsigned old = xb_add(&bar[XB_XSUB(bx)], 1u);
        const unsigned gen = old / nloc;
        if (old + 1u == (gen + 1u) * nloc) {
            __builtin_amdgcn_fence(__ATOMIC_RELEASE, "agent");
            asm volatile("s_waitcnt vmcnt(0)" ::: "memory");
            const unsigned og = xb_add(&bar[XB_TOP], 1u);
            const unsigned tg = og / nx;
            if (og + 1u == (tg + 1u) * nx) xb_add(&bar[XB_TOPGEN], 1u);
            else XB_SPIN(xb_ld(&bar[XB_TOPGEN]) == tg, bar);
            __builtin_amdgcn_fence(__ATOMIC_ACQUIRE, "agent");
            xb_add(&bar[XB_XGEN(bx)], 1u);
            asm volatile("s_waitcnt vmcnt(0)" ::: "memory");
        } else {
            XB_SPIN(xb_ld(&bar[XB_XGEN(bx)]) == gen, bar);
            __builtin_amdgcn_fence(__ATOMIC_ACQUIRE, "agent");
            asm volatile("s_waitcnt vmcnt(0)" ::: "memory");
        }
    }
    __syncthreads();
}


struct Args {
    const float* x; const int* pos; const float* norm1_g; const float* w_in; const float* dlam; const float* subg; const float* lblog; const float* hgn;
    const float* w_out; const float* norm2_g; const float* router_w; const float* w_gate; const float* w_up; const float* w_down; const float* final_g;
    float* out; unsigned char* ws; int ph_lo, ph_hi;
};
struct Frame { LAS unsigned char* lds; volatile LAS unsigned* MISC; int tid, lane, wave, vcu, G; };

__device__ __forceinline__ float wave_sum(float v, int lane) {
#pragma unroll
    for (int o = 1; o < 64; o <<= 1) v += shx(v, o, lane);
    return v;
}
__device__ __forceinline__ float wave_max(float v, int lane) {
#pragma unroll
    for (int o = 1; o < 64; o <<= 1) v = fmaxf(v, shx(v, o, lane));
    return v;
}
constexpr int I_IN = 32 * 256, I_OUT = 32 * 64, I_G = 32 * 32, I_D = 16 * 64, PER_LAYER = I_IN + I_OUT + 2 * NE * I_G + NE * I_D;
constexpr int CVT_LDS_OFF = 65536, CVT_SCR = 64 * 33 * 4;
#ifndef CVT_NS
#define CVT_NS 4
#endif
struct CvtItem { const float* src; bf16* dst; const float* gk; int N, K; };
struct CvtSrc { const float* w_in; const float* w_out; const float* w_gate; const float* w_up; const float* w_down; const float* norm1_g; const float* norm2_g; };
constexpr size_t WS_PTAB = 10 * MiB + 768 * 1024;
__device__ __forceinline__ size_t inproj_colmap(int n0);
__device__ __forceinline__ CvtItem cvt_item(const CvtSrc& a, unsigned char* ws, int l, int r) {
    CvtItem c;
    if (r < I_IN) { const int kb = r >> 8, nb = r & 255; c.N = INC; c.K = DM;
        c.src = a.w_in + (size_t)l * DM * INC + (size_t)(kb * 64) * INC + nb * 32; c.dst = (bf16*)(ws + WS_WIN) + (size_t)l * INC * DM + inproj_colmap(nb * 32) * DM + kb * 64; c.gk = a.norm1_g + l * DM + kb * 64; return c; }
    r -= I_IN;
    if (r < I_OUT) { const int kb = r >> 6, nb = r & 63; c.N = DM; c.K = DM;
        c.src = a.w_out + (size_t)l * DM * DM + (size_t)(kb * 64) * DM + nb * 32; c.dst = (bf16*)(ws + WS_WOUT) + (size_t)l * DM * DM + (size_t)(nb * 32) * DM + kb * 64; c.gk = nullptr; return c; }
    r -= I_OUT;
    if (r < 2 * NE * I_G) { const int up = r >= NE * I_G; if (up) r -= NE * I_G; const int le = l * NE + (r >> 10), i = r & 1023, kb = i >> 5, f0 = (i & 31) * 32; c.N = FF; c.K = DM;
        c.src = (up ? a.w_up : a.w_gate) + (size_t)le * DM * FF + (size_t)(kb * 64) * FF + f0; c.dst = (bf16*)(ws + WS_WGU) + (size_t)le * 2048 * DM + (size_t)((f0 >> 7) * 256 + up * 128 + (f0 & 127)) * DM + kb * 64;
        c.gk = a.norm2_g + l * DM + kb * 64; return c; }
    r -= 2 * NE * I_G;
    { const int le = l * NE + (r >> 10), i = r & 1023, kb = i >> 6, nb = i & 63; c.N = DM; c.K = FF;
        c.src = a.w_down + (size_t)le * FF * DM + (size_t)(kb * 64) * DM + nb * 32; c.dst = (bf16*)(ws + WS_WDN) + (size_t)le * DM * FF + (size_t)(nb * 32) * FF + kb * 64; c.gk = nullptr; }
    return c;
}
__device__ __forceinline__ void cvt_load(const CvtItem& c, float (&v)[32], f32x4& g0, f32x4& g1, int lane) {
#pragma unroll
    for (int i = 0; i < 32; ++i) v[i] = __builtin_nontemporal_load((const GAS float*)(c.src + (size_t)(2 * i) * c.N) + ((lane >> 5) * c.N + (lane & 31)));
    g0 = (f32x4){1.f, 1.f, 1.f, 1.f}; g1 = g0;
    if (c.gk) { g0 = *(const GAS f32x4*)(c.gk + 8 * (lane & 7)); g1 = *(const GAS f32x4*)(c.gk + 8 * (lane & 7) + 4); }
}
__device__ __forceinline__ void cvt_process(bf16* dst, int K, float (&v)[32], f32x4& g0, f32x4& g1, const CvtItem& cn, bool hn, LAS float* scr, int lane) {
#pragma unroll
    for (int i = 0; i < 32; ++i) scr[(2 * i + (lane >> 5)) * 33 + (lane & 31)] = v[i];
    const f32x4 h0 = g0, h1 = g1;
    if (hn) cvt_load(cn, v, g0, g1, lane);
    LDS_WAIT(); asm volatile("" ::: "memory");
    const int cc = lane & 7;
#pragma unroll
    for (int j = 0; j < 4; ++j) { const int n = (lane >> 3) + 8 * j; const LAS float* s = scr + (8 * cc) * 33 + n;
        v4u o; o.x = pk2(s[0 * 33] * h0.x, s[1 * 33] * h0.y); o.y = pk2(s[2 * 33] * h0.z, s[3 * 33] * h0.w); o.z = pk2(s[4 * 33] * h1.x, s[5 * 33] * h1.y); o.w = pk2(s[6 * 33] * h1.z, s[7 * 33] * h1.w);
        __builtin_nontemporal_store(o, (GAS v4u*)(dst + (size_t)n * K + 8 * cc)); }
    LDS_WAIT(); asm volatile("" ::: "memory");
}
template <bool FROM_ARGS>
__device__ __forceinline__ void p0_convert(Frame& F, const Args& args, unsigned char* ws_in, int l0, int r0, int count) {
    LAS float* scr = (LAS float*)(F.lds + CVT_LDS_OFF + F.wave * CVT_SCR);
    const int NGW = F.G * NWAVES; int lane = F.lane;
    int v = F.vcu * NWAVES + F.wave; unsigned char* ws = ws_in; asm volatile("" : "+s"(v), "+s"(ws), "+v"(lane));
    if (v >= count) return;
    CvtSrc a;
    if (FROM_ARGS) a = CvtSrc{args.w_in, args.w_out, args.w_gate, args.w_up, args.w_down, args.norm1_g, args.norm2_g};
    else { const int tv = (int)((const GAS unsigned*)(ws + WS_PTAB))[lane & 15];
#define CVT_PTR(i) ((const float*)(((unsigned long long)(unsigned)__builtin_amdgcn_readlane(tv, 2 * (i) + 1) << 32) | (unsigned long long)(unsigned)__builtin_amdgcn_readlane(tv, 2 * (i))))
        a = CvtSrc{CVT_PTR(0), CVT_PTR(1), CVT_PTR(2), CVT_PTR(3), CVT_PTR(4), CVT_PTR(5), CVT_PTR(6)};
#undef CVT_PTR
    }
#define CVT_ITEM(vv) cvt_item(a, ws, (r0 + (vv) >= PER_LAYER) ? l0 + 1 : l0, (r0 + (vv) >= PER_LAYER) ? r0 + (vv) - PER_LAYER : r0 + (vv))
    constexpr int NS = CVT_NS;
    float vv[NS][32]; f32x4 g0[NS], g1[NS]; bf16* dd[NS]; int kk[NS]; bool has[NS];
#pragma unroll
    for (int s_ = 0; s_ < NS; ++s_) { has[s_] = v + s_ * NGW < count; dd[s_] = nullptr; kk[s_] = 0;
        if (has[s_]) { const CvtItem c = CVT_ITEM(v + s_ * NGW); dd[s_] = c.dst; kk[s_] = c.K; cvt_load(c, vv[s_], g0[s_], g1[s_], lane); } }
#pragma unroll 1
    for (bool more = true; more; v += NS * NGW) {
#pragma unroll
        for (int s_ = 0; s_ < NS; ++s_) {
            if (more && has[s_]) {
                const bool hn = v + (s_ + NS) * NGW < count; CvtItem cn{}; if (hn) cn = CVT_ITEM(v + (s_ + NS) * NGW);
                cvt_process(dd[s_], kk[s_], vv[s_], g0[s_], g1[s_], cn, hn, scr, lane); dd[s_] = cn.dst; kk[s_] = cn.K; has[s_] = hn;
            } else more = false;
        }
    }
#undef CVT_ITEM
}
__device__ __forceinline__ void rms_row(const f32x4 (&v)[8], const float* g, bf16* obf, float* of32, int lane) {
    float s = 0.f;
#pragma unroll
    for (int j = 0; j < 8; ++j) s += (v[j].x * v[j].x + v[j].y * v[j].y) + (v[j].z * v[j].z + v[j].w * v[j].w);
    const float rstd = rsqrtf(wave_sum(s, lane) * (1.f / DM) + EPS);
#pragma unroll
    for (int j = 0; j < 8; ++j) { const f32x4 gv = *(const f32x4*)(g + j * 256 + lane * 4); const f32x4 y = v[j] * rstd * gv;
        if (obf) { v2u w; w.x = pk2(y.x, y.y); w.y = pk2(y.z, y.w); *(GAS v2u*)(obf + j * 256 + lane * 4) = w; }
        else *(GAS f32x4*)(of32 + j * 256 + lane * 4) = y; }
}

__device__ __forceinline__ size_t inproj_colmap(int n0) {
    const int seg = n0 >> 10;
    if (seg >= 2) return (size_t)n0;
    const int w = n0 & 1023, hm = w >> 6, half = (w >> 5) & 1;
    return (size_t)(seg * 1024 + (hm >> 2) * 256 + half * 128 + (hm & 3) * 32);
}
__device__ __forceinline__ void p0_prologue(Frame& F, const Args& a, unsigned char* ws) {
    const int gw = F.vcu * NWAVES + F.wave, NGW = F.G * NWAVES;
#if CVT_HOST
    p0_convert<true>(F, a, ws, 0, 0, I_IN);
    if (gw == 0 && F.lane < 7) { const float* pv = F.lane == 0 ? a.w_in : F.lane == 1 ? a.w_out : F.lane == 2 ? a.w_gate : F.lane == 3 ? a.w_up : F.lane == 4 ? a.w_down : F.lane == 5 ? a.norm1_g : a.norm2_g;
        ((GAS unsigned long long*)(ws + WS_PTAB))[F.lane] = (unsigned long long)(uintptr_t)pv; }
#else
    for (int l = 0; l < NL; ++l) p0_convert<true>(F, a, ws, l, 0, PER_LAYER);
#endif
    { float* rope = (float*)(ws + WS_ROPE); const int gt = F.vcu * 512 + F.tid, NGT = F.G * 512;
      for (int e = gt; e < T * 32; e += NGT) { const int t = e >> 5, i = e & 31;
          const double inv = exp2(-(double)i * (13.287712379549449 / 32.0));
          const double ang = (double)((float)a.pos[t] * (float)inv);
          const double n = rint(ang * 0.6366197723675814);
          const double f = (ang - n * 1.5707963267948966) - n * 6.123233995736766e-17;
          const double f2 = f * f;
          const double sn = f * (1.0 + f2 * (-1.0 / 6 + f2 * (1.0 / 120 + f2 * (-1.0 / 5040 + f2 * (1.0 / 362880 + f2 * (-1.0 / 39916800))))));
          const double cs = 1.0 + f2 * (-0.5 + f2 * (1.0 / 24 + f2 * (-1.0 / 720 + f2 * (1.0 / 40320 + f2 * (-1.0 / 3628800 + f2 * (1.0 / 479001600))))));
          const int q = ((int)(long long)n) & 3;
          const double c_ = (q == 0) ? cs : (q == 1) ? -sn : (q == 2) ? -cs : sn;
          const double s_ = (q == 0) ? sn : (q == 1) ? cs : (q == 2) ? -sn : -cs;
          rope[(size_t)t * 64 + i] = (float)c_; rope[(size_t)t * 64 + 32 + i] = (float)s_; }
      float* lbs = (float*)(ws + WS_LBS);
      for (int e = gt; e < 2 * 1024; e += NGT) { const int dir = e >> 10, c = e & 1023; const float* lg = a.lblog + (size_t)dir * NL * 1024 + c;
          const float l0 = lg[0], l1 = lg[1024], l2 = lg[2048], l3 = lg[3072]; const float mx = fmaxf(fmaxf(l0, l1), fmaxf(l2, l3));
          const float e0 = expf(l0 - mx), e1 = expf(l1 - mx), e2 = expf(l2 - mx), e3 = expf(l3 - mx); const float inv = 1.0f / (e0 + e1 + e2 + e3);
          float* o = lbs + (size_t)dir * NL * 1024 + c; o[0] = 0.f; o[1024] = e1 * inv; o[2048] = (e1 + e2) * inv; o[3072] = (e1 + e2 + e3) * inv; }
    }
    { float* par = (float*)(ws + WS_PAR); const int gt = F.vcu * 512 + F.tid, NGT = F.G * 512;
      for (int e = gt; e < PAR_END; e += NGT) { float v;
          if (e < PAR_N2) v = a.norm1_g[e - PAR_N1]; else if (e < PAR_FG) v = a.norm2_g[e - PAR_N2]; else if (e < PAR_DLAM) v = a.final_g[e - PAR_FG]; else if (e < PAR_SUBG) v = a.dlam[e - PAR_DLAM];
          else if (e < PAR_HGN) v = a.subg[e - PAR_SUBG]; else if (e < PAR_RW) v = a.hgn[e - PAR_HGN]; else v = a.router_w[e - PAR_RW];
          par[e] = v; } }
    { bf16* RWS = (bf16*)(ws + WS_RWS); const int gt = F.vcu * 512 + F.tid, NGT = F.G * 512;
      for (int i = gt; i < NL * DM * NE; i += NGT) { const int l = i / (DM * NE), r = i % (DM * NE), dd = r >> 4, e = r & 15;
          const float wv = a.router_w[i] * a.norm2_g[l * DM + dd]; const unsigned hi_ = pk2(wv, 0.f) & 0xffffu; const float lo_f = wv - __uint_as_float(hi_ << 16);
          bf16* img = RWS + (size_t)l * (RW_IMG / 2); img[e * RW_PITCH + dd] = (bf16)hi_; img[NE * RW_PITCH + e * RW_PITCH + dd] = (bf16)(pk2(lo_f, 0.f) & 0xffffu); } }
    { bf16* X = (bf16*)(ws + WS_X); float* RS1 = (float*)(ws + WS_RS1);
      for (int m = gw; m < T; m += NGW) { float ss = 0.f;
#pragma unroll
          for (int j = 0; j < 8; ++j) { const f32x4 v = *(const GAS f32x4*)(a.x + (size_t)m * DM + j * 256 + F.lane * 4); ss += (v.x * v.x + v.y * v.y) + (v.z * v.z + v.w * v.w);
              v2u w; w.x = pk2(v.x, v.y); w.y = pk2(v.z, v.w); *(GAS v2u*)(X + (size_t)m * DM + j * 256 + F.lane * 4) = w; }
          ss = wave_sum(ss, F.lane); if (F.lane == 0) RS1[m] = rsqrtf(ss * (1.f / DM) + EPS); } }
}

__device__ __forceinline__ void router_phase(Frame& F, const bf16* X, const bf16* RWimg, float* RS2, float* AFFT) {
    typedef short bf16x8r __attribute__((ext_vector_type(8)));
    { const GAS v4u* s = (const GAS v4u*)RWimg; LAS v4u* d = (LAS v4u*)F.lds;
      for (int i = F.tid; i < RW_IMG / 16; i += 512) d[i] = s[i]; }
    __syncthreads();
    const int lane = F.lane, r16 = lane & 15, q = lane >> 4;
    const LAS unsigned char* bhi = F.lds + (r16 * RW_PITCH + 512 * q) * 2; const LAS unsigned char* blo = bhi + NE * RW_PITCH * 2;
    if (F.wave < 4) {
        for (int tile = F.vcu * 4 + F.wave; tile < T / 16; tile += F.G * 4) {
            const bf16* xr = X + (size_t)(tile * 16 + r16) * DM + 512 * q;
            f32x4 acc = (f32x4){0.f, 0.f, 0.f, 0.f}; float ss = 0.f;
#pragma unroll 8
            for (int s = 0; s < 64; ++s) { const bf16x8r a = *(const GAS bf16x8r*)(xr + 8 * s);
                const bf16x8r b0 = *(const LAS bf16x8r*)(bhi + 16 * s), b1 = *(const LAS bf16x8r*)(blo + 16 * s);
                acc = __builtin_amdgcn_mfma_f32_16x16x32_bf16(a, b0, acc, 0, 0, 0); acc = __builtin_amdgcn_mfma_f32_16x16x32_bf16(a, b1, acc, 0, 0, 0);
#pragma unroll
                for (int j = 0; j < 8; ++j) { const float v = __uint_as_float(((unsigned)(unsigned short)a[j]) << 16); ss += v * v; } }
            ss += shx(ss, 16, lane); ss += shx(ss, 32, lane);
            const float rstd = rsqrtf(ss * (1.f / DM) + EPS);
            if (q == 0) RS2[tile * 16 + r16] = rstd;
#pragma unroll
            for (int r = 0; r < 4; ++r) { const float rr = __int_as_float(shi(__float_as_int(rstd), 4 * q + r)); float lg = acc[r] * rr; float mx = lg;
#pragma unroll
                for (int o = 1; o < 16; o <<= 1) mx = fmaxf(mx, shx(mx, o, lane));
                const float ex = expf(lg - mx); float sum = ex;
#pragma unroll
                for (int o = 1; o < 16; o <<= 1) sum += shx(sum, o, lane);
                AFFT[(size_t)r16 * T + tile * 16 + 4 * q + r] = ex / sum; }
        }
    }
    __syncthreads();
}

__device__ __forceinline__ unsigned topk_total(Frame& F, LAS unsigned* cnt, int par, unsigned wave_count) {
    if (F.lane == 0) cnt[par * 8 + F.wave] = wave_count;
    __syncthreads();
    unsigned tot = 0;
#pragma unroll
    for (int w_ = 0; w_ < 8; ++w_) tot += cnt[par * 8 + w_];
    return tot;
}
__device__ __forceinline__ void topk_expert(Frame& F, int e, const float* AFFT, const float* RS2, int* IDX, float* GATE, float* RSG, int* SLOTT) {
    LAS unsigned* cnt = (LAS unsigned*)F.lds;
    const int tid = F.tid, lane = F.lane, wid = F.wave;
    unsigned key[32];
#pragma unroll
    for (int i = 0; i < 8; ++i) { const v4u k4 = *(const GAS v4u*)(AFFT + (size_t)e * T + 32 * tid + 4 * i); key[4 * i] = k4.x; key[4 * i + 1] = k4.y; key[4 * i + 2] = k4.z; key[4 * i + 3] = k4.w; }
    unsigned tkey = 0u;
#pragma unroll 1
    for (int b = 30; b >= 0; --b) {
        const unsigned cand = tkey | (1u << b); unsigned c = 0u;
#pragma unroll
        for (int i = 0; i < 32; ++i) c += (unsigned)__popcll(__ballot(key[i] >= cand));
        if (topk_total(F, cnt, b & 1, c) >= (unsigned)CAP) tkey = cand;
    }
    unsigned gmask = 0u, emask = 0u, cgw = 0u;
#pragma unroll
    for (int i = 0; i < 32; ++i) { gmask |= (key[i] > tkey ? 1u : 0u) << i; emask |= (key[i] == tkey ? 1u : 0u) << i; cgw += (unsigned)__popcll(__ballot(key[i] > tkey)); }
    const int cg = __popc(gmask), ce = __popc(emask);
    const unsigned krem = (unsigned)CAP - topk_total(F, cnt, 1, cgw);
    int ig = cg, ie = ce;
#pragma unroll
    for (int off = 1; off < 64; off <<= 1) { const int tg = shi(ig, (lane - off) & 63), te = shi(ie, (lane - off) & 63); if (lane >= off) { ig += tg; ie += te; } }
    if (lane == 63) { cnt[16 + 2 * wid] = (unsigned)ig; cnt[17 + 2 * wid] = (unsigned)ie; }
    __syncthreads();
    int og = 0, oe = 0;
    for (int w_ = 0; w_ < wid; ++w_) { og += (int)cnt[16 + 2 * w_]; oe += (int)cnt[17 + 2 * w_]; }
    const int gbefore = og + ig - cg, ebefore = oe + ie - ce;
    const float* rs2p = RS2 + 32 * tid; int* idxp = IDX + e * CAP; float* gatep = GATE + e * CAP; float* rsgp = RSG + e * CAP;
    int sl[4];
#pragma unroll
    for (int i = 0; i < 32; ++i) { const unsigned low = (1u << i) - 1u;
        const int gb = gbefore + __popc(gmask & low), eb = ebefore + __popc(emask & low);
        const bool isg = (gmask >> i) & 1u, ise = (emask >> i) & 1u;
        const bool sel = isg || (ise && eb < (int)krem);
        const int slot = gb + (eb < (int)krem ? eb : (int)krem);
        sl[i & 3] = sel ? slot : -1;
        if (sel) { idxp[slot] = 32 * tid + i; gatep[slot] = __uint_as_float(key[i]); rsgp[slot] = rs2p[i]; }
        if ((i & 3) == 3) *(GAS v4u*)(SLOTT + (size_t)e * T + 32 * tid + (i - 3)) = (v4u){(unsigned)sl[0], (unsigned)sl[1], (unsigned)sl[2], (unsigned)sl[3]}; }
    __syncthreads();
}

__device__ __forceinline__ void combine_phase(Frame& F, bf16* X, const bf16* Y, const int* SLOT, float* RS1, const float* gfin, float* OUT) {
    const int gw = F.vcu * NWAVES + F.wave, NGW = F.G * NWAVES;
    v4u xn[4]; int slotn = -1;
    if (gw < T) {
#pragma unroll
        for (int j = 0; j < 4; ++j) xn[j] = *(const GAS v4u*)(X + (size_t)gw * DM + j * 512 + F.lane * 8);
        slotn = (F.lane < NE) ? SLOT[(size_t)F.lane * T + gw] : -1; }
    for (int row = gw; row < T; row += NGW) {
        float x[4][8];
#pragma unroll
        for (int j = 0; j < 4; ++j) { x[j][0] = __uint_as_float(xn[j].x << 16); x[j][1] = __uint_as_float(xn[j].x & 0xffff0000u); x[j][2] = __uint_as_float(xn[j].y << 16); x[j][3] = __uint_as_float(xn[j].y & 0xffff0000u);
            x[j][4] = __uint_as_float(xn[j].z << 16); x[j][5] = __uint_as_float(xn[j].z & 0xffff0000u); x[j][6] = __uint_as_float(xn[j].w << 16); x[j][7] = __uint_as_float(xn[j].w & 0xffff0000u); }
        const int myslot = slotn;
        if (row + NGW < T) {
#pragma unroll
            for (int j = 0; j < 4; ++j) xn[j] = *(const GAS v4u*)(X + (size_t)(row + NGW) * DM + j * 512 + F.lane * 8);
            slotn = (F.lane < NE) ? SLOT[(size_t)F.lane * T + row + NGW] : -1; }
#pragma unroll 1
        for (int e = 0; e < NE; ++e) { const int s = shi(myslot, e);
            if (s >= 0) { const bf16* yr = Y + ((size_t)e * CAP + s) * DM;
#pragma unroll
                for (int j = 0; j < 4; ++j) { const v4u w = *(const GAS v4u*)(yr + j * 512 + F.lane * 8);
                    x[j][0] += __uint_as_float(w.x << 16); x[j][1] += __uint_as_float(w.x & 0xffff0000u); x[j][2] += __uint_as_float(w.y << 16); x[j][3] += __uint_as_float(w.y & 0xffff0000u);
                    x[j][4] += __uint_as_float(w.z << 16); x[j][5] += __uint_as_float(w.z & 0xffff0000u); x[j][6] += __uint_as_float(w.w << 16); x[j][7] += __uint_as_float(w.w & 0xffff0000u); } } }
        float ss = 0.f;
#pragma unroll
        for (int j = 0; j < 4; ++j)
#pragma unroll
            for (int k = 0; k < 8; ++k) ss += x[j][k] * x[j][k];
        const float rstd = rsqrtf(wave_sum(ss, F.lane) * (1.f / DM) + EPS);
        if (OUT) {
#pragma unroll
            for (int j = 0; j < 4; ++j) { const f32x4 g0 = *(const f32x4*)(gfin + j * 512 + F.lane * 8), g1 = *(const f32x4*)(gfin + j * 512 + F.lane * 8 + 4);
                *(GAS f32x4*)(OUT + (size_t)row * DM + j * 512 + F.lane * 8) = (f32x4){x[j][0] * rstd * g0.x, x[j][1] * rstd * g0.y, x[j][2] * rstd * g0.z, x[j][3] * rstd * g0.w};
                *(GAS f32x4*)(OUT + (size_t)row * DM + j * 512 + F.lane * 8 + 4) = (f32x4){x[j][4] * rstd * g1.x, x[j][5] * rstd * g1.y, x[j][6] * rstd * g1.z, x[j][7] * rstd * g1.w}; }
        } else {
#pragma unroll
            for (int j = 0; j < 4; ++j) { v4u w; w.x = pk2(x[j][0], x[j][1]); w.y = pk2(x[j][2], x[j][3]); w.z = pk2(x[j][4], x[j][5]); w.w = pk2(x[j][6], x[j][7]); *(GAS v4u*)(X + (size_t)row * DM + j * 512 + F.lane * 8) = w; }
            if (F.lane == 0) RS1[row] = rstd; }
    }
}

__device__ __forceinline__ void vt_transpose(Frame& F, const bf16* V, bf16* VT) {
    LAS bf16* tile = (LAS bf16*)(F.lds + F.wave * 9216);
    const int gw = F.vcu * NWAVES + F.wave, NGW = F.G * NWAVES, lane = F.lane;
    for (int it = gw; it < (T / 64) * 16; it += NGW) { const int t0 = (it >> 4) * 64, c0 = (it & 15) * 64;
#pragma unroll
        for (int i = 0; i < 8; ++i) { const int r = (lane >> 3) + 8 * i; *(LAS v4u*)(tile + r * 72 + (lane & 7) * 8) = *(const GAS v4u*)(V + (size_t)(t0 + r) * 1024 + c0 + (lane & 7) * 8); }
        LDS_WAIT(); asm volatile("" ::: "memory");
        const int g = lane & 7;
#pragma unroll
        for (int i = 0; i < 8; ++i) { const int col = (lane >> 3) + 8 * i; const LAS bf16* s = tile + (8 * g) * 72 + col;
            const LAS bf16* s2 = tile + (16 * (g >> 1) + 4 * (g & 1)) * 72 + col;
            v4u o; o.x = (unsigned)s2[0] | ((unsigned)s2[72] << 16); o.y = (unsigned)s2[144] | ((unsigned)s2[216] << 16); o.z = (unsigned)s2[8 * 72] | ((unsigned)s2[9 * 72] << 16); o.w = (unsigned)s2[10 * 72] | ((unsigned)s2[11 * 72] << 16);
            *(GAS v4u*)(VT + (size_t)(c0 + col) * T + t0 + 8 * g) = o; }
        LDS_WAIT(); asm volatile("" ::: "memory");
    }
}

constexpr int PH_PER_LAYER = 11, N_PHASES = 1 + NL * PH_PER_LAYER;
#ifndef PHMASK
#define PHMASK 0xFFFF
#endif
#define PM(b) ((PHMASK >> (b)) & 1)
#ifndef PROBE_NOSTORE
#define PROBE_NOSTORE 0
#endif
#ifndef REPMASK
#define REPMASK 0
#endif
#define NREP(b) (((REPMASK >> (b)) & 1) ? 2 : 1)
#define PHASE_BEGIN() int wv_ = wave_s; asm volatile("" : "+s"(wv_)); int tid_ = wv_ * 64 + (int)xb_lane(); asm volatile("" : "+v"(tid_)); unsigned char* w = args.ws; asm volatile("" : "+s"(w)); \
    int bx_ = blockIdx.x, gx_ = gridDim.x; asm volatile("" : "+s"(bx_), "+s"(gx_)); \
    Frame F; F.lds = lds0; F.MISC = (volatile LAS unsigned*)(lds0 + MISC_OFF); F.tid = tid_; F.lane = tid_ & 63; F.wave = wv_; F.G = gx_; \
    F.vcu = (gx_ % 8 == 0) ? (bx_ % 8) * (gx_ / 8) + bx_ / 8 : bx_
__global__ void __launch_bounds__(NWAVES * 64, 2) mega_fwd(Args args) {
    extern __shared__ __attribute__((aligned(16))) unsigned char lds_raw[];
    LAS unsigned char* const lds0 = (LAS unsigned char*)lds_raw;
    const int wave_s = __builtin_amdgcn_readfirstlane((int)threadIdx.x >> 6);
    if (wave_s < 2) ((LAS unsigned*)(lds0 + MISC_OFF))[wave_s * 64 + (int)xb_lane()] = 0u;
    __syncthreads();
    XcdBarrier bar; bar.bar = (unsigned*)(args.ws + WS_CTL) + CW_BAR; bar.x = 0; bar.st = nullptr; bar.wv = wave_s;
    if (!MK_PER_PHASE) bar = xcd_barrier_post((unsigned*)(args.ws + WS_CTL) + CW_BAR, (volatile LAS unsigned*)(lds0 + MISC_OFF) + 8, wave_s);
    const int lo = args.ph_lo, hi = args.ph_hi;
#define IN(k) (lo <= (k) && (k) < hi)
#define SEAM(k) do { if (IN(k) && IN((k) + 1)) xcd_barrier(bar); } while (0)

    for (int rep_ = 0; rep_ < NREP(0); ++rep_) if (PM(0) && IN(0)) { if (rep_) xcd_barrier(bar); PHASE_BEGIN(); p0_prologue(F, args, w); }
    SEAM(0);

#pragma unroll 1
    for (int l = 0; l < NL; ++l) {
        const int pb = 1 + l * PH_PER_LAYER;
        for (int rep_ = 0; rep_ < NREP(1); ++rep_) if (PM(1) && IN(pb + 0)) { if (rep_) xcd_barrier(bar); PHASE_BEGIN();
            pg8::Gemm g{(bf16*)(w + WS_X), (bf16*)(w + WS_WIN) + (size_t)l * INC * DM, T, INC, DM, 31, 0, nullptr}; pg8::StaticOrder S; S.init(T, INC, F.G, bx_);
            pg8::EpiInProj E{(bf16*)(w + WS_Q), (bf16*)(w + WS_K), (bf16*)(w + WS_V), (bf16*)(w + WS_HQ), (bf16*)(w + WS_KK), (bf16*)(w + WS_HV), (bf16*)(w + WS_HG), (unsigned short*)(w + WS_LF),
                              (const float*)(w + WS_ROPE), (const float*)(w + WS_LBS) + l * 1024, QSCALE, (unsigned*)(w + WS_CTL) + CW_KMAX + l * 16, (PROBE_NOSTORE && rep_) ? 1 : 0, (const float*)(w + WS_RS1)};
            pg8::gemm_phase<pg8::EpiInProj, pg8::StaticOrder, true, true>(F.lds, g, S, E, F.tid);
        }
        SEAM(pb + 0);
        for (int rep_ = 0; rep_ < NREP(2); ++rep_) if (PM(2) && IN(pb + 1)) { if (rep_) xcd_barrier(bar); PHASE_BEGIN();
            const hg::HgArgs HA{(bf16*)(w + WS_HQ), (bf16*)(w + WS_KK), (unsigned short*)(w + WS_LF), (bf16*)(w + WS_HV), (bf16*)(w + WS_HG), (float*)(w + WS_HS), (float*)(w + WS_GS), (float*)(w + WS_HOF), (bf16*)(w + WS_MIX), (const float*)(w + WS_PAR) + PAR_HGN + l * 128};
            for (int s_ = 0; s_ < 2; ++s_) {
                if ((s_ ^ (F.vcu & 1)) == 0) { for (int n = F.vcu; n < 512; n += F.G) hg::hgrn_unit<false>(HA, n >> 8, (n >> 5) & 7, n & 31, F.lds, F.tid); }
                else vt_transpose(F, (const bf16*)(w + WS_V), (bf16*)(w + WS_VT));
                __syncthreads(); }
        }
        SEAM(pb + 1);
        if (PM(3) && IN(pb + 2)) { PHASE_BEGIN(); hg::hgrn_scan((float*)(w + WS_HS), (const float*)(w + WS_GS), F.vcu * 512 + F.tid, F.G * 512); }
        SEAM(pb + 2);
        if (PM(4) && IN(pb + 3)) {
            for (int rep_ = 0; rep_ < NREP(13); ++rep_) if (PM(13)) { if (rep_) xcd_barrier(bar); PHASE_BEGIN();
                const float lam_init = 0.8f - 0.6f * expf(-0.3f * (float)l);
                const float* lv = (const float*)(w + WS_PAR) + PAR_DLAM + l * 256;
                const float s1 = wave_sum(lv[F.lane] * lv[64 + F.lane], F.lane), s2 = wave_sum(lv[128 + F.lane] * lv[192 + F.lane], F.lane);
                const float lam = expf(s1) - expf(s2) + lam_init;
                const att::AttnArgs AA{(bf16*)(w + WS_Q), (bf16*)(w + WS_K), (bf16*)(w + WS_V), (bf16*)(w + WS_VT), (float*)(w + WS_AO1), (bf16*)(w + WS_MIX), (const float*)(w + WS_PAR) + PAR_SUBG + l * 128, (const float*)(w + WS_CTL) + CW_KMAX + l * 16, lam, 1.0f - lam_init};
                #ifdef ATT_OLD_BODY
                for (int n = F.vcu; n < 512; n += F.G) att::attn_unit<0>(AA, (n & 255) >> 5, (n & 31) + 32 * (n >> 8), (AT_LAS char*)F.lds, F.tid);
#else
                { int slot_ = 0; const int cpos = (CVT_HOST && rep_ == 0) ? (int)((unsigned)F.vcu % 6u) : -1; const int ccnt = l < NL - 1 ? PER_LAYER : PER_LAYER - I_IN;
                  for (int n = F.vcu; n < 512; n += F.G, ++slot_) {
                    if (cpos == 2 * slot_) p0_convert<false>(F, args, w, l, I_IN, ccnt);
                    att::attn_unit2<0>(AA, (n & 255) >> 5, (n & 31) + 32 * (n >> 8), (AT_LAS char*)F.lds, F.tid, [&]() { if (cpos == 2 * slot_ + 1) p0_convert<false>(F, args, w, l, I_IN, ccnt); }); } }
#endif
                __syncthreads();
            }
#ifdef HG_PROBE
            { xcd_barrier(bar); PHASE_BEGIN();
                const hg::HgArgs HA{(bf16*)(w + WS_HQ), (bf16*)(w + WS_KK), (unsigned short*)(w + WS_LF), (bf16*)(w + WS_HV), (bf16*)(w + WS_HG), (float*)(w + WS_HS), (float*)(w + WS_GS), (float*)(w + WS_END), (bf16*)(w + WS_END + 64 * MiB), (const float*)(w + WS_PAR) + PAR_HGN + l * 128};
                for (int n = F.vcu; n < 256; n += F.G) { const int h = n >> 5, sc = n & 31;
                    hg::hgrn_unit<true, HG_PROBE>(HA, 0, h, sc, F.lds, F.tid);
                    __threadfence_block(); __syncthreads();
                    hg::hgrn_unit<true, HG_PROBE>(HA, 1, h, sc, F.lds, F.tid); }
            }
#endif
#ifdef ATT_PROBE
            { xcd_barrier(bar); PHASE_BEGIN();
                const att::AttnArgs AA{(bf16*)(w + WS_Q), (bf16*)(w + WS_K), (bf16*)(w + WS_V), (bf16*)(w + WS_VT), (float*)(w + WS_END), (bf16*)(w + WS_END + 64 * MiB), (const float*)(w + WS_PAR) + PAR_SUBG + l * 128, (const float*)(w + WS_CTL) + CW_KMAX + l * 16, 0.5f, 0.5f};
                for (int n = F.vcu; n < 512; n += F.G) att::attn_unit2<ATT_PROBE>(AA, (n & 255) >> 5, (n & 31) + 32 * (n >> 8), (AT_LAS char*)F.lds, F.tid);
                __syncthreads();
            }
#endif
            for (int rep_ = 0; rep_ < NREP(12); ++rep_) if (PM(12)) { if (rep_) xcd_barrier(bar); PHASE_BEGIN();
                const int cpos = (CVT_HOST && rep_ == 0) ? (int)((unsigned)F.vcu % 6u) : -1; const int ccnt = l < NL - 1 ? PER_LAYER : PER_LAYER - I_IN;
                if (cpos == 4) { p0_convert<false>(F, args, w, l, I_IN, ccnt); __syncthreads(); }
                const hg::HgArgs HA{(bf16*)(w + WS_HQ), (bf16*)(w + WS_KK), (unsigned short*)(w + WS_LF), (bf16*)(w + WS_HV), (bf16*)(w + WS_HG), (float*)(w + WS_HS), (float*)(w + WS_GS), (float*)(w + WS_HOF), (bf16*)(w + WS_MIX), (const float*)(w + WS_PAR) + PAR_HGN + l * 128};
                for (int n = F.vcu; n < 256; n += F.G) { const int h = n >> 5, sc = n & 31;
                    hg::hgrn_unit<true>(HA, 0, h, sc, F.lds, F.tid);
                    __threadfence_block(); __syncthreads();
                    hg::hgrn_unit<true>(HA, 1, h, sc, F.lds, F.tid); }
                if (cpos == 5) { __syncthreads(); p0_convert<false>(F, args, w, l, I_IN, ccnt); }
            }
        }
        SEAM(pb + 3);
        for (int rep_ = 0; rep_ < NREP(5); ++rep_) if (PM(5) && IN(pb + 4)) { if (rep_) xcd_barrier(bar); PHASE_BEGIN();
            pg8::Gemm g{(bf16*)(w + WS_MIX), (bf16*)(w + WS_WOUT) + (size_t)l * DM * DM, T, DM, DM, 31, 0, nullptr}; pg8::StaticOrder S; S.init(T, DM, F.G, bx_);
            if (l == 0) { pg8::EpiResidBf<true> E{args.x, (bf16*)(w + WS_X)}; pg8::gemm_phase<pg8::EpiResidBf<true>, pg8::StaticOrder, true, true>(F.lds, g, S, E, F.tid); }
            else { pg8::EpiResidBf<false> E{nullptr, (bf16*)(w + WS_X)}; pg8::gemm_phase<pg8::EpiResidBf<false>, pg8::StaticOrder, true, true>(F.lds, g, S, E, F.tid); }
        }
        SEAM(pb + 4);
        for (int rep_ = 0; rep_ < NREP(6); ++rep_) if (PM(6) && IN(pb + 5)) { if (rep_) xcd_barrier(bar); PHASE_BEGIN(); router_phase(F, (const bf16*)(w + WS_X), (const bf16*)(w + WS_RWS + (size_t)l * RW_IMG), (float*)(w + WS_RS2), (float*)(w + WS_AFF)); }
        SEAM(pb + 5);
        for (int rep_ = 0; rep_ < NREP(7); ++rep_) if (PM(7) && IN(pb + 6)) { if (rep_) xcd_barrier(bar); PHASE_BEGIN(); for (int e = bx_; e < NE; e += F.G) topk_expert(F, e, (const float*)(w + WS_AFF), (const float*)(w + WS_RS2), (int*)(w + WS_IDX), (float*)(w + WS_GATE), (float*)(w + WS_RSG), (int*)(w + WS_SLOT)); }
        SEAM(pb + 6);
        for (int rep_ = 0; rep_ < NREP(9); ++rep_) if (PM(9) && IN(pb + 8)) { if (rep_) xcd_barrier(bar); PHASE_BEGIN();
            pg8::Gemm g{(bf16*)(w + WS_X), (bf16*)(w + WS_WGU) + (size_t)l * NE * 2048 * DM, XR, 2048, DM, 3, (size_t)2048 * DM * 2, (const int*)(w + WS_IDX)}; pg8::StaticOrder S; S.init(XR, 2048, F.G, bx_);
            pg8::EpiSwiGLU E{(bf16*)(w + WS_HM), (const float*)(w + WS_RSG)};
            pg8::gemm_phase<pg8::EpiSwiGLU, pg8::StaticOrder, true, true, true>(F.lds, g, S, E, F.tid);
        }
        SEAM(pb + 8);
        for (int rep_ = 0; rep_ < NREP(10); ++rep_) if (PM(10) && IN(pb + 9)) { if (rep_) xcd_barrier(bar); PHASE_BEGIN();
            pg8::Gemm g{(bf16*)(w + WS_HM), (bf16*)(w + WS_WDN) + (size_t)l * NE * DM * FF, XR, DM, FF, 3, (size_t)DM * FF * 2, nullptr}; pg8::StaticOrder S; S.init(XR, DM, F.G, bx_);
            pg8::EpiDown E{(bf16*)(w + WS_Y), (const float*)(w + WS_GATE)};
            pg8::gemm_phase<pg8::EpiDown, pg8::StaticOrder, true, true>(F.lds, g, S, E, F.tid);
        }
        SEAM(pb + 9);
        for (int rep_ = 0; rep_ < NREP(11); ++rep_) if (PM(11) && IN(pb + 10)) { if (rep_) xcd_barrier(bar); PHASE_BEGIN();
            if (l < NL - 1) combine_phase(F, (bf16*)(w + WS_X), (const bf16*)(w + WS_Y), (const int*)(w + WS_SLOT), (float*)(w + WS_RS1), nullptr, nullptr);
            else combine_phase(F, (bf16*)(w + WS_X), (const bf16*)(w + WS_Y), (const int*)(w + WS_SLOT), nullptr, (const float*)(w + WS_PAR) + PAR_FG, args.out);
        }
        SEAM(pb + 10);
    }
#undef IN
#undef SEAM
}

extern "C" void kernel_launch(void* const* d_in, const int* in_sizes, int n_in, void* d_out, int out_size, void* d_ws, size_t ws_size, hipStream_t stream) {
    static int grid = 0;
    if (grid == 0) {
        if (n_in != 15 || in_sizes[0] != T * DM || out_size != T * DM || ws_size < WS_END) { fprintf(stderr, "kernel_launch: shape/workspace mismatch (n_in %d, ws %zu < %zu)\n", n_in, ws_size, (size_t)WS_END); grid = -1; return; }
        int dev = 0, cus = 0, per_cu = 0;
        if (hipGetDevice(&dev) != hipSuccess || hipDeviceGetAttribute(&cus, hipDeviceAttributeMultiprocessorCount, dev) != hipSuccess) { grid = -1; return; }
        if (hipFuncSetAttribute((const void*)mega_fwd, hipFuncAttributeMaxDynamicSharedMemorySize, LDS_BYTES) != hipSuccess) { fprintf(stderr, "kernel_launch: hipFuncSetAttribute failed\n"); grid = -1; return; }
        if (hipOccupancyMaxActiveBlocksPerMultiprocessor(&per_cu, (const void*)mega_fwd, NWAVES * 64, LDS_BYTES) != hipSuccess || per_cu < 1) fprintf(stderr, "kernel_launch: occupancy query reports %d\n", per_cu);
        (void)hipGetLastError();
        grid = cus;
    }
    if (grid < 0) return;
    if (hipMemsetAsync((char*)d_ws + WS_CTL, 0, CTL_ZERO_BYTES, stream) != hipSuccess) return;
    Args a{};
    a.x = (const float*)d_in[0]; a.pos = (const int*)d_in[1]; a.norm1_g = (const float*)d_in[2]; a.w_in = (const float*)d_in[3]; a.dlam = (const float*)d_in[4]; a.subg = (const float*)d_in[5];
    a.lblog = (const float*)d_in[6]; a.hgn = (const float*)d_in[7]; a.w_out = (const float*)d_in[8]; a.norm2_g = (const float*)d_in[9]; a.router_w = (const float*)d_in[10];
    a.w_gate = (const float*)d_in[11]; a.w_up = (const float*)d_in[12]; a.w_down = (const float*)d_in[13]; a.final_g = (const float*)d_in[14];
    a.out = (float*)d_out; a.ws = (unsigned char*)d_ws;
#if MK_PER_PHASE
    for (int p = 0; p < N_PHASES; ++p) { a.ph_lo = p; a.ph_hi = p + 1; hipLaunchKernelGGL(mega_fwd, dim3(grid), dim3(NWAVES * 64), LDS_BYTES, stream, a); }
#else
    a.ph_lo = 0; a.ph_hi = N_PHASES; hipLaunchKernelGGL(mega_fwd, dim3(grid), dim3(NWAVES * 64), LDS_BYTES, stream, a);
#endif
    const hipError_t le = hipPeekAtLastError();
    if (le != hipSuccess) fprintf(stderr, "kernel_launch: launch failed: %s\n", hipGetErrorName(le));
}
```

```cpp
#include <hip/hip_runtime.h>
#include <hip/hip_bf16.h>
#include <cstdio>
#include <cstdint>
__device__ __forceinline__ float shx(float v, int off, int lane) { return __int_as_float(__builtin_amdgcn_ds_bpermute((lane ^ off) << 2, __float_as_int(v))); }
__device__ __forceinline__ int shi(int v, int src) { return __builtin_amdgcn_ds_bpermute(src << 2, v); }
namespace pg8 {
#define PG8_LAS __attribute__((address_space(3)))
typedef unsigned short bf16_t;
typedef short bf16x8 __attribute__((ext_vector_type(8)));
typedef float f32x4 __attribute__((ext_vector_type(4)));
typedef unsigned u32x4 __attribute__((ext_vector_type(4)));
constexpr int BM = 256, BK = 64, HALF = 128, HTB = HALF * BK * 2  , STAGE_BYTES = 8 * HTB, NXCD = 8, WGM = 8;

__host__ __device__ __forceinline__ int lds_byte(int r, int c) { const int st = (r >> 4) * 2 + (c >> 5), rr = r & 15, cc = c & 31, ob = rr * 64 + cc * 2; return st * 1024 + (ob ^ (((ob >> 9) & 1) << 5)); }
__host__ __device__ __forceinline__ void stage_rc(int b, int& R, int& C) { const int st = b / 1024, sb = b % 1024, swz = sb ^ (((sb >> 9) & 1) << 5); R = (st >> 1) * 16 + swz / 64; C = (st & 1) * 32 + (swz % 64) / 2; }
__host__ __device__ __forceinline__ int perm32(int rho) { const int n = rho >> 4, i = rho & 15; return 8 * (i >> 2) + 4 * n + (i & 3); }

struct Unit { int pm, pn; };
struct Gemm { const bf16_t* A; const bf16_t* Bt; int M, N, K; int gshift; size_t gstride; const int* gidx; };

struct StaticOrder {
    int nM, nN, nwg, G, c;
    __host__ __device__ void init(int M, int N, int G_, int c_) { nM = M / BM; nN = N / BM; nwg = nM * nN; G = G_; c = c_; }
    __host__ __device__ bool next(int i, Unit& u) const {
        const long L = (long)i * G + c; if (L >= nwg) return false;
        int wgid = (int)L; { const int q = nwg / NXCD, r = nwg % NXCD, xcd = wgid % NXCD, off = wgid / NXCD; wgid = (xcd < r ? xcd * (q + 1) : r * (q + 1) + (xcd - r) * q) + off; }
        const int nig = WGM * nN, gid = wgid / nig, fm = gid * WGM, gsz = (nM - fm) < WGM ? (nM - fm) : WGM;
        u.pm = fm + ((wgid % nig) % gsz); u.pn = (wgid % nig) / gsz; return true;
    }
    __device__ __forceinline__ void a_ready(const Unit&) const {}
    __device__ __forceinline__ void done(const Unit&) const {}
};

#define PG8_GAS __attribute__((address_space(1)))
typedef float f32x2 __attribute__((ext_vector_type(2)));
typedef __bf16 bf16x2_t __attribute__((ext_vector_type(2)));
__device__ __forceinline__ unsigned cvt_pk_bf16(float lo, float hi) { f32x2 v = {lo, hi}; bf16x2_t b = __builtin_convertvector(v, bf16x2_t); return __builtin_bit_cast(unsigned, b); }
__device__ __forceinline__ u32x4 pack8(const f32x4 v0, const f32x4 v1) { u32x4 w; w.x = cvt_pk_bf16(v0[0], v0[1]); w.y = cvt_pk_bf16(v0[2], v0[3]); w.z = cvt_pk_bf16(v1[0], v1[1]); w.w = cvt_pk_bf16(v1[2], v1[3]); return w; }
__device__ __forceinline__ float sigmoidf_(float x) { return __builtin_amdgcn_rcpf(1.0f + __expf(-x)); }
__device__ __forceinline__ f32x4 silu4(const f32x4 v) { f32x4 o; o[0] = v[0] * sigmoidf_(v[0]); o[1] = v[1] * sigmoidf_(v[1]); o[2] = v[2] * sigmoidf_(v[2]); o[3] = v[3] * sigmoidf_(v[3]); return o; }

struct EpiInProj {
    static constexpr bool PERM = true, AFTER_DRAIN = false;
    bf16_t *Q, *Kb, *V, *HQ, *KK, *HV, *HG; unsigned short* LF;   const float* rope; const float* lbs;
    float qscale; unsigned* kmax; int nostore; const float* rs;
    __device__ __forceinline__ void operator()(const f32x4 (&acc)[2][2][4][2], const Unit& u, int wr, int wc, int fr, int fq) const {
        const int seg = u.pn >> 2, tp = u.pn & 3;
        const int row0 = u.pm * BM + wr * 64 + fr;
        if (seg < 2) {
            bf16_t* dst = seg == 0 ? Q : Kb; const float sc = seg == 0 ? qscale : 1.0f;
            const int col = (tp * 4 + wc) * 64 + 8 * fq;
            float kmx = 0.f;
#pragma unroll
            for (int ai = 0; ai < 2; ++ai)
#pragma unroll
                for (int m = 0; m < 4; ++m) { const int row = row0 + ai * HALF + m * 16;
                    const float* tb = rope + (size_t)row * 64 + 8 * fq;
                    const f32x4 c0 = *(const PG8_GAS f32x4*)(tb), c1 = *(const PG8_GAS f32x4*)(tb + 4), s0 = *(const PG8_GAS f32x4*)(tb + 32), s1 = *(const PG8_GAS f32x4*)(tb + 36);
                    const float r_ = ((const PG8_GAS float*)rs)[row]; const f32x4 xa = acc[ai][0][m][0] * r_, xb = acc[ai][0][m][1] * r_, ya = acc[ai][1][m][0] * r_, yb = acc[ai][1][m][1] * r_;
                    const f32x4 o1a = (xa * c0 - ya * s0) * sc, o1b = (xb * c1 - yb * s1) * sc, o2a = (ya * c0 + xa * s0) * sc, o2b = (yb * c1 + xb * s1) * sc;
                    bf16_t* rowp = dst + (size_t)row * 1024 + col;
                    if (!nostore) { *(PG8_GAS u32x4*)(rowp) = pack8(o1a, o1b); *(PG8_GAS u32x4*)(rowp + 32) = pack8(o2a, o2b); }
                    if (seg == 1) { const f32x4 q2 = xa * xa + xb * xb + ya * ya + yb * yb; float ss = (q2[0] + q2[1]) + (q2[2] + q2[3]);
                        ss += shx(ss, 16, fq * 16 + fr); ss += shx(ss, 32, fq * 16 + fr); kmx = fmaxf(kmx, ss); } }
            if (seg == 1) {
#pragma unroll
                for (int o_ = 1; o_ < 16; o_ <<= 1) kmx = fmaxf(kmx, shx(kmx, o_, fq * 16 + fr));
                if (fr == 0 && fq == 0) __hip_atomic_fetch_max(kmax + tp * 4 + wc, __float_as_uint(sqrtf(kmx)), __ATOMIC_RELAXED, __HIP_MEMORY_SCOPE_AGENT); }
        } else if (seg == 4 || seg == 5) {
            const int dir = seg - 4;
#pragma unroll
            for (int bj = 0; bj < 2; ++bj) { const int col = tp * 256 + bj * HALF + wc * 32 + 8 * fq;
                const f32x4 lb0 = *(const PG8_GAS f32x4*)(lbs + dir * 4096 + col), lb1 = *(const PG8_GAS f32x4*)(lbs + dir * 4096 + col + 4);
#pragma unroll
                for (int ai = 0; ai < 2; ++ai)
#pragma unroll
                    for (int m = 0; m < 4; ++m) { const int row = row0 + ai * HALF + m * 16;
                        f32x4 lf0, lf1, k0, k1; const float r_ = ((const PG8_GAS float*)rs)[row];
#pragma unroll
                        for (int q = 0; q < 4; ++q) { const float z0 = fminf(fmaxf(acc[ai][bj][m][0][q] * r_, -80.f), 80.f), z1 = fminf(fmaxf(acc[ai][bj][m][1][q] * r_, -80.f), 80.f);
                            const float e0 = __expf(-z0), e1 = __expf(-z1), sg0 = __builtin_amdgcn_rcpf(1.0f + e0), sg1 = __builtin_amdgcn_rcpf(1.0f + e1);
                            lf0[q] = __logf(lb0[q] + (1.0f - lb0[q]) * sg0); lf1[q] = __logf(lb1[q] + (1.0f - lb1[q]) * sg1);
                            k0[q] = (1.0f - lb0[q]) * (e0 * sg0); k1[q] = (1.0f - lb1[q]) * (e1 * sg1); }
                        unsigned short* lfp = LF + (size_t)row * 2048 + dir * 1024 + col; if (!nostore) { typedef _Float16 h2_t __attribute__((ext_vector_type(2))); u32x4 hw_;
                        hw_.x = __builtin_bit_cast(unsigned, __builtin_convertvector((f32x2){lf0[0], lf0[1]}, h2_t)); hw_.y = __builtin_bit_cast(unsigned, __builtin_convertvector((f32x2){lf0[2], lf0[3]}, h2_t));
                        hw_.z = __builtin_bit_cast(unsigned, __builtin_convertvector((f32x2){lf1[0], lf1[1]}, h2_t)); hw_.w = __builtin_bit_cast(unsigned, __builtin_convertvector((f32x2){lf1[2], lf1[3]}, h2_t)); *(u32x4*)lfp = hw_;
                        *(PG8_GAS u32x4*)(KK + (size_t)row * 2048 + dir * 1024 + col) = pack8(k0, k1); } else if (lf0[0] + lf1[1] + k0[2] + k1[3] == 12345.678f) *lfp = 0; }
            }
        } else {
            bf16_t* dst = seg == 2 ? V : seg == 3 ? HQ : seg == 6 ? HV : HG;
#pragma unroll
            for (int bj = 0; bj < 2; ++bj) { const int col = tp * 256 + bj * HALF + wc * 32 + 8 * fq;
#pragma unroll
                for (int ai = 0; ai < 2; ++ai)
#pragma unroll
                    for (int m = 0; m < 4; ++m) { const int row = row0 + ai * HALF + m * 16;
                        const float r_ = ((const PG8_GAS float*)rs)[row]; f32x4 v0 = acc[ai][bj][m][0] * r_, v1 = acc[ai][bj][m][1] * r_;
                        if (seg == 3) { v0 = silu4(v0) * 0.08838834764831845f; v1 = silu4(v1) * 0.08838834764831845f; }
                        else if (seg == 7) { v0 = silu4(v0); v1 = silu4(v1); }
                        if (!nostore) *(PG8_GAS u32x4*)(dst + (size_t)row * 1024 + col) = pack8(v0, v1); else if (v0[0] + v1[1] == 12345.678f) dst[0] = 0; }
            }
        }
    }
};
template <bool F32BASE> struct EpiResidBf {
    static constexpr bool PERM = true, AFTER_DRAIN = false;
    const float* xf; bf16_t* X;
    __device__ __forceinline__ void operator()(const f32x4 (&acc)[2][2][4][2], const Unit& u, int wr, int wc, int fr, int fq) const {
#pragma unroll
        for (int ai = 0; ai < 2; ++ai)
#pragma unroll
            for (int m = 0; m < 4; ++m) { const size_t row = (size_t)(u.pm * BM + ai * HALF + wr * 64 + m * 16 + fr);
#pragma unroll
                for (int bj = 0; bj < 2; ++bj) { const size_t off = row * 2048 + u.pn * BM + bj * HALF + wc * 32 + 8 * fq;
                    f32x4 b0, b1;
                    if (F32BASE) { b0 = *(const PG8_GAS f32x4*)(xf + off); b1 = *(const PG8_GAS f32x4*)(xf + off + 4); }
                    else { const u32x4 w = *(const PG8_GAS u32x4*)(X + off); b0 = (f32x4){__uint_as_float(w.x << 16), __uint_as_float(w.x & 0xffff0000u), __uint_as_float(w.y << 16), __uint_as_float(w.y & 0xffff0000u)};
                           b1 = (f32x4){__uint_as_float(w.z << 16), __uint_as_float(w.z & 0xffff0000u), __uint_as_float(w.w << 16), __uint_as_float(w.w & 0xffff0000u)}; }
                    *(PG8_GAS u32x4*)(X + off) = pack8(b0 + acc[ai][bj][m][0], b1 + acc[ai][bj][m][1]); } }
    }
};
struct EpiSwiGLU {
    static constexpr bool PERM = true, AFTER_DRAIN = false;
    bf16_t* H; const float* rsg;
    __device__ __forceinline__ void operator()(const f32x4 (&acc)[2][2][4][2], const Unit& u, int wr, int wc, int fr, int fq) const {
        const int col = u.pn * HALF + wc * 32 + 8 * fq;
#pragma unroll
        for (int ai = 0; ai < 2; ++ai)
#pragma unroll
            for (int m = 0; m < 4; ++m) { const int row = u.pm * BM + ai * HALF + wr * 64 + m * 16 + fr; const float r_ = ((const PG8_GAS float*)rsg)[row];
                const f32x4 h0 = silu4(acc[ai][0][m][0] * r_) * (acc[ai][1][m][0] * r_), h1 = silu4(acc[ai][0][m][1] * r_) * (acc[ai][1][m][1] * r_);
                *(PG8_GAS u32x4*)(H + (size_t)row * 1024 + col) = pack8(h0, h1); }
    }
};
struct EpiDown {
    static constexpr bool PERM = true, AFTER_DRAIN = false;
    bf16_t* Y; const float* gate;
    __device__ __forceinline__ void operator()(const f32x4 (&acc)[2][2][4][2], const Unit& u, int wr, int wc, int fr, int fq) const {
#pragma unroll
        for (int ai = 0; ai < 2; ++ai)
#pragma unroll
            for (int m = 0; m < 4; ++m) { const int row = u.pm * BM + ai * HALF + wr * 64 + m * 16 + fr; const float g = ((const PG8_GAS float*)gate)[row];
#pragma unroll
                for (int bj = 0; bj < 2; ++bj) { const int col = u.pn * BM + bj * HALF + wc * 32 + 8 * fq;
                    *(PG8_GAS u32x4*)(Y + (size_t)row * 2048 + col) = pack8(acc[ai][bj][m][0] * g, acc[ai][bj][m][1] * g); } }
    }
};
template <class Epi, class Sched, bool ALIGN_EPI = false, bool SP2 = false, bool GATHER = false>
__device__ __forceinline__ void gemm_phase(PG8_LAS unsigned char* lds, const Gemm g, const Sched& S, const Epi& E, const int tid) {
    const int wid = __builtin_amdgcn_readfirstlane(tid >> 6), lane = tid & 63, wr = wid >> 2, wc = wid & 3, fr = lane & 15, fq = lane >> 4;
    const int K = g.K, nt = K / BK;
    unsigned voffA[2], voffB[2];
#pragma unroll
    for (int i = 0; i < 2; ++i) { int R, C; stage_rc(tid * 16 + i * 8192, R, C); const int Rb = Epi::PERM ? ((R & ~31) + perm32(R & 31)) : R;
        voffA[i] = (unsigned)(R * K + C) * 2u; voffB[i] = (unsigned)(Rb * K + C) * 2u; }
    unsigned vgc[2][2], vgn[2][2];
#define PG8_GLOAD(u, v) do { _Pragma("unroll") for (int h_ = 0; h_ < 2; ++h_) _Pragma("unroll") for (int i_ = 0; i_ < 2; ++i_) { int R_, C_; stage_rc(tid * 16 + i_ * 8192, R_, C_); \
        v[h_][i_] = ((unsigned)g.gidx[(u).pm * BM + h_ * HALF + R_] * (unsigned)K + (unsigned)C_) * 2u; } } while (0)
#define PG8_STA(b, h, base, NX) do { if constexpr (GATHER) { const unsigned vv_[2] = {(NX) ? vgn[h][0] : vgc[h][0], (NX) ? vgn[h][1] : vgc[h][1]}; PG8_STAGE(PG8_SA(b, h), base, vv_); } \
        else { PG8_STAGE(PG8_SA(b, h), (base) + (h) * hstep, voffA); } } while (0)
    const size_t kstep = (size_t)(BK * 2);
    const size_t hstep = (size_t)HALF * K * 2;
    const size_t tstep = 2 * hstep;
    const unsigned ldsw = (unsigned)wid * 1024u;
    const int aoff = lds_byte(wr * 64 + fr, fq * 8), boff = lds_byte(wc * 32 + fr, fq * 8);
#define PG8_SA(b, h) (((b) * 2 + (h)) * HTB)
#define PG8_SB(b, h) ((4 + (b) * 2 + (h)) * HTB)
#define PG8_STAGE(bufoff, gbase, voff) do { _Pragma("unroll") for (int _i = 0; _i < 2; ++_i) \
        __builtin_amdgcn_global_load_lds((const unsigned*)((const char*)(gbase) + (voff)[_i]), (PG8_LAS unsigned*)(lds + (bufoff) + ldsw + _i * 8192), 16, 0, 0); } while (0)
#define PG8_LDA(dst, b, h) do { _Pragma("unroll") for (int m = 0; m < 4; ++m) _Pragma("unroll") for (int k = 0; k < 2; ++k) dst[m][k] = *(const PG8_LAS bf16x8*)(lds + PG8_SA(b, h) + aoff + m * 2048 + k * 1024); } while (0)
#define PG8_LDB(dst, b, h) do { _Pragma("unroll") for (int n = 0; n < 2; ++n) _Pragma("unroll") for (int k = 0; k < 2; ++k) dst[n][k] = *(const PG8_LAS bf16x8*)(lds + PG8_SB(b, h) + boff + n * 2048 + k * 1024); } while (0)
#define PG8_MMA(ai, bj, At, Bt) do { __builtin_amdgcn_s_setprio(1); _Pragma("unroll") for (int m = 0; m < 4; ++m) _Pragma("unroll") for (int n = 0; n < 2; ++n) _Pragma("unroll") for (int k = 0; k < 2; ++k) \
        acc[ai][bj][m][n] = __builtin_amdgcn_mfma_f32_16x16x32_bf16(Bt[n][k], At[m][k], acc[ai][bj][m][n], 0, 0, 0); __builtin_amdgcn_s_setprio(0); } while (0)
#define PG8_WAIT_V(n) asm volatile("s_waitcnt vmcnt(" #n ")" ::: "memory")
#define PG8_WAIT_L(n) asm volatile("s_waitcnt lgkmcnt(" #n ")" ::: "memory")
#define PG8_BAR __builtin_amdgcn_s_barrier()
#define PG8_SCHED __builtin_amdgcn_sched_barrier(0)
    Unit cur, nxt; int ui = 0;
    if (!S.next(0, cur)) return;
    f32x4 acc[2][2][4][2];
#pragma unroll
    for (int a = 0; a < 2; ++a)
#pragma unroll
        for (int b = 0; b < 2; ++b)
#pragma unroll
            for (int m = 0; m < 4; ++m)
#pragma unroll
                for (int n = 0; n < 2; ++n) acc[a][b][m][n] = (f32x4){0.f, 0.f, 0.f, 0.f};
    bf16x8 At[4][2], B0[2][2], B1[2][2];
    if constexpr (GATHER) PG8_GLOAD(cur, vgc);
    const char* cA = (const char*)g.A + (GATHER ? (size_t)0 : (size_t)cur.pm * tstep); const char* cB = (const char*)g.Bt + (size_t)(cur.pm >> g.gshift) * g.gstride + (size_t)cur.pn * tstep;
    S.a_ready(cur);
    if constexpr (SP2) {
        PG8_STAGE(PG8_SB(0, 0), cB, voffB); PG8_STAGE(PG8_SB(0, 1), cB + hstep, voffB); PG8_STA(0, 0, cA, false); PG8_STA(0, 1, cA, false);
        if (wr == 1) PG8_BAR;
        PG8_WAIT_V(2); PG8_BAR;
        PG8_STAGE(PG8_SB(1, 0), cB + kstep, voffB); PG8_STA(1, 0, cA + kstep, false); PG8_STAGE(PG8_SB(1, 1), cB + hstep + kstep, voffB);
        PG8_WAIT_V(6); PG8_BAR;
    } else {
        PG8_STAGE(PG8_SB(0, 0), cB, voffB); PG8_STA(0, 0, cA, false); PG8_STAGE(PG8_SB(0, 1), cB + hstep, voffB); PG8_STA(0, 1, cA, false);
        if (wr == 1) PG8_BAR;
        PG8_WAIT_V(4); PG8_BAR;
        PG8_STAGE(PG8_SB(1, 0), cB + kstep, voffB); PG8_STA(1, 0, cA + kstep, false); PG8_STAGE(PG8_SB(1, 1), cB + hstep + kstep, voffB);
        PG8_WAIT_V(6); PG8_BAR;
    }
    for (;;) {
        const bool has_next = S.next(ui + 1, nxt);
        if constexpr (GATHER) { if (has_next) PG8_GLOAD(nxt, vgn); else { vgn[0][0] = vgc[0][0]; vgn[0][1] = vgc[0][1]; vgn[1][0] = vgc[1][0]; vgn[1][1] = vgc[1][1]; } }
        const char* nA = (has_next && !GATHER) ? (const char*)g.A + (size_t)nxt.pm * tstep : cA; const char* nB = has_next ? (const char*)g.Bt + (size_t)(nxt.pm >> g.gshift) * g.gstride + (size_t)nxt.pn * tstep : cB;
        for (int t = 0; t < nt; t += 2) {
            const bool last = (t == nt - 2);
            const char* a1 = cA + (size_t)(t + 1) * kstep;
            const char* a2 = last ? nA : cA + (size_t)(t + 2) * kstep; const char* b2 = last ? nB : cB + (size_t)(t + 2) * kstep;
            const char* a3 = a2 + kstep; const char* b3 = b2 + kstep;
            if (last && has_next) S.a_ready(nxt);
            if constexpr (SP2) {
            PG8_LDB(B0, 0, 0); PG8_LDB(B1, 0, 1); PG8_SCHED; PG8_LDA(At, 0, 0); PG8_STA(1, 1, a1, false);
            PG8_WAIT_V(8); PG8_WAIT_L(0); PG8_BAR; PG8_MMA(0, 0, At, B0); PG8_MMA(0, 1, At, B1); PG8_BAR; PG8_SCHED;
            PG8_LDA(At, 0, 1); PG8_STAGE(PG8_SB(0, 0), b2, voffB); PG8_STAGE(PG8_SB(0, 1), b2 + hstep, voffB); PG8_STA(0, 0, a2, last);
            PG8_WAIT_V(8); PG8_WAIT_L(0); PG8_BAR; PG8_MMA(1, 0, At, B0); PG8_MMA(1, 1, At, B1); PG8_BAR; PG8_SCHED;
            PG8_LDB(B0, 1, 0); PG8_LDB(B1, 1, 1); PG8_SCHED; PG8_LDA(At, 1, 0); PG8_STA(0, 1, a2, last);
            PG8_WAIT_V(8); PG8_WAIT_L(0); PG8_BAR; PG8_MMA(0, 0, At, B0); PG8_MMA(0, 1, At, B1); PG8_BAR; PG8_SCHED;
            PG8_LDA(At, 1, 1); PG8_STAGE(PG8_SB(1, 0), b3, voffB); PG8_STAGE(PG8_SB(1, 1), b3 + hstep, voffB); PG8_STA(1, 0, a3, last);
            PG8_WAIT_V(8); PG8_WAIT_L(0); PG8_BAR; PG8_MMA(1, 0, At, B0); PG8_MMA(1, 1, At, B1); PG8_BAR; PG8_SCHED;
            } else {
            PG8_LDB(B0, 0, 0); PG8_SCHED; PG8_LDA(At, 0, 0); PG8_STA(1, 1, a1, false);
            PG8_WAIT_L(8); PG8_BAR; PG8_WAIT_L(0); PG8_MMA(0, 0, At, B0); PG8_BAR; PG8_SCHED;
            PG8_LDB(B1, 0, 1); PG8_STAGE(PG8_SB(0, 0), b2, voffB);
            PG8_BAR; PG8_WAIT_L(0); PG8_MMA(0, 1, At, B1); PG8_BAR;
            PG8_LDA(At, 0, 1); PG8_STA(0, 0, a2, last);
            PG8_BAR; PG8_WAIT_L(0); PG8_MMA(1, 0, At, B0); PG8_BAR; PG8_SCHED;
            PG8_STAGE(PG8_SB(0, 1), b2 + hstep, voffB);
            PG8_WAIT_V(6); PG8_BAR; PG8_MMA(1, 1, At, B1); PG8_BAR;
            PG8_LDB(B0, 1, 0); PG8_SCHED; PG8_LDA(At, 1, 0); PG8_STA(0, 1, a2, last);
            PG8_WAIT_L(8); PG8_BAR; PG8_WAIT_L(0); PG8_MMA(0, 0, At, B0); PG8_BAR; PG8_SCHED;
            PG8_LDB(B1, 1, 1); PG8_STAGE(PG8_SB(1, 0), b3, voffB);
            PG8_BAR; PG8_WAIT_L(0); PG8_MMA(0, 1, At, B1); PG8_BAR;
            PG8_LDA(At, 1, 1); PG8_STA(1, 0, a3, last);
            PG8_BAR; PG8_WAIT_L(0); PG8_MMA(1, 0, At, B0); PG8_BAR; PG8_SCHED;
            PG8_STAGE(PG8_SB(1, 1), b3 + hstep, voffB);
            PG8_WAIT_V(6); PG8_BAR; PG8_MMA(1, 1, At, B1); PG8_BAR;
            }
        }
        if constexpr (ALIGN_EPI) { if (wr == 0) PG8_BAR; }
        if constexpr (!Epi::AFTER_DRAIN) { E(acc, cur, wr, wc, fr, fq); S.done(cur); }
        if (!has_next) break;
#pragma unroll
        for (int a = 0; a < 2; ++a)
#pragma unroll
            for (int b = 0; b < 2; ++b)
#pragma unroll
                for (int m = 0; m < 4; ++m)
#pragma unroll
                    for (int n = 0; n < 2; ++n) acc[a][b][m][n] = (f32x4){0.f, 0.f, 0.f, 0.f};
        cur = nxt; cA = nA; cB = nB; ++ui;
        if constexpr (GATHER) { vgc[0][0] = vgn[0][0]; vgc[0][1] = vgn[0][1]; vgc[1][0] = vgn[1][0]; vgc[1][1] = vgn[1][1]; }
        if constexpr (ALIGN_EPI) { if (wr == 1) PG8_BAR; }
    }
    PG8_WAIT_V(0);
    if constexpr (!ALIGN_EPI) { if (wr == 0) PG8_BAR; }
    PG8_BAR;
    if constexpr (Epi::AFTER_DRAIN) { E.fused(acc, cur, wr, wc, fr, fq, lds, wid, lane); S.done(cur); }
#undef PG8_SA
#undef PG8_SB
#undef PG8_STAGE
#undef PG8_LDA
#undef PG8_LDB
#undef PG8_MMA
#undef PG8_WAIT_V
#undef PG8_WAIT_L
#undef PG8_BAR
#undef PG8_SCHED
#undef PG8_STA
#undef PG8_GLOAD
}
}

namespace att {
using bf16 = unsigned short;
using bf16x8 = __attribute__((ext_vector_type(8))) short;
using s16x4  = __attribute__((ext_vector_type(4))) short;
using f32x16 = __attribute__((ext_vector_type(16))) float;
using u32x4  = __attribute__((ext_vector_type(4))) unsigned;
constexpr int NW = 8, QBLK = 32, KVBLK = 64, SEQ = 16384, LDQ = 1024, LDMIX = 2048;
constexpr int SHM_V = KVBLK * 128 * 2, SHM_K = KVBLK * 64 * 2;
constexpr int OFF_V = 0, OFF_K = 2 * SHM_V, OFF_WS = OFF_K + 2 * SHM_K, LDS_BYTES = OFF_WS + NW * 64 * 4;
constexpr float THR2 = 11.0f;
#define AT_LAS __attribute__((address_space(3)))
#define AT_KSWZ(row, colB) ((row) * 128 + ((colB) ^ ((((row) >> 1) & 7) << 4)))
#define AT_SBAR() __builtin_amdgcn_sched_barrier(0)
__device__ __forceinline__ int crow(int r, int hi) { return (r & 3) + 8 * (r >> 2) + 4 * hi; }
__device__ __forceinline__ unsigned cvtpk(float lo, float hi) { unsigned r; asm volatile("v_cvt_pk_bf16_f32 %0, %1, %2" : "=v"(r) : "v"(lo), "v"(hi)); return r; }

__device__ __forceinline__ void partialSM(f32x16& p0, f32x16& p1, float& m_reg, float& alpha) {
  float pmax = p0[0];
#pragma unroll
  for (int r = 1; r < 16; ++r) pmax = fmaxf(pmax, p0[r]);
#pragma unroll
  for (int r = 0; r < 16; ++r) pmax = fmaxf(pmax, p1[r]);
  { auto rr = __builtin_amdgcn_permlane32_swap(__float_as_uint(pmax), __float_as_uint(pmax), false, false);
    pmax = fmaxf(__uint_as_float(rr[0]), __uint_as_float(rr[1])); }
  float mn;
  if (__builtin_expect(__all(pmax - m_reg <= THR2), 1)) { mn = m_reg; alpha = 1.f; }
  else { mn = fmaxf(m_reg, pmax); alpha = __builtin_amdgcn_exp2f(m_reg - mn); m_reg = mn; }
#pragma unroll
  for (int r = 0; r < 16; ++r) { p0[r] -= mn; p1[r] -= mn; }
#pragma unroll
  for (int r = 0; r < 16; ++r) p0[r] = __builtin_amdgcn_exp2f(p0[r]);
}
__device__ __forceinline__ void finishSM(f32x16& p0, f32x16& p1, float alpha, float& l_reg, bf16x8& pa0, bf16x8& pa1, bf16x8& pa2, bf16x8& pa3) {
#pragma unroll
  for (int r = 0; r < 16; ++r) p1[r] = __builtin_amdgcn_exp2f(p1[r]);
  float ps = 0;
#pragma unroll
  for (int r = 0; r < 16; ++r) ps += p0[r];
#pragma unroll
  for (int r = 0; r < 16; ++r) ps += p1[r];
  { auto rr = __builtin_amdgcn_permlane32_swap(__float_as_uint(ps), __float_as_uint(ps), false, false);
    ps = __uint_as_float(rr[0]) + __uint_as_float(rr[1]); }
  l_reg = l_reg * alpha + ps;
#define AT_PK4(P, BASE, OUT) do { unsigned a0 = cvtpk(P[BASE + 0], P[BASE + 1]), a1 = cvtpk(P[BASE + 2], P[BASE + 3]);   \
    unsigned b0 = cvtpk(P[BASE + 4], P[BASE + 5]), b1 = cvtpk(P[BASE + 6], P[BASE + 7]);                              \
    auto r0 = __builtin_amdgcn_permlane32_swap(a0, b0, false, false); auto r1 = __builtin_amdgcn_permlane32_swap(a1, b1, false, false); \
    u32x4 w = {r0[0], r1[0], r0[1], r1[1]}; OUT = __builtin_bit_cast(bf16x8, w); } while (0)
  AT_PK4(p0, 0, pa0); AT_PK4(p0, 8, pa1); AT_PK4(p1, 0, pa2); AT_PK4(p1, 8, pa3);
#undef AT_PK4
}
__device__ __forceinline__ void qkt(f32x16& p0, f32x16& p1, const AT_LAS char* Ks, const bf16x8 (&qr)[4], int r32, int hi) {
  p0 = f32x16{}; p1 = f32x16{};
#pragma unroll
  for (int d0 = 0; d0 < 4; ++d0) { const int cb = (d0 * 16 + hi * 8) * 2;
    const bf16x8 b0 = *(const AT_LAS bf16x8*)(Ks + AT_KSWZ(r32, cb));
    const bf16x8 b1 = *(const AT_LAS bf16x8*)(Ks + AT_KSWZ(32 + r32, cb));
    p0 = __builtin_amdgcn_mfma_f32_32x32x16_bf16(b0, qr[d0], p0, 0, 0, 0);
    p1 = __builtin_amdgcn_mfma_f32_32x32x16_bf16(b1, qr[d0], p1, 0, 0, 0); }
}
__device__ __forceinline__ int v_st(int k, int c) { const int kk = (k & ~0xC) | ((k & 4) << 1) | ((k & 8) >> 1); return ((kk >> 3) * 4 + (c >> 5)) * 512 + ((kk & 7) * 32 + (c & 31)) * 2; }
__device__ __forceinline__ int v_rd_base(int lane) { return ((lane & 3) << 3) | (((lane >> 2) & 3) << 6) | (((lane >> 4) & 1) << 5) | (((lane >> 5) & 1) << 8); }
constexpr int v_rd_off(int d0, int ks, int half) { return d0 * 512 + ks * 4096 + half * 2048; }
template <int OFF> __device__ __forceinline__ s16x4 tr_read(int vb) {
  s16x4 r; asm volatile("ds_read_b64_tr_b16 %0, %1 offset:%2" : "=&v"(r) : "v"(vb), "i"(OFF) : "memory"); return r;
}
template <int D0> __device__ __forceinline__ void pv_one(f32x16& od, int vb, bf16x8 pa0, bf16x8 pa1, bf16x8 pa2, bf16x8 pa3) {
  const s16x4 l0 = tr_read<v_rd_off(D0, 0, 0)>(vb), h0 = tr_read<v_rd_off(D0, 0, 1)>(vb), l1 = tr_read<v_rd_off(D0, 1, 0)>(vb), h1 = tr_read<v_rd_off(D0, 1, 1)>(vb);
  const s16x4 l2 = tr_read<v_rd_off(D0, 2, 0)>(vb), h2 = tr_read<v_rd_off(D0, 2, 1)>(vb), l3 = tr_read<v_rd_off(D0, 3, 0)>(vb), h3 = tr_read<v_rd_off(D0, 3, 1)>(vb);
  asm volatile("s_waitcnt lgkmcnt(0)" ::: "memory"); AT_SBAR();
#define AT_PK(L, H) (bf16x8){L[0], L[1], L[2], L[3], H[0], H[1], H[2], H[3]}
  od = __builtin_amdgcn_mfma_f32_32x32x16_bf16(pa0, AT_PK(l0, h0), od, 0, 0, 0);
  od = __builtin_amdgcn_mfma_f32_32x32x16_bf16(pa1, AT_PK(l1, h1), od, 0, 0, 0);
  od = __builtin_amdgcn_mfma_f32_32x32x16_bf16(pa2, AT_PK(l2, h2), od, 0, 0, 0);
  od = __builtin_amdgcn_mfma_f32_32x32x16_bf16(pa3, AT_PK(l3, h3), od, 0, 0, 0);
#undef AT_PK
}
__device__ __forceinline__ void pv_d0(f32x16 (&o)[4], int vb, bf16x8 pa0, bf16x8 pa1, bf16x8 pa2, bf16x8 pa3) {
  pv_one<0>(o[0], vb, pa0, pa1, pa2, pa3); pv_one<1>(o[1], vb, pa0, pa1, pa2, pa3); pv_one<2>(o[2], vb, pa0, pa1, pa2, pa3); pv_one<3>(o[3], vb, pa0, pa1, pa2, pa3);
}

struct AttnArgs { const bf16* Q; const bf16* K; const bf16* V; const bf16* VT; float* AO1; bf16* MIX; const float* subg; const float* kmax; float lam; float outscale; };

#ifndef AT_STAGGER
#define AT_STAGGER 0
#endif
#ifndef AT_PF
#define AT_PF 2
#endif
constexpr int NBUF = 5, BUF_BYTES = SHM_K + SHM_V;
constexpr int OFF_WS2 = NBUF * BUF_BYTES, LDS_BYTES2 = OFF_WS2 + NW * 64 * 4;
__device__ __forceinline__ void glds16(const void* gsrc, unsigned lds_dst) { unsigned keep;
  asm volatile("s_mov_b32 %0, m0\n\ts_mov_b32 m0, %2\n\ts_nop 0\n\tglobal_load_lds_dwordx4 %1, off\n\ts_mov_b32 m0, %0" : "=&s"(keep) : "v"(gsrc), "s"(lds_dst) : "memory"); }
__device__ __forceinline__ void glds16s(const void* sbase, unsigned voff, unsigned lds_dst) { unsigned keep;
  asm volatile("s_mov_b32 %0, m0\n\ts_mov_b32 m0, %3\n\ts_nop 4\n\tglobal_load_lds_dwordx4 %1, %2\n\ts_mov_b32 m0, %0" : "=&s"(keep) : "v"(voff), "s"(sbase), "s"(lds_dst) : "memory"); }
#define AT_WAIT_BAR(N) asm volatile("s_waitcnt vmcnt(" #N ") lgkmcnt(0)\n\ts_barrier" ::: "memory")

template <int VAR>
__device__ __forceinline__ void attn_unit(const AttnArgs& A, int h, int qt, AT_LAS char* lds, const int tid) {
  const int q0 = qt * 256;
  const unsigned lds0 = (unsigned)(uintptr_t)lds;
  constexpr int NT = SEQ / KVBLK;
#pragma unroll 1
  for (int mp = 0; mp < 2; ++mp) {
    int tl = tid; asm volatile("" : "+v"(tl));
    const int lane = tl & 63, r32 = lane & 31, hi = lane >> 5; const int wid = __builtin_amdgcn_readfirstlane(tl >> 6);
    AT_LAS float* li_l = (AT_LAS float*)(lds + OFF_WS2) + wid * 64;
    int koff, voff0, voff1;
    { const int row = 8 * wid + (lane >> 3), cpos = lane & 7; koff = row * LDQ + 8 * (cpos ^ ((row >> 1) & 7)); }
    { const int B = (2 * wid) * 1024 + lane * 16, sub = B >> 9, wel = (B & 511) >> 1, kk = (sub >> 2) * 8 + (wel >> 5), k = (kk & ~0xC) | ((kk & 4) << 1) | ((kk & 8) >> 1); voff0 = k * LDQ + (sub & 3) * 32 + (wel & 31); }
    { const int B = (2 * wid + 1) * 1024 + lane * 16, sub = B >> 9, wel = (B & 511) >> 1, kk = (sub >> 2) * 8 + (wel >> 5), k = (kk & ~0xC) | ((kk & 4) << 1) | ((kk & 8) >> 1); voff1 = k * LDQ + (sub & 3) * 32 + (wel & 31); }
    const unsigned kdst = lds0 + wid * 1024, vdst = lds0 + SHM_K + wid * 2048;
    const int vrd = (int)lds0 + SHM_K + v_rd_base(lane);
    const bf16* Vh = A.V + h * 128;
    const bf16* Kh = A.K + (h * 2 + mp) * 64;
    const bf16* Qw = A.Q + (size_t)(q0 + wid * QBLK + r32) * LDQ + (h * 2 + mp) * 64 + hi * 8;
    const unsigned kob = (unsigned)koff * 2u, vob0 = (unsigned)voff0 * 2u, vob1 = (unsigned)voff1 * 2u;
#define AT_DMA(t, boff) do { const size_t to_ = (size_t)(t) * (KVBLK * LDQ); const unsigned bo_ = (unsigned)__builtin_amdgcn_readfirstlane(boff); \
    glds16s(Kh + to_, kob, (unsigned)__builtin_amdgcn_readfirstlane(kdst + bo_)); glds16s(Vh + to_, vob0, (unsigned)__builtin_amdgcn_readfirstlane(vdst + bo_)); glds16s(Vh + to_, vob1, (unsigned)__builtin_amdgcn_readfirstlane(vdst + bo_ + 1024u)); } while (0)
    __syncthreads();
    AT_DMA(0, 0); AT_DMA(1, BUF_BYTES); if (AT_PF == 3) AT_DMA(2, 2 * BUF_BYTES);
    bf16x8 qr[4];
#pragma unroll
    for (int d0 = 0; d0 < 4; ++d0) qr[d0] = *(const bf16x8*)(Qw + d0 * 16);
    float qss = 0.f;
#pragma unroll
    for (int d0 = 0; d0 < 4; ++d0)
#pragma unroll
      for (int e = 0; e < 8; ++e) { const float v = __uint_as_float(((unsigned)(unsigned short)qr[d0][e]) << 16); qss += v * v; }
    { auto rr = __builtin_amdgcn_permlane32_swap(__float_as_uint(qss), __float_as_uint(qss), false, false); qss = __uint_as_float(rr[0]) + __uint_as_float(rr[1]); }
    const float mref = sqrtf(qss) * A.kmax[h * 2 + mp] * 1.01f + 0.25f;
    f32x16 negm;
#pragma unroll
    for (int r = 0; r < 16; ++r) negm[r] = -mref;
    float l_reg = 0.f; f32x16 o[4]; o[0] = f32x16{}; o[1] = f32x16{}; o[2] = f32x16{}; o[3] = f32x16{};
    f32x16 sA0, sA1, sB0, sB1; bf16x8 pa0, pa1, pa2, pa3;
    if (VAR & 4) { sB0 = negm; sB1 = negm; }
    if (AT_PF == 3) AT_WAIT_BAR(3); else AT_WAIT_BAR(0);
#define AT_QKT_D(P0, P1, kb_, d0) do { const int cb = ((d0) * 16 + hi * 8) * 2; \
      const bf16x8 b0 = *(const AT_LAS bf16x8*)(kb_ + AT_KSWZ(r32, cb)); const bf16x8 b1 = *(const AT_LAS bf16x8*)(kb_ + AT_KSWZ(32 + r32, cb)); \
      if ((d0) == 0) { P0 = __builtin_amdgcn_mfma_f32_32x32x16_bf16(b0, qr[d0], negm, 0, 0, 0); P1 = __builtin_amdgcn_mfma_f32_32x32x16_bf16(b1, qr[d0], negm, 0, 0, 0); } \
      else { P0 = __builtin_amdgcn_mfma_f32_32x32x16_bf16(b0, qr[d0], P0, 0, 0, 0); P1 = __builtin_amdgcn_mfma_f32_32x32x16_bf16(b1, qr[d0], P1, 0, 0, 0); } } while (0)
#define AT_QKT(P0, P1, boff) do { const AT_LAS char* kb_ = lds + (boff); \
    AT_QKT_D(P0, P1, kb_, 0); AT_QKT_D(P0, P1, kb_, 1); AT_SBAR(); AT_QKT_D(P0, P1, kb_, 2); AT_QKT_D(P0, P1, kb_, 3); } while (0)
#define AT_SOFT(P0, P1) do { float ps = 0.f; \
    if (!(VAR & 1)) { _Pragma("unroll") for (int r = 0; r < 16; ++r) { P0[r] = __builtin_amdgcn_exp2f(P0[r]); P1[r] = __builtin_amdgcn_exp2f(P1[r]); } } \
    _Pragma("unroll") for (int r = 0; r < 16; ++r) ps += P0[r]; \
    _Pragma("unroll") for (int r = 0; r < 16; ++r) ps += P1[r]; \
    l_reg += ps; \
    AT_PK4(P0, 0, pa0); AT_PK4(P0, 8, pa1); AT_PK4(P1, 0, pa2); AT_PK4(P1, 8, pa3); } while (0)
#define AT_PK4(P, BASE, OUT) do { unsigned a0 = cvtpk(P[BASE + 0], P[BASE + 1]), a1 = cvtpk(P[BASE + 2], P[BASE + 3]);   \
    unsigned b0 = cvtpk(P[BASE + 4], P[BASE + 5]), b1 = cvtpk(P[BASE + 6], P[BASE + 7]);                              \
    auto r0 = __builtin_amdgcn_permlane32_swap(a0, b0, false, false); auto r1 = __builtin_amdgcn_permlane32_swap(a1, b1, false, false); \
    u32x4 w = {r0[0], r1[0], r0[1], r1[1]}; OUT = __builtin_bit_cast(bf16x8, w); } while (0)
#define AT_STEP(C0, C1, N0, N1, j) do { \
    if (!(VAR & 16) && (j) + AT_PF < NT) AT_DMA((j) + AT_PF, (AT_PF == 3 ? b4 : b3)); \
    AT_SBAR(); if (!(VAR & 2) && late && (j) > 0) pv_d0(o, vrd + b0, pa0, pa1, pa2, pa3); AT_SBAR(); \
    if (!(VAR & 4) && (j) + 1 < NT) AT_QKT(N0, N1, b2); AT_SBAR(); \
    AT_SOFT(C0, C1); AT_SBAR(); \
    if (!(VAR & 2) && !late) pv_d0(o, vrd + b1, pa0, pa1, pa2, pa3); \
    if (VAR & 32) asm volatile("s_waitcnt lgkmcnt(0)\n\ts_barrier" ::: "memory"); else if (AT_PF == 3 && (j) + 3 < NT) AT_WAIT_BAR(3); else AT_WAIT_BAR(0); \
    { const int t_ = b0; b0 = b1; b1 = b2; b2 = b3; b3 = b4; b4 = t_; } } while (0)

    const bool late = AT_STAGGER && wid >= 4;
    int b0 = 4 * BUF_BYTES, b1 = 0, b2 = BUF_BYTES, b3 = 2 * BUF_BYTES, b4 = 3 * BUF_BYTES;
    AT_QKT(sA0, sA1, b1);
    for (int j = 0; j < NT; j += 2) {
      AT_STEP(sA0, sA1, sB0, sB1, j);
      AT_STEP(sB0, sB1, sA0, sA1, j + 1);
    }
    if (late) pv_d0(o, vrd + b0, pa0, pa1, pa2, pa3);
#undef AT_STEP
#undef AT_PK4
#undef AT_SOFT
#undef AT_QKT
#undef AT_QKT_D
#undef AT_DMA
    { auto rr = __builtin_amdgcn_permlane32_swap(__float_as_uint(l_reg), __float_as_uint(l_reg), false, false); l_reg = __uint_as_float(rr[0]) + __uint_as_float(rr[1]); }
    if (hi == 0) li_l[r32] = l_reg; asm volatile("s_waitcnt lgkmcnt(0)" ::: "memory");
    int r32e = r32, hie = hi; asm volatile("" : "+v"(r32e), "+v"(hie));
    const unsigned ebase = (unsigned)((q0 + wid * QBLK + 4 * hie) * 1024 + h * 128 + r32e);
    if (mp == 0) {
#pragma unroll
      for (int r = 0; r < 16; ++r) { float* op = A.AO1 + (ebase + (unsigned)(((r & 3) + 8 * (r >> 2)) * 1024)); const float rl = __builtin_amdgcn_rcpf(li_l[crow(r, hi)]);
#pragma unroll
        for (int d0 = 0; d0 < 4; ++d0) op[d0 * 32] = o[d0][r] * rl;
        if ((r & 3) == 3) asm volatile("" ::: "memory"); }
    } else {
      float sg[4];
#pragma unroll
      for (int d0 = 0; d0 < 4; ++d0) sg[d0] = A.subg[d0 * 32 + r32e] * A.outscale;
#pragma unroll
      for (int r = 0; r < 16; ++r) { const unsigned eo = ebase + (unsigned)(((r & 3) + 8 * (r >> 2)) * 1024); const float* ip = A.AO1 + eo; const float rl = __builtin_amdgcn_rcpf(li_l[crow(r, hi)]) * A.lam;
        float v[4]; float ss = 0.f;
#pragma unroll
        for (int d0 = 0; d0 < 4; ++d0) { v[d0] = ip[d0 * 32] - o[d0][r] * rl; ss += v[d0] * v[d0]; }
#pragma unroll
        for (int off = 1; off < 32; off <<= 1) ss += shx(ss, off, lane);
        const float rs = rsqrtf(ss * (1.0f / 128.0f) + 1e-6f);
        bf16* mp_ = A.MIX + (eo + (eo & ~1023u));
#pragma unroll
        for (int d0 = 0; d0 < 4; ++d0) mp_[d0 * 32] = (bf16)(pg8::cvt_pk_bf16(v[d0] * rs * sg[d0], 0.f) & 0xffffu);
        if ((r & 3) == 3) asm volatile("" ::: "memory"); }
    }
  }
}
#undef AT_SBAR
}

namespace att {
#define A2_SBAR() __builtin_amdgcn_sched_barrier(0)
#ifndef A2_NVF
#define A2_NVF 6
#endif
#ifndef A2_PRIO
#define A2_PRIO 1
#endif
__device__ __forceinline__ void glds3(const void* kbase, unsigned kvo, unsigned kdst, const void* vbase, unsigned vo0, unsigned vo1, unsigned vdst) { unsigned keep;
  asm volatile("s_mov_b32 %0, m0\n\ts_mov_b32 m0, %3\n\ts_nop 4\n\tglobal_load_lds_dwordx4 %1, %2\n\t"
               "s_mov_b32 m0, %7\n\ts_nop 0\n\tglobal_load_lds_dwordx4 %4, %6\n\t"
               "s_add_u32 m0, %7, 0x400\n\ts_nop 0\n\tglobal_load_lds_dwordx4 %5, %6\n\ts_mov_b32 m0, %0"
               : "=&s"(keep) : "v"(kvo), "s"(kbase), "s"(kdst), "v"(vo0), "v"(vo1), "s"(vbase), "s"(vdst) : "memory", "scc"); }
typedef short v4i16_t __attribute__((ext_vector_type(4)));
__device__ __forceinline__ s16x4 vtr(const AT_LAS char* p) { return __builtin_bit_cast(s16x4, __builtin_amdgcn_ds_read_tr16_b64_v4i16((AT_LAS v4i16_t*)p)); }
constexpr int A2_KB = SHM_K, A2_VB = SHM_V, A2_OFF_V = 2 * A2_KB, A2_OFF_WS = A2_OFF_V + 2 * A2_VB, A2_LDS_BYTES = A2_OFF_WS + NW * 64 * 4;
struct NoMid { __device__ __forceinline__ void operator()() const {} };
template <int VAR = 0, class Mid = NoMid>
__device__ __forceinline__ void attn_unit2(const AttnArgs& A, int h, int qt, AT_LAS char* lds, const int tid, const Mid& mid = Mid()) {
  const int q0 = qt * 256;
  const unsigned lds0 = (unsigned)(uintptr_t)lds;
  constexpr int NT = SEQ / KVBLK;
  constexpr size_t TS = (size_t)KVBLK * LDQ;
#pragma unroll 1
  for (int mp = 0; mp < 2; ++mp) {
    if (mp == 1) mid();
    int tl = tid; asm volatile("" : "+v"(tl));
    const int lane = tl & 63, r32 = lane & 31, hi = lane >> 5; const int wid = __builtin_amdgcn_readfirstlane(tl >> 6);
    AT_LAS float* li_l = (AT_LAS float*)(lds + A2_OFF_WS) + wid * 64;
    int koff, voff0, voff1;
    { const int row = 8 * wid + (lane >> 3), cpos = lane & 7; koff = row * LDQ + 8 * (cpos ^ ((row >> 1) & 7)); }
    { const int row = 8 * (2 * wid) + (lane >> 3), cpos = lane & 7; voff0 = row * SEQ + 8 * (cpos ^ ((row >> 1) & 7)); }
    { const int row = 8 * (2 * wid + 1) + (lane >> 3), cpos = lane & 7; voff1 = row * SEQ + 8 * (cpos ^ ((row >> 1) & 7)); }
    const unsigned kob = (unsigned)koff * 2u, vob0 = (unsigned)voff0 * 2u, vob1 = (unsigned)voff1 * 2u;
    const unsigned kdst = lds0 + wid * 1024, vdst = lds0 + A2_OFF_V + wid * 2048;
    const bf16* Vh = A.VT + (size_t)h * 128 * SEQ;
    const bf16* Kh = A.K + (h * 2 + mp) * 64;
    const bf16* Qw = A.Q + (size_t)(q0 + wid * QBLK + r32) * LDQ + (h * 2 + mp) * 64 + hi * 8;
    const AT_LAS char* ksl = lds + r32 * 128;
    const int kswz = ((r32 >> 1) & 7) << 4;
    const AT_LAS char* vsl = lds + A2_OFF_V + r32 * 128;
#define A2_DMAK(t, s) glds16s(Kh + (size_t)(t) * TS, kob, (unsigned)__builtin_amdgcn_readfirstlane(kdst + (s) * A2_KB))
#define A2_DMAV(t, s) do { glds16s(Vh + (size_t)(t) * KVBLK, vob0, (unsigned)__builtin_amdgcn_readfirstlane(vdst + (s) * A2_VB)); glds16s(Vh + (size_t)(t) * KVBLK, vob1, (unsigned)__builtin_amdgcn_readfirstlane(vdst + (s) * A2_VB + 1024u)); } while (0)
#define A2_KRD(g, s) (*(const AT_LAS bf16x8*)(ksl + (s) * A2_KB + ((g) & 1) * 4096 + ((((g) >> 1) * 32 + hi * 16) ^ kswz)))
#define A2_VRD(m, s) do { vf[(m) % A2_NVF] = *(const AT_LAS bf16x8*)(vsl + (s) * A2_VB + ((m) & 3) * 4096 + ((((m) >> 2) * 32 + hi * 16) ^ kswz)); } while (0)
#define A2_VFR(m) vf[(m) % A2_NVF]
    __syncthreads();
    A2_DMAK(0, 0); A2_DMAK(1, 1);
    bf16x8 qr[4];
#pragma unroll
    for (int d0 = 0; d0 < 4; ++d0) qr[d0] = *(const __attribute__((address_space(1))) bf16x8*)(Qw + d0 * 16);
    float qss = 0.f;
#pragma unroll
    for (int d0 = 0; d0 < 4; ++d0)
#pragma unroll
      for (int e = 0; e < 8; ++e) { const float v = __uint_as_float(((unsigned)(unsigned short)qr[d0][e]) << 16); qss += v * v; }
    { auto rr = __builtin_amdgcn_permlane32_swap(__float_as_uint(qss), __float_as_uint(qss), false, false); qss = __uint_as_float(rr[0]) + __uint_as_float(rr[1]); }
    const float mref = sqrtf(qss) * A.kmax[h * 2 + mp] * 1.01f + 0.25f;
    f32x16 negm;
#pragma unroll
    for (int r = 0; r < 16; ++r) negm[r] = -mref;
    float l_reg = 0.f; f32x16 o[4]; o[0] = f32x16{}; o[1] = f32x16{}; o[2] = f32x16{}; o[3] = f32x16{};
    f32x16 cA0, cA1, cB0, cB1; bf16x8 pa[4]; bf16x8 kf[8]; bf16x8 vf[A2_NVF];
    if (VAR) { cA0 = negm; cA1 = negm; cB0 = negm; cB1 = negm; _Pragma("unroll") for (int i_ = 0; i_ < 4; ++i_) { pa[i_] = qr[i_]; vf[i_] = qr[i_]; } }
    AT_WAIT_BAR(0);
#pragma unroll
    for (int g = 0; g < 8; ++g) kf[g] = A2_KRD(g, 0);
    asm volatile("s_waitcnt lgkmcnt(0)\n\ts_barrier" ::: "memory");
#define A2_GA(g, N0, N1, P0, P1, DOQK, DOPREV, VS) do { \
    if ((DOQK) && !(VAR & 8)) { if ((g) & 1) N1 = __builtin_amdgcn_mfma_f32_32x32x16_bf16(kf[g], qr[(g) >> 1], (g) < 2 ? negm : N1, 0, 0, 0); \
                else         N0 = __builtin_amdgcn_mfma_f32_32x32x16_bf16(kf[g], qr[(g) >> 1], (g) < 2 ? negm : N0, 0, 0, 0); } \
    if ((DOPREV) && !(VAR & 128)) { \
        \
      if (((g) & 1) == 0) { pk0 = (g) < 4 ? cvtpk(P0[((g) & 2) * 4 + 0], P0[((g) & 2) * 4 + 1]) : cvtpk(P1[((g) & 2) * 4 + 0], P1[((g) & 2) * 4 + 1]); \
                            pk1 = (g) < 4 ? cvtpk(P0[((g) & 2) * 4 + 2], P0[((g) & 2) * 4 + 3]) : cvtpk(P1[((g) & 2) * 4 + 2], P1[((g) & 2) * 4 + 3]); } \
      else { const unsigned a1_ = (g) < 4 ? cvtpk(P0[((g) & 2) * 4 + 4], P0[((g) & 2) * 4 + 5]) : cvtpk(P1[((g) & 2) * 4 + 4], P1[((g) & 2) * 4 + 5]); \
             const unsigned b1_ = (g) < 4 ? cvtpk(P0[((g) & 2) * 4 + 6], P0[((g) & 2) * 4 + 7]) : cvtpk(P1[((g) & 2) * 4 + 6], P1[((g) & 2) * 4 + 7]); \
             const u32x4 w_ = {pk0, pk1, a1_, b1_}; pa[(g) >> 1] = __builtin_bit_cast(bf16x8, w_); } \
      } if ((DOPREV) && !(VAR & 4) && (g) >= 8 - A2_NVF) { A2_VRD((g) - (8 - A2_NVF), VS); } \
    A2_SBAR(); } while (0)
#define A2_GB(m, N0, N1, DOPREV, DOEXP, DOK, VS, KS) do { \
    if (DOPREV) { if (!(VAR & 2)) o[(m) & 3] = __builtin_amdgcn_mfma_f32_32x32x16_bf16(pa[(m) >> 2], A2_VFR(m), o[(m) & 3], 0, 0, 0); if (!(VAR & 4) && (m) + A2_NVF < 16) A2_VRD((m) + A2_NVF, VS); } \
    if ((DOEXP) && !(VAR & 1)) { if ((m) < 8) { N0[2 * (m)] = __builtin_amdgcn_exp2f(N0[2 * (m)]); N0[2 * (m) + 1] = __builtin_amdgcn_exp2f(N0[2 * (m) + 1]); l_reg += N0[2 * (m)]; l_reg += N0[2 * (m) + 1]; } \
                 else { N1[2 * (m) - 16] = __builtin_amdgcn_exp2f(N1[2 * (m) - 16]); N1[2 * (m) - 15] = __builtin_amdgcn_exp2f(N1[2 * (m) - 15]); l_reg += N1[2 * (m) - 16]; l_reg += N1[2 * (m) - 15]; } } \
    if ((DOK) && !(VAR & 64) && (m) >= 4 && (m) < 12) kf[(m) - 4] = A2_KRD((m) - 4, KS); \
    A2_SBAR(); } while (0)
#define A2_STEP(t, PAR, N0, N1, P0, P1, DOQK, DOPREV, DOEXP) do { unsigned pk0 = 0u, pk1 = 0u; \
    A2_GA(0, N0, N1, P0, P1, DOQK, DOPREV, (PAR) ^ 1); A2_GA(1, N0, N1, P0, P1, DOQK, DOPREV, (PAR) ^ 1); A2_GA(2, N0, N1, P0, P1, DOQK, DOPREV, (PAR) ^ 1); A2_GA(3, N0, N1, P0, P1, DOQK, DOPREV, (PAR) ^ 1); \
    A2_GA(4, N0, N1, P0, P1, DOQK, DOPREV, (PAR) ^ 1); A2_GA(5, N0, N1, P0, P1, DOQK, DOPREV, (PAR) ^ 1); A2_GA(6, N0, N1, P0, P1, DOQK, DOPREV, (PAR) ^ 1); A2_GA(7, N0, N1, P0, P1, DOQK, DOPREV, (PAR) ^ 1); \
    if (!(VAR & 16)) { if ((t) + 2 < NT) glds3(Kh + (size_t)((t) + 2) * TS, kob, (unsigned)__builtin_amdgcn_readfirstlane(kdst + (PAR) * A2_KB), Vh + (size_t)(t) * KVBLK, vob0, vob1, (unsigned)__builtin_amdgcn_readfirstlane(vdst + (PAR) * A2_VB)); \
                       else if ((t) < NT) A2_DMAV((t), PAR); } A2_SBAR(); \
    const bool dok_ = (t) + 1 < NT; \
    A2_GB(0, N0, N1, DOPREV, DOEXP, dok_, (PAR) ^ 1, (PAR) ^ 1); A2_GB(1, N0, N1, DOPREV, DOEXP, dok_, (PAR) ^ 1, (PAR) ^ 1); A2_GB(2, N0, N1, DOPREV, DOEXP, dok_, (PAR) ^ 1, (PAR) ^ 1); A2_GB(3, N0, N1, DOPREV, DOEXP, dok_, (PAR) ^ 1, (PAR) ^ 1); \
    A2_GB(4, N0, N1, DOPREV, DOEXP, dok_, (PAR) ^ 1, (PAR) ^ 1); A2_GB(5, N0, N1, DOPREV, DOEXP, dok_, (PAR) ^ 1, (PAR) ^ 1); A2_GB(6, N0, N1, DOPREV, DOEXP, dok_, (PAR) ^ 1, (PAR) ^ 1); A2_GB(7, N0, N1, DOPREV, DOEXP, dok_, (PAR) ^ 1, (PAR) ^ 1); \
    A2_GB(8, N0, N1, DOPREV, DOEXP, dok_, (PAR) ^ 1, (PAR) ^ 1); A2_GB(9, N0, N1, DOPREV, DOEXP, dok_, (PAR) ^ 1, (PAR) ^ 1); A2_GB(10, N0, N1, DOPREV, DOEXP, dok_, (PAR) ^ 1, (PAR) ^ 1); A2_GB(11, N0, N1, DOPREV, DOEXP, dok_, (PAR) ^ 1, (PAR) ^ 1); \
    A2_GB(12, N0, N1, DOPREV, DOEXP, dok_, (PAR) ^ 1, (PAR) ^ 1); A2_GB(13, N0, N1, DOPREV, DOEXP, dok_, (PAR) ^ 1, (PAR) ^ 1); A2_GB(14, N0, N1, DOPREV, DOEXP, dok_, (PAR) ^ 1, (PAR) ^ 1); A2_GB(15, N0, N1, DOPREV, DOEXP, dok_, (PAR) ^ 1, (PAR) ^ 1); \
    if (VAR & 32) asm volatile("s_waitcnt lgkmcnt(0)" ::: "memory"); else AT_WAIT_BAR(0); } while (0)
    if (A2_PRIO && wid >= 4) __builtin_amdgcn_s_setprio(1);
    A2_STEP(0, 0, cA0, cA1, cB0, cB1, true, false, true);
    for (int t = 1; t + 1 < NT; t += 2) {
      A2_STEP(t, 1, cB0, cB1, cA0, cA1, true, true, true);
      A2_STEP(t + 1, 0, cA0, cA1, cB0, cB1, true, true, true);
    }
    A2_STEP(NT - 1, 1, cB0, cB1, cA0, cA1, true, true, true);
    A2_STEP(NT, 0, cA0, cA1, cB0, cB1, false, true, false);
    if (A2_PRIO) __builtin_amdgcn_s_setprio(0);
#undef A2_STEP
#undef A2_GB
#undef A2_GA
#undef A2_VFR
#undef A2_VRD
#undef A2_KRD
#undef A2_DMAV
#undef A2_DMAK
    { auto rr = __builtin_amdgcn_permlane32_swap(__float_as_uint(l_reg), __float_as_uint(l_reg), false, false); l_reg = __uint_as_float(rr[0]) + __uint_as_float(rr[1]); }
    if (hi == 0) li_l[r32] = l_reg; asm volatile("s_waitcnt lgkmcnt(0)" ::: "memory");
    int r32e = r32, hie = hi; asm volatile("" : "+v"(r32e), "+v"(hie));
    const unsigned ebase = (unsigned)((q0 + wid * QBLK + 4 * hie) * 1024 + h * 128 + r32e);
    if (mp == 0) {
#pragma unroll
      for (int r = 0; r < 16; ++r) { __attribute__((address_space(1))) float* op = (__attribute__((address_space(1))) float*)A.AO1 + (ebase + (unsigned)(((r & 3) + 8 * (r >> 2)) * 1024)); const float rl = __builtin_amdgcn_rcpf(li_l[crow(r, hi)]);
#pragma unroll
        for (int d0 = 0; d0 < 4; ++d0) op[d0 * 32] = o[d0][r] * rl;
        if ((r & 3) == 3) asm volatile("" ::: "memory"); }
    } else {
      float sg[4];
#pragma unroll
      for (int d0 = 0; d0 < 4; ++d0) sg[d0] = A.subg[d0 * 32 + r32e] * A.outscale;
#pragma unroll
      for (int r = 0; r < 16; ++r) { const unsigned eo = ebase + (unsigned)(((r & 3) + 8 * (r >> 2)) * 1024); const __attribute__((address_space(1))) float* ip = (const __attribute__((address_space(1))) float*)A.AO1 + eo; const float rl = __builtin_amdgcn_rcpf(li_l[crow(r, hi)]) * A.lam;
        float v[4]; float ss = 0.f;
#pragma unroll
        for (int d0 = 0; d0 < 4; ++d0) { v[d0] = ip[d0 * 32] - o[d0][r] * rl; ss += v[d0] * v[d0]; }
#pragma unroll
        for (int off = 1; off < 32; off <<= 1) ss += shx(ss, off, lane);
        const float rs = rsqrtf(ss * (1.0f / 128.0f) + 1e-6f);
        __attribute__((address_space(1))) bf16* mp_ = (__attribute__((address_space(1))) bf16*)A.MIX + (eo + (eo & ~1023u));
#pragma unroll
        for (int d0 = 0; d0 < 4; ++d0) mp_[d0 * 32] = (bf16)(pg8::cvt_pk_bf16(v[d0] * rs * sg[d0], 0.f) & 0xffffu);
        if ((r & 3) == 3) asm volatile("" ::: "memory"); }
    }
  }
}
#undef A2_SBAR
}

namespace hg {
using bf16 = unsigned short;
using bf16x8 = __attribute__((ext_vector_type(8))) short;
using f32x16 = __attribute__((ext_vector_type(16))) float;
using u32x4  = __attribute__((ext_vector_type(4))) unsigned;
using u32x2  = __attribute__((ext_vector_type(2))) unsigned;
#define HG_LAS __attribute__((address_space(3)))
constexpr int P128 = 136, P64 = 72;
constexpr int L_QT = 0, L_KT = L_QT + 64 * P128 * 2, L_QB = L_KT + 64 * P128 * 2, L_KH = L_QB + 64 * P128 * 2, L_VT = L_KH + 128 * P64 * 2,
              L_ST = L_VT + 128 * P64 * 2, L_AM = L_ST + 128 * P128 * 2, L_EB = L_AM + 64 * P64 * 2, L_PS = L_EB + 512, L_SSQ = L_PS + 2048, LDS_BYTES = L_SSQ + 1024;
constexpr int SCT = 512, NSC = 32;
__device__ __forceinline__ int crow(int r, int hi) { return (r & 3) + 8 * (r >> 2) + 4 * hi; }
typedef float f32x2_t __attribute__((ext_vector_type(2))); typedef __bf16 bf16x2_t __attribute__((ext_vector_type(2)));
__device__ __forceinline__ unsigned cvtpk(float lo, float hi) { f32x2_t v = {lo, hi}; bf16x2_t b = __builtin_convertvector(v, bf16x2_t); return __builtin_bit_cast(unsigned, b); }
__device__ __forceinline__ float bf2f(unsigned short b) { return __uint_as_float((unsigned)b << 16); }
template <int CTRL> __device__ __forceinline__ float dppf(float v) { return __int_as_float(__builtin_amdgcn_update_dpp(0, __float_as_int(v), CTRL, 0xf, 0xf, true)); }
#define HG_EXP(x) ((VAR & 2) ? (x) : __expf(x))
#define HG_BAR() do { asm volatile("s_waitcnt lgkmcnt(0)" ::: "memory"); __builtin_amdgcn_s_barrier(); asm volatile("" ::: "memory"); } while (0)

struct HgArgs { const bf16* HQ; const bf16* KK; const unsigned short* LF; const bf16* HV; const bf16* HGt; float* HS; float* GS; float* HOF; bf16* MIX; const float* gn; };

template <bool OUT, int VAR = 0>
__device__ __forceinline__ void hgrn_unit(const HgArgs& A, int dir, int h, int sc, HG_LAS unsigned char* lds, const int tid) {
  const int lane = tid & 63, r32 = lane & 31, hi = lane >> 5; const int wid = __builtin_amdgcn_readfirstlane(tid >> 6);
  const int d = tid & 127, qt = tid >> 7;
  typedef __attribute__((address_space(1))) const unsigned short gcus; typedef __attribute__((address_space(1))) float gfl; typedef __attribute__((address_space(1))) unsigned short gus;
  gcus* gLF = (gcus*)A.LF; gcus* gKK = (gcus*)A.KK; gcus* gHV = (gcus*)A.HV; gcus* gHQ = (gcus*)A.HQ; gcus* gHG = (gcus*)A.HGt; gus* gHOF = (gus*)A.HOF;     gus* gMIX = (gus*)A.MIX; gfl* gHS = (gfl*)A.HS; gfl* gGS = (gfl*)A.GS;
  HG_LAS bf16* QT = (HG_LAS bf16*)(lds + L_QT); HG_LAS bf16* KT = (HG_LAS bf16*)(lds + L_KT); HG_LAS bf16* QB = (HG_LAS bf16*)(lds + L_QB);
  HG_LAS bf16* KH = (HG_LAS bf16*)(lds + L_KH); HG_LAS bf16* VT = (HG_LAS bf16*)(lds + L_VT); HG_LAS bf16* ST = (HG_LAS bf16*)(lds + L_ST);
  HG_LAS bf16* AM = (HG_LAS bf16*)(lds + L_AM); HG_LAS float* EB = (HG_LAS float*)(lds + L_EB); HG_LAS float* PS = (HG_LAS float*)(lds + L_PS);
  HG_LAS float* SSQ = (HG_LAS float*)(lds + L_SSQ);
  const int db = wid >> 1, eb0 = (wid & 1) * 2;
  const int jb = wid & 1, eb = wid >> 1;
  const size_t unit = (size_t)(dir * 8 + h) * NSC + sc;
  gfl* HSu = gHS + unit * 16384;
  f32x16 S0, S1;
  if (OUT) {
#pragma unroll
    for (int r = 0; r < 16; ++r) { const gfl* p = HSu + (32 * db + crow(r, hi)) * 128 + 32 * eb0 + r32; S0[r] = p[0]; S1[r] = p[32]; }
#pragma unroll
    for (int rg = 0; rg < 4; ++rg) { u32x2 w0, w1; w0.x = cvtpk(S0[4 * rg], S0[4 * rg + 1]); w0.y = cvtpk(S0[4 * rg + 2], S0[4 * rg + 3]); w1.x = cvtpk(S1[4 * rg], S1[4 * rg + 1]); w1.y = cvtpk(S1[4 * rg + 2], S1[4 * rg + 3]);
      *(HG_LAS u32x2*)(ST + (32 * eb0 + r32) * P128 + 32 * db + 8 * rg + 4 * hi) = w0; *(HG_LAS u32x2*)(ST + (32 * (eb0 + 1) + r32) * P128 + 32 * db + 8 * rg + 4 * hi) = w1; }
  } else { S0 = f32x16{}; S1 = f32x16{}; }
  float gtot = 0.f;
  const float gnv = (OUT && dir != 0) ? ((__attribute__((address_space(1))) const float*)A.gn)[32 * eb + r32] : 0.f;
  const int cofs = h * 128 + d;
  unsigned short rl[16]; unsigned short kkv[16], qv[16], vv[16];
#define HG_LOAD(cc) do { _Pragma("unroll") for (int jj = 0; jj < 16; ++jj) { const int p = (cc) * 64 + qt * 16 + jj; const size_t tok = (size_t)(dir ? sc * SCT + (SCT - 1) - p : sc * SCT + p); \
      rl[jj] = gLF[tok * 2048 + dir * 1024 + cofs]; kkv[jj] = gKK[tok * 2048 + dir * 1024 + cofs]; vv[jj] = gHV[tok * 1024 + cofs]; \
      if (OUT) qv[jj] = gHQ[tok * 1024 + cofs]; } } while (0)
  HG_LOAD(0);
#pragma unroll 1
  for (int c = 0; c < 8; ++c) {
    float lf[16]; unsigned short hofv[16]; unsigned short hgv[16];
    float run = 0.f;
#pragma unroll
    for (int jj = 0; jj < 16; ++jj) { run += (float)__builtin_bit_cast(_Float16, rl[jj]); lf[jj] = run; }
    PS[qt * 128 + d] = run;
    HG_BAR();
    const float p0 = PS[d], p1 = PS[128 + d], p2 = PS[256 + d], p3 = PS[384 + d];
    const float off = qt == 0 ? 0.f : qt == 1 ? p0 : qt == 2 ? p0 + p1 : p0 + p1 + p2;
    const float b63 = (p0 + p1) + (p2 + p3), rmid = p0 + p1;
    gtot += b63;
    if (qt == 0) EB[d] = HG_EXP(b63);
    unsigned kh[8];
#pragma unroll
    for (int jj = 0; jj < 16; jj += 2) {
      const float b0 = off + lf[jj], b1 = off + lf[jj + 1]; const float k0 = bf2f(kkv[jj]), k1 = bf2f(kkv[jj + 1]);
      kh[jj >> 1] = cvtpk(k0 * HG_EXP(b63 - b0), k1 * HG_EXP(b63 - b1));
      if (OUT) { const float q0 = bf2f(qv[jj]), q1 = bf2f(qv[jj + 1]);
        const unsigned qt_ = cvtpk(q0 * HG_EXP(b0 - rmid), q1 * HG_EXP(b1 - rmid)), kt_ = cvtpk(k0 * HG_EXP(rmid - b0), k1 * HG_EXP(rmid - b1)), qb_ = cvtpk(q0 * HG_EXP(b0), q1 * HG_EXP(b1));
        const int j0 = qt * 16 + jj;
        if (!(VAR & 1)) {
          const unsigned xq = (unsigned)__builtin_amdgcn_update_dpp(0, (int)qt_, 0xB1, 0xf, 0xf, true), xk = (unsigned)__builtin_amdgcn_update_dpp(0, (int)kt_, 0xB1, 0xf, 0xf, true), xb = (unsigned)__builtin_amdgcn_update_dpp(0, (int)qb_, 0xB1, 0xf, 0xf, true);
          const bool odd = d & 1; const int wofs = (odd ? (j0 + 1) * P128 + d - 1 : j0 * P128 + d);
          *(HG_LAS unsigned*)(QT + wofs) = odd ? ((xq >> 16) | (qt_ & 0xffff0000u)) : ((qt_ & 0xffffu) | (xq << 16));
          *(HG_LAS unsigned*)(KT + wofs) = odd ? ((xk >> 16) | (kt_ & 0xffff0000u)) : ((kt_ & 0xffffu) | (xk << 16));
          *(HG_LAS unsigned*)(QB + wofs) = odd ? ((xb >> 16) | (qb_ & 0xffff0000u)) : ((qb_ & 0xffffu) | (xb << 16)); } }
    }
    *(HG_LAS u32x4*)(KH + d * P64 + qt * 16) = (u32x4){kh[0], kh[1], kh[2], kh[3]}; *(HG_LAS u32x4*)(KH + d * P64 + qt * 16 + 8) = (u32x4){kh[4], kh[5], kh[6], kh[7]};
    { u32x4 w0, w1;
      w0.x = (unsigned)vv[0] | ((unsigned)vv[1] << 16); w0.y = (unsigned)vv[2] | ((unsigned)vv[3] << 16); w0.z = (unsigned)vv[4] | ((unsigned)vv[5] << 16); w0.w = (unsigned)vv[6] | ((unsigned)vv[7] << 16);
      w1.x = (unsigned)vv[8] | ((unsigned)vv[9] << 16); w1.y = (unsigned)vv[10] | ((unsigned)vv[11] << 16); w1.z = (unsigned)vv[12] | ((unsigned)vv[13] << 16); w1.w = (unsigned)vv[14] | ((unsigned)vv[15] << 16);
      *(HG_LAS u32x4*)(VT + d * P64 + qt * 16) = w0; *(HG_LAS u32x4*)(VT + d * P64 + qt * 16 + 8) = w1; }
    if (OUT && dir != 0) {
#pragma unroll
      for (int r = 0; r < 16; ++r) { const int p = c * 64 + 32 * jb + crow(r, hi); const size_t tok = (size_t)(sc * SCT + (SCT - 1) - p);
        hofv[r] = gHOF[tok * 1024 + h * 128 + 32 * eb + r32]; hgv[r] = gHG[tok * 1024 + h * 128 + 32 * eb + r32]; } }
    if (!(VAR & 16) && c + 1 < 8) HG_LOAD(c + 1);
    HG_BAR();
    f32x16 oacc = f32x16{};
    if (OUT) {
      if (!(VAR & 4)) {
#pragma unroll
      for (int ks = 0; ks < 8; ++ks) { const bf16x8 a = *(const HG_LAS bf16x8*)(QB + (32 * jb + r32) * P128 + 16 * ks + 8 * hi), b = *(const HG_LAS bf16x8*)(ST + (32 * eb + r32) * P128 + 16 * ks + 8 * hi);
        oacc = __builtin_amdgcn_mfma_f32_32x32x16_bf16(a, b, oacc, 0, 0, 0); }
      if (wid < 4) { const int jb2 = wid & 1, sb = wid >> 1;
        if (sb <= jb2) { f32x16 aacc = f32x16{};
#pragma unroll
          for (int ks = 0; ks < 8; ++ks) { const bf16x8 a = *(const HG_LAS bf16x8*)(QT + (32 * jb2 + r32) * P128 + 16 * ks + 8 * hi), b = *(const HG_LAS bf16x8*)(KT + (32 * sb + r32) * P128 + 16 * ks + 8 * hi);
            aacc = __builtin_amdgcn_mfma_f32_32x32x16_bf16(a, b, aacc, 0, 0, 0); }
#pragma unroll
          for (int r = 0; r < 16; ++r) { const int j = 32 * jb2 + crow(r, hi), s = 32 * sb + r32; AM[j * P64 + s] = (bf16)(cvtpk(s <= j ? aacc[r] : 0.f, 0.f) & 0xffffu); }
        } else {
#pragma unroll
          for (int r = 0; r < 16; ++r) AM[(32 * jb2 + crow(r, hi)) * P64 + 32 * sb + r32] = (bf16)0;
        }
      }
      }
      HG_BAR();
      if (!(VAR & 4))
#pragma unroll
      for (int ks = 0; ks < 4; ++ks) { const bf16x8 a = *(const HG_LAS bf16x8*)(AM + (32 * jb + r32) * P64 + 16 * ks + 8 * hi), b = *(const HG_LAS bf16x8*)(VT + (32 * eb + r32) * P64 + 16 * ks + 8 * hi);
        oacc = __builtin_amdgcn_mfma_f32_32x32x16_bf16(a, b, oacc, 0, 0, 0); }
    }
    if (!(VAR & 8)) {
#pragma unroll
    for (int r = 0; r < 16; ++r) { const float g = EB[32 * db + crow(r, hi)]; S0[r] *= g; S1[r] *= g; }
#pragma unroll
    for (int ks = 0; ks < 4; ++ks) { const bf16x8 a = *(const HG_LAS bf16x8*)(KH + (32 * db + r32) * P64 + 16 * ks + 8 * hi);
      const bf16x8 b0 = *(const HG_LAS bf16x8*)(VT + (32 * eb0 + r32) * P64 + 16 * ks + 8 * hi), b1 = *(const HG_LAS bf16x8*)(VT + (32 * (eb0 + 1) + r32) * P64 + 16 * ks + 8 * hi);
      S0 = __builtin_amdgcn_mfma_f32_32x32x16_bf16(a, b0, S0, 0, 0, 0); S1 = __builtin_amdgcn_mfma_f32_32x32x16_bf16(a, b1, S1, 0, 0, 0); }
    }
    if (OUT) {
      if (!(VAR & 8))
#pragma unroll
      for (int rg = 0; rg < 4; ++rg) { u32x2 w0, w1; w0.x = cvtpk(S0[4 * rg], S0[4 * rg + 1]); w0.y = cvtpk(S0[4 * rg + 2], S0[4 * rg + 3]); w1.x = cvtpk(S1[4 * rg], S1[4 * rg + 1]); w1.y = cvtpk(S1[4 * rg + 2], S1[4 * rg + 3]);
        *(HG_LAS u32x2*)(ST + (32 * eb0 + r32) * P128 + 32 * db + 8 * rg + 4 * hi) = w0; *(HG_LAS u32x2*)(ST + (32 * (eb0 + 1) + r32) * P128 + 32 * db + 8 * rg + 4 * hi) = w1; }
      const int ecol = h * 128 + 32 * eb + r32;
      if (VAR & 32) { if (oacc[0] == 123.456f) gHOF[ecol] = (bf16)1; }
      else if (dir == 0) {
#pragma unroll
        for (int r = 0; r < 16; ++r) { const int p = c * 64 + 32 * jb + crow(r, hi); gHOF[(size_t)(sc * SCT + p) * 1024 + ecol] = (bf16)(cvtpk(oacc[r], 0.f) & 0xffffu); }
      } else {
        float tot[16];
#pragma unroll
        for (int r = 0; r < 16; ++r) { const int p = c * 64 + 32 * jb + crow(r, hi); const size_t tok = (size_t)(sc * SCT + (SCT - 1) - p);
          tot[r] = oacc[r] + bf2f(hofv[r]); float ss = tot[r] * tot[r];
          ss += dppf<0xB1>(ss); ss += dppf<0x4E>(ss); ss += dppf<0x141>(ss); ss += dppf<0x140>(ss);
          ss += shx(ss, 16, lane);
          if (r32 == 0) SSQ[(32 * jb + crow(r, hi)) * 4 + eb] = ss; }
        HG_BAR();
#pragma unroll
        for (int r = 0; r < 16; ++r) { const int j = 32 * jb + crow(r, hi); const int p = c * 64 + j; const size_t tok = (size_t)(sc * SCT + (SCT - 1) - p);
          const float ssum = (SSQ[j * 4] + SSQ[j * 4 + 1]) + (SSQ[j * 4 + 2] + SSQ[j * 4 + 3]);
          const float rs = rsqrtf(ssum * (1.0f / 128.0f) + 1e-6f);
          const float g = bf2f(hgv[r]);
          gMIX[tok * 2048 + 1024 + ecol] = (bf16)(cvtpk(tot[r] * rs * gnv * g, 0.f) & 0xffffu); }
      }
    }
  }
  if (!OUT) {
#pragma unroll
    for (int r = 0; r < 16; ++r) { gfl* p = HSu + (32 * db + crow(r, hi)) * 128 + 32 * eb0 + r32; p[0] = S0[r]; p[32] = S1[r]; }
    if (qt == 0) gGS[unit * 128 + d] = gtot;
  }
  HG_BAR();
}

__device__ __forceinline__ void hgrn_scan(float* HS, const float* GS, int gtid, int nthr) {
  for (int p = gtid; p < 16 * 16384; p += nthr) { const int dh = p >> 14, idx = p & 16383, dd = idx >> 7, dir = dh >> 3;
    float* base = HS + (size_t)dh * NSC * 16384 + idx; const float* g = GS + dh * NSC * 128 + dd;
    float v[NSC], ge[NSC];
#pragma unroll
    for (int k = 0; k < NSC; ++k) { const int s = dir ? NSC - 1 - k : k; v[k] = base[(size_t)s * 16384]; ge[k] = g[s * 128]; }
    float carry = 0.f;
#pragma unroll
    for (int k = 0; k < NSC; ++k) { const int s = dir ? NSC - 1 - k : k; base[(size_t)s * 16384] = carry; carry = __expf(ge[k]) * carry + v[k]; }
  }
}
#undef HG_BAR
#undef HG_LOAD
}

constexpr int NWAVES = 8;
#ifndef MK_PER_PHASE
#define MK_PER_PHASE 0
#endif
#ifndef CVT_HOST
#define CVT_HOST 1
#endif
constexpr int T = 16384, DM = 2048, NL = 4, INC = 8192, NE = 16, CAP = 2048, FF = 1024, XR = NE * CAP;
constexpr float EPS = 1e-6f;
constexpr float QSCALE = 0.125f * 1.4426950408889634f;
constexpr size_t MiB = 1u << 20;
constexpr size_t WS_CTL = 0, CTL_ZERO_BYTES = 32 * 1024;
constexpr size_t WS_ROPE = 1 * MiB, WS_LBS = 5 * MiB, WS_AFF = 6 * MiB, WS_SLOT = 7 * MiB, WS_IDX = 8 * MiB, WS_GATE = 8 * MiB + 512 * 1024, WS_GS = 9 * MiB, WS_PAR = 10 * MiB;
constexpr int PAR_N1 = 0, PAR_N2 = PAR_N1 + NL * DM, PAR_FG = PAR_N2 + NL * DM, PAR_DLAM = PAR_FG + DM, PAR_SUBG = PAR_DLAM + NL * 256, PAR_HGN = PAR_SUBG + NL * 128, PAR_RW = PAR_HGN + NL * 128, PAR_END = PAR_RW + NL * DM * NE;
constexpr size_t WS_WIN = 16 * MiB, WS_WOUT = 144 * MiB, WS_WGU = 176 * MiB, WS_WDN = 688 * MiB;
constexpr size_t WS_X = 944 * MiB, WS_MIX = 1264 * MiB;
constexpr int RW_PITCH = 2056, RW_IMG = 2 * NE * RW_PITCH * 2;
constexpr size_t WS_RWS = 12 * MiB;
constexpr size_t WS_RS1 = 11 * MiB, WS_RS2 = 11 * MiB + 64 * 1024, WS_RSG = 11 * MiB + 128 * 1024;
constexpr size_t WS_Q = 1328 * MiB, WS_K = 1360 * MiB, WS_V = 1392 * MiB, WS_HQ = 1424 * MiB, WS_LF = 1456 * MiB, WS_KK = 1584 * MiB, WS_HV = 1648 * MiB, WS_HG = 1680 * MiB,
                 WS_AO1 = 1712 * MiB, WS_HS = 1776 * MiB, WS_HOF = 1808 * MiB;
constexpr size_t WS_VT = 1072 * MiB;
constexpr size_t WS_XG = 1328 * MiB, WS_HM = 1456 * MiB, WS_Y = 1520 * MiB;
constexpr size_t WS_END = 1872 * MiB;
constexpr int CW_BAR = 4096, CW_KMAX = 2048, CW_SCAN = 3072;
constexpr int RING_BYTES = 131072, LDS_BYTES = 147456, MISC_OFF = LDS_BYTES - 512;
static_assert(hg::LDS_BYTES <= MISC_OFF && att::LDS_BYTES2 <= RING_BYTES, "LDS map");

#define GAS __attribute__((address_space(1)))
#define LAS __attribute__((address_space(3)))
typedef unsigned short bf16;
typedef unsigned v4u __attribute__((ext_vector_type(4)));
typedef unsigned v2u __attribute__((ext_vector_type(2)));
typedef float f32x4 __attribute__((ext_vector_type(4)));
typedef GAS unsigned gu32;
#define RLX_AGENT __ATOMIC_RELAXED, __HIP_MEMORY_SCOPE_AGENT
#define LDS_WAIT() asm volatile("s_waitcnt lgkmcnt(0)" ::: "memory")
#define VM_WAIT() asm volatile("s_waitcnt vmcnt(0)" ::: "memory")
__device__ __forceinline__ unsigned pk2(float lo, float hi) { return pg8::cvt_pk_bf16(lo, hi); }
__device__ __forceinline__ float bf2f(unsigned short b) { return __uint_as_float((unsigned)b << 16); }

#define XB_TMO      128
#define XB_XCNT(j)  (256  + 64 * (j))
#define XB_XSUB(j)  (1280 + 64 * (j))
#define XB_XGEN(j)  (2304 + 64 * (j))
#define XB_TOP      3328
#define XB_TOPGEN   3392
#define XCD_BAR_WORDS 3456
#define XB_SPIN_CAP (1u << 18)

__device__ __forceinline__ unsigned xb_ld(unsigned* p)              { return __hip_atomic_load(p, __ATOMIC_RELAXED, __HIP_MEMORY_SCOPE_AGENT); }
__device__ __forceinline__ unsigned xb_add(unsigned* p, unsigned v) { return __hip_atomic_fetch_add(p, v, __ATOMIC_RELAXED, __HIP_MEMORY_SCOPE_AGENT); }
__device__ __forceinline__ unsigned xb_xcc_id() { return (unsigned)__builtin_amdgcn_s_getreg((3 << 11) | 20) & 0xFu; }
#define XB_SPIN(cond, bar) do { unsigned _sp = 0; while (cond) { __builtin_amdgcn_s_sleep(1); \
    if ((++_sp & 255u) == 0u) { if (xb_ld(&(bar)[XB_TMO])) break; if (_sp > XB_SPIN_CAP) { atomicAdd(&(bar)[XB_TMO], 1u); break; } } } } while (0)

__device__ __forceinline__ unsigned xb_lane() { unsigned z = 0u; asm volatile("" : "+s"(z)); return __builtin_amdgcn_mbcnt_hi(~0u, __builtin_amdgcn_mbcnt_lo(~0u, z)); }
struct XcdBarrier {
    int wv;
    unsigned* bar; unsigned x;
    volatile LAS unsigned* st;
};

__device__ __forceinline__ XcdBarrier xcd_barrier_post(unsigned* bar, volatile LAS unsigned* st, int wv) {
    XcdBarrier b; b.bar = bar; b.x = xb_xcc_id(); b.st = st; b.wv = wv;
    if (wv == 0 && xb_lane() == 0u) (void)xb_add(&bar[XB_XCNT(b.x)], 1u);
    return b;
}
__device__ __forceinline__ void xcd_barrier_complete(unsigned* bar, unsigned x, unsigned& nloc, unsigned& nx) {
    const unsigned G = gridDim.x * gridDim.y * gridDim.z;
    unsigned sum, cnt, mine, sp = 0u;
    for (;;) {
        sum = 0u; cnt = 0u; mine = 0u;
#pragma unroll
        for (unsigned j = 0; j < 16; ++j) { const unsigned c = xb_ld(&bar[XB_XCNT(j)]); sum += c; cnt += (c > 0u) ? 1u : 0u; mine = (j == x) ? c : mine; }
        if (sum == G) break;
        __builtin_amdgcn_s_sleep(1);
        if ((++sp & 255u) == 0u) { if (xb_ld(&bar[XB_TMO])) break; if (sp > XB_SPIN_CAP) { atomicAdd(&bar[XB_TMO], 1u); break; } }
    }
    nloc = mine > 0u ? mine : 1u; nx = cnt > 0u ? cnt : 1u;
}

__device__ __forceinline__ void xcd_barrier(const XcdBarrier& b) {
    asm volatile("s_waitcnt vmcnt(0)" ::: "memory");
    __syncthreads();
    if (b.wv == 0 && xb_lane() == 0u) {
        unsigned* bar = b.bar; unsigned bx = b.x; asm volatile("" : "+s"(bar), "+s"(bx));
        __builtin_amdgcn_s_waitcnt(0);
        unsigned nloc = b.st[0], nx = b.st[1];
        if (nloc == 0u) { xcd_barrier_complete(bar, bx, nloc, nx); b.st[0] = nloc; b.st[1] = nx; }
        const unsigned old = xb_add(&bar[XB_XSUB(bx)], 1u);
        const unsigned gen = old / nloc;
        if (old + 1u == (gen + 1u) * nloc) {
            __builtin_amdgcn_fence(__ATOMIC_RELEASE, "agent");
            asm volatile("s_waitcnt vmcnt(0)" ::: "memory");
            const unsigned og = xb_add(&bar[XB_TOP], 1u);
            const unsigned tg = og / nx;
            if (og + 1u == (tg + 1u) * nx) xb_add(&bar[XB_TOPGEN], 1u);
            else XB_SPIN(xb_ld(&bar[XB_TOPGEN]) == tg, bar);
            __builtin_amdgcn_fence(__ATOMIC_ACQUIRE, "agent");
            xb_add(&bar[XB_XGEN(bx)], 1u);
            asm volatile("s_waitcnt vmcnt(0)" ::: "memory");
        } else {
            XB_SPIN(xb_ld(&bar[XB_XGEN(bx)]) == gen, bar);
            __builtin_amdgcn_fence(__ATOMIC_ACQUIRE, "agent");
            asm volatile("s_waitcnt vmcnt(0)" ::: "memory");
        }
    }
    __syncthreads();
}


struct Args {
    const float* x; const int* pos; const float* norm1_g; const float* w_in; const float* dlam; const float* subg; const float* lblog; const float* hgn;
    const float* w_out; const float* norm2_g; const float* router_w; const float* w_gate; const float* w_up; const float* w_down; const float* final_g;
    float* out; unsigned char* ws; int ph_lo, ph_hi;
};
struct Frame { LAS unsigned char* lds; volatile LAS unsigned* MISC; int tid, lane, wave, vcu, G; };

__device__ __forceinline__ float wave_sum(float v, int lane) {
#pragma unroll
    for (int o = 1; o < 64; o <<= 1) v += shx(v, o, lane);
    return v;
}
__device__ __forceinline__ float wave_max(float v, int lane) {
#pragma unroll
    for (int o = 1; o < 64; o <<= 1) v = fmaxf(v, shx(v, o, lane));
    return v;
}
constexpr int I_IN = 32 * 256, I_OUT = 32 * 64, I_G = 32 * 32, I_D = 16 * 64, PER_LAYER = I_IN + I_OUT + 2 * NE * I_G + NE * I_D;
constexpr int CVT_LDS_OFF = 65536, CVT_SCR = 64 * 33 * 4;
#ifndef CVT_NS
#define CVT_NS 4
#endif
struct CvtItem { const float* src; bf16* dst; const float* gk; int N, K; };
struct CvtSrc { const float* w_in; const float* w_out; const float* w_gate; const float* w_up; const float* w_down; const float* norm1_g; const float* norm2_g; };
constexpr size_t WS_PTAB = 10 * MiB + 768 * 1024;
__device__ __forceinline__ size_t inproj_colmap(int n0);
__device__ __forceinline__ CvtItem cvt_item(const CvtSrc& a, unsigned char* ws, int l, int r) {
    CvtItem c;
    if (r < I_IN) { const int kb = r >> 8, nb = r & 255; c.N = INC; c.K = DM;
        c.src = a.w_in + (size_t)l * DM * INC + (size_t)(kb * 64) * INC + nb * 32; c.dst = (bf16*)(ws + WS_WIN) + (size_t)l * INC * DM + inproj_colmap(nb * 32) * DM + kb * 64; c.gk = a.norm1_g + l * DM + kb * 64; return c; }
    r -= I_IN;
    if (r < I_OUT) { const int kb = r >> 6, nb = r & 63; c.N = DM; c.K = DM;
        c.src = a.w_out + (size_t)l * DM * DM + (size_t)(kb * 64) * DM + nb * 32; c.dst = (bf16*)(ws + WS_WOUT) + (size_t)l * DM * DM + (size_t)(nb * 32) * DM + kb * 64; c.gk = nullptr; return c; }
    r -= I_OUT;
    if (r < 2 * NE * I_G) { const int up = r >= NE * I_G; if (up) r -= NE * I_G; const int le = l * NE + (r >> 10), i = r & 1023, kb = i >> 5, f0 = (i & 31) * 32; c.N = FF; c.K = DM;
        c.src = (up ? a.w_up : a.w_gate) + (size_t)le * DM * FF + (size_t)(kb * 64) * FF + f0; c.dst = (bf16*)(ws + WS_WGU) + (size_t)le * 2048 * DM + (size_t)((f0 >> 7) * 256 + up * 128 + (f0 & 127)) * DM + kb * 64;
        c.gk = a.norm2_g + l * DM + kb * 64; return c; }
    r -= 2 * NE * I_G;
    { const int le = l * NE + (r >> 10), i = r & 1023, kb = i >> 6, nb = i & 63; c.N = DM; c.K = FF;
        c.src = a.w_down + (size_t)le * FF * DM + (size_t)(kb * 64) * DM + nb * 32; c.dst = (bf16*)(ws + WS_WDN) + (size_t)le * DM * FF + (size_t)(nb * 32) * FF + kb * 64; c.gk = nullptr; }
    return c;
}
__device__ __forceinline__ void cvt_load(const CvtItem& c, float (&v)[32], f32x4& g0, f32x4& g1, int lane) {
#pragma unroll
    for (int i = 0; i < 32; ++i) v[i] = __builtin_nontemporal_load((const GAS float*)(c.src + (size_t)(2 * i) * c.N) + ((lane >> 5) * c.N + (lane & 31)));
    g0 = (f32x4){1.f, 1.f, 1.f, 1.f}; g1 = g0;
    if (c.gk) { g0 = *(const GAS f32x4*)(c.gk + 8 * (lane & 7)); g1 = *(const GAS f32x4*)(c.gk + 8 * (lane & 7) + 4); }
}
__device__ __forceinline__ void cvt_process(bf16* dst, int K, float (&v)[32], f32x4& g0, f32x4& g1, const CvtItem& cn, bool hn, LAS float* scr, int lane) {
#pragma unroll
    for (int i = 0; i < 32; ++i) scr[(2 * i + (lane >> 5)) * 33 + (lane & 31)] = v[i];
    const f32x4 h0 = g0, h1 = g1;
    if (hn) cvt_load(cn, v, g0, g1, lane);
    LDS_WAIT(); asm volatile("" ::: "memory");
    const int cc = lane & 7;
#pragma unroll
    for (int j = 0; j < 4; ++j) { const int n = (lane >> 3) + 8 * j; const LAS float* s = scr + (8 * cc) * 33 + n;
        v4u o; o.x = pk2(s[0 * 33] * h0.x, s[1 * 33] * h0.y); o.y = pk2(s[2 * 33] * h0.z, s[3 * 33] * h0.w); o.z = pk2(s[4 * 33] * h1.x, s[5 * 33] * h1.y); o.w = pk2(s[6 * 33] * h1.z, s[7 * 33] * h1.w);
        __builtin_nontemporal_store(o, (GAS v4u*)(dst + (size_t)n * K + 8 * cc)); }
    LDS_WAIT(); asm volatile("" ::: "memory");
}
template <bool FROM_ARGS>
__device__ __forceinline__ void p0_convert(Frame& F, const Args& args, unsigned char* ws_in, int l0, int r0, int count) {
    LAS float* scr = (LAS float*)(F.lds + CVT_LDS_OFF + F.wave * CVT_SCR);
    const int NGW = F.G * NWAVES; int lane = F.lane;
    int v = F.vcu * NWAVES + F.wave; unsigned char* ws = ws_in; asm volatile("" : "+s"(v), "+s"(ws), "+v"(lane));
    if (v >= count) return;
    CvtSrc a;
    if (FROM_ARGS) a = CvtSrc{args.w_in, args.w_out, args.w_gate, args.w_up, args.w_down, args.norm1_g, args.norm2_g};
    else { const int tv = (int)((const GAS unsigned*)(ws + WS_PTAB))[lane & 15];
#define CVT_PTR(i) ((const float*)(((unsigned long long)(unsigned)__builtin_amdgcn_readlane(tv, 2 * (i) + 1) << 32) | (unsigned long long)(unsigned)__builtin_amdgcn_readlane(tv, 2 * (i))))
        a = CvtSrc{CVT_PTR(0), CVT_PTR(1), CVT_PTR(2), CVT_PTR(3), CVT_PTR(4), CVT_PTR(5), CVT_PTR(6)};
#undef CVT_PTR
    }
#define CVT_ITEM(vv) cvt_item(a, ws, (r0 + (vv) >= PER_LAYER) ? l0 + 1 : l0, (r0 + (vv) >= PER_LAYER) ? r0 + (vv) - PER_LAYER : r0 + (vv))
    constexpr int NS = CVT_NS;
    float vv[NS][32]; f32x4 g0[NS], g1[NS]; bf16* dd[NS]; int kk[NS]; bool has[NS];
#pragma unroll
    for (int s_ = 0; s_ < NS; ++s_) { has[s_] = v + s_ * NGW < count; dd[s_] = nullptr; kk[s_] = 0;
        if (has[s_]) { const CvtItem c = CVT_ITEM(v + s_ * NGW); dd[s_] = c.dst; kk[s_] = c.K; cvt_load(c, vv[s_], g0[s_], g1[s_], lane); } }
#pragma unroll 1
    for (bool more = true; more; v += NS * NGW) {
#pragma unroll
        for (int s_ = 0; s_ < NS; ++s_) {
            if (more && has[s_]) {
                const bool hn = v + (s_ + NS) * NGW < count; CvtItem cn{}; if (hn) cn = CVT_ITEM(v + (s_ + NS) * NGW);
                cvt_process(dd[s_], kk[s_], vv[s_], g0[s_], g1[s_], cn, hn, scr, lane); dd[s_] = cn.dst; kk[s_] = cn.K; has[s_] = hn;
            } else more = false;
        }
    }
#undef CVT_ITEM
}
__device__ __forceinline__ void rms_row(const f32x4 (&v)[8], const float* g, bf16* obf, float* of32, int lane) {
    float s = 0.f;
#pragma unroll
    for (int j = 0; j < 8; ++j) s += (v[j].x * v[j].x + v[j].y * v[j].y) + (v[j].z * v[j].z + v[j].w * v[j].w);
    const float rstd = rsqrtf(wave_sum(s, lane) * (1.f / DM) + EPS);
#pragma unroll
    for (int j = 0; j < 8; ++j) { const f32x4 gv = *(const f32x4*)(g + j * 256 + lane * 4); const f32x4 y = v[j] * rstd * gv;
        if (obf) { v2u w; w.x = pk2(y.x, y.y); w.y = pk2(y.z, y.w); *(GAS v2u*)(obf + j * 256 + lane * 4) = w; }
        else *(GAS f32x4*)(of32 + j * 256 + lane * 4) = y; }
}

__device__ __forceinline__ size_t inproj_colmap(int n0) {
    const int seg = n0 >> 10;
    if (seg >= 2) return (size_t)n0;
    const int w = n0 & 1023, hm = w >> 6, half = (w >> 5) & 1;
    return (size_t)(seg * 1024 + (hm >> 2) * 256 + half * 128 + (hm & 3) * 32);
}
__device__ __forceinline__ void p0_prologue(Frame& F, const Args& a, unsigned char* ws) {
    const int gw = F.vcu * NWAVES + F.wave, NGW = F.G * NWAVES;
#if CVT_HOST
    p0_convert<true>(F, a, ws, 0, 0, I_IN);
    if (gw == 0 && F.lane < 7) { const float* pv = F.lane == 0 ? a.w_in : F.lane == 1 ? a.w_out : F.lane == 2 ? a.w_gate : F.lane == 3 ? a.w_up : F.lane == 4 ? a.w_down : F.lane == 5 ? a.norm1_g : a.norm2_g;
        ((GAS unsigned long long*)(ws + WS_PTAB))[F.lane] = (unsigned long long)(uintptr_t)pv; }
#else
    for (int l = 0; l < NL; ++l) p0_convert<true>(F, a, ws, l, 0, PER_LAYER);
#endif
    { float* rope = (float*)(ws + WS_ROPE); const int gt = F.vcu * 512 + F.tid, NGT = F.G * 512;
      for (int e = gt; e < T * 32; e += NGT) { const int t = e >> 5, i = e & 31;
          const double inv = exp2(-(double)i * (13.287712379549449 / 32.0));
          const double ang = (double)((float)a.pos[t] * (float)inv);
          const double n = rint(ang * 0.6366197723675814);
          const double f = (ang - n * 1.5707963267948966) - n * 6.123233995736766e-17;
          const double f2 = f * f;
          const double sn = f * (1.0 + f2 * (-1.0 / 6 + f2 * (1.0 / 120 + f2 * (-1.0 / 5040 + f2 * (1.0 / 362880 + f2 * (-1.0 / 39916800))))));
          const double cs = 1.0 + f2 * (-0.5 + f2 * (1.0 / 24 + f2 * (-1.0 / 720 + f2 * (1.0 / 40320 + f2 * (-1.0 / 3628800 + f2 * (1.0 / 479001600))))));
          const int q = ((int)(long long)n) & 3;
          const double c_ = (q == 0) ? cs : (q == 1) ? -sn : (q == 2) ? -cs : sn;
          const double s_ = (q == 0) ? sn : (q == 1) ? cs : (q == 2) ? -sn : -cs;
          rope[(size_t)t * 64 + i] = (float)c_; rope[(size_t)t * 64 + 32 + i] = (float)s_; }
      float* lbs = (float*)(ws + WS_LBS);
      for (int e = gt; e < 2 * 1024; e += NGT) { const int dir = e >> 10, c = e & 1023; const float* lg = a.lblog + (size_t)dir * NL * 1024 + c;
          const float l0 = lg[0], l1 = lg[1024], l2 = lg[2048], l3 = lg[3072]; const float mx = fmaxf(fmaxf(l0, l1), fmaxf(l2, l3));
          const float e0 = expf(l0 - mx), e1 = expf(l1 - mx), e2 = expf(l2 - mx), e3 = expf(l3 - mx); const float inv = 1.0f / (e0 + e1 + e2 + e3);
          float* o = lbs + (size_t)dir * NL * 1024 + c; o[0] = 0.f; o[1024] = e1 * inv; o[2048] = (e1 + e2) * inv; o[3072] = (e1 + e2 + e3) * inv; }
    }
    { float* par = (float*)(ws + WS_PAR); const int gt = F.vcu * 512 + F.tid, NGT = F.G * 512;
      for (int e = gt; e < PAR_END; e += NGT) { float v;
          if (e < PAR_N2) v = a.norm1_g[e - PAR_N1]; else if (e < PAR_FG) v = a.norm2_g[e - PAR_N2]; else if (e < PAR_DLAM) v = a.final_g[e - PAR_FG]; else if (e < PAR_SUBG) v = a.dlam[e - PAR_DLAM];
          else if (e < PAR_HGN) v = a.subg[e - PAR_SUBG]; else if (e < PAR_RW) v = a.hgn[e - PAR_HGN]; else v = a.router_w[e - PAR_RW];
          par[e] = v; } }
    { bf16* RWS = (bf16*)(ws + WS_RWS); const int gt = F.vcu * 512 + F.tid, NGT = F.G * 512;
      for (int i = gt; i < NL * DM * NE; i += NGT) { const int l = i / (DM * NE), r = i % (DM * NE), dd = r >> 4, e = r & 15;
          const float wv = a.router_w[i] * a.norm2_g[l * DM + dd]; const unsigned hi_ = pk2(wv, 0.f) & 0xffffu; const float lo_f = wv - __uint_as_float(hi_ << 16);
          bf16* img = RWS + (size_t)l * (RW_IMG / 2); img[e * RW_PITCH + dd] = (bf16)hi_; img[NE * RW_PITCH + e * RW_PITCH + dd] = (bf16)(pk2(lo_f, 0.f) & 0xffffu); } }
    { bf16* X = (bf16*)(ws + WS_X); float* RS1 = (float*)(ws + WS_RS1);
      for (int m = gw; m < T; m += NGW) { float ss = 0.f;
#pragma unroll
          for (int j = 0; j < 8; ++j) { const f32x4 v = *(const GAS f32x4*)(a.x + (size_t)m * DM + j * 256 + F.lane * 4); ss += (v.x * v.x + v.y * v.y) + (v.z * v.z + v.w * v.w);
              v2u w; w.x = pk2(v.x, v.y); w.y = pk2(v.z, v.w); *(GAS v2u*)(X + (size_t)m * DM + j * 256 + F.lane * 4) = w; }
          ss = wave_sum(ss, F.lane); if (F.lane == 0) RS1[m] = rsqrtf(ss * (1.f / DM) + EPS); } }
}

__device__ __forceinline__ void router_phase(Frame& F, const bf16* X, const bf16* RWimg, float* RS2, float* AFFT) {
    typedef short bf16x8r __attribute__((ext_vector_type(8)));
    { const GAS v4u* s = (const GAS v4u*)RWimg; LAS v4u* d = (LAS v4u*)F.lds;
      for (int i = F.tid; i < RW_IMG / 16; i += 512) d[i] = s[i]; }
    __syncthreads();
    const int lane = F.lane, r16 = lane & 15, q = lane >> 4;
    const LAS unsigned char* bhi = F.lds + (r16 * RW_PITCH + 512 * q) * 2; const LAS unsigned char* blo = bhi + NE * RW_PITCH * 2;
    if (F.wave < 4) {
        for (int tile = F.vcu * 4 + F.wave; tile < T / 16; tile += F.G * 4) {
            const bf16* xr = X + (size_t)(tile * 16 + r16) * DM + 512 * q;
            f32x4 acc = (f32x4){0.f, 0.f, 0.f, 0.f}; float ss = 0.f;
#pragma unroll 8
            for (int s = 0; s < 64; ++s) { const bf16x8r a = *(const GAS bf16x8r*)(xr + 8 * s);
                const bf16x8r b0 = *(const LAS bf16x8r*)(bhi + 16 * s), b1 = *(const LAS bf16x8r*)(blo + 16 * s);
                acc = __builtin_amdgcn_mfma_f32_16x16x32_bf16(a, b0, acc, 0, 0, 0); acc = __builtin_amdgcn_mfma_f32_16x16x32_bf16(a, b1, acc, 0, 0, 0);
#pragma unroll
                for (int j = 0; j < 8; ++j) { const float v = __uint_as_float(((unsigned)(unsigned short)a[j]) << 16); ss += v * v; } }
            ss += shx(ss, 16, lane); ss += shx(ss, 32, lane);
            const float rstd = rsqrtf(ss * (1.f / DM) + EPS);
            if (q == 0) RS2[tile * 16 + r16] = rstd;
#pragma unroll
            for (int r = 0; r < 4; ++r) { const float rr = __int_as_float(shi(__float_as_int(rstd), 4 * q + r)); float lg = acc[r] * rr; float mx = lg;
#pragma unroll
                for (int o = 1; o < 16; o <<= 1) mx = fmaxf(mx, shx(mx, o, lane));
                const float ex = expf(lg - mx); float sum = ex;
#pragma unroll
                for (int o = 1; o < 16; o <<= 1) sum += shx(sum, o, lane);
                AFFT[(size_t)r16 * T + tile * 16 + 4 * q + r] = ex / sum; }
        }
    }
    __syncthreads();
}

__device__ __forceinline__ unsigned topk_total(Frame& F, LAS unsigned* cnt, int par, unsigned wave_count) {
    if (F.lane == 0) cnt[par * 8 + F.wave] = wave_count;
    __syncthreads();
    unsigned tot = 0;
#pragma unroll
    for (int w_ = 0; w_ < 8; ++w_) tot += cnt[par * 8 + w_];
    return tot;
}
__device__ __forceinline__ void topk_expert(Frame& F, int e, const float* AFFT, const float* RS2, int* IDX, float* GATE, float* RSG, int* SLOTT) {
    LAS unsigned* cnt = (LAS unsigned*)F.lds;
    const int tid = F.tid, lane = F.lane, wid = F.wave;
    unsigned key[32];
#pragma unroll
    for (int i = 0; i < 8; ++i) { const v4u k4 = *(const GAS v4u*)(AFFT + (size_t)e * T + 32 * tid + 4 * i); key[4 * i] = k4.x; key[4 * i + 1] = k4.y; key[4 * i + 2] = k4.z; key[4 * i + 3] = k4.w; }
    unsigned tkey = 0u;
#pragma unroll 1
    for (int b = 30; b >= 0; --b) {
        const unsigned cand = tkey | (1u << b); unsigned c = 0u;
#pragma unroll
        for (int i = 0; i < 32; ++i) c += (unsigned)__popcll(__ballot(key[i] >= cand));
        if (topk_total(F, cnt, b & 1, c) >= (unsigned)CAP) tkey = cand;
    }
    unsigned gmask = 0u, emask = 0u, cgw = 0u;
#pragma unroll
    for (int i = 0; i < 32; ++i) { gmask |= (key[i] > tkey ? 1u : 0u) << i; emask |= (key[i] == tkey ? 1u : 0u) << i; cgw += (unsigned)__popcll(__ballot(key[i] > tkey)); }
    const int cg = __popc(gmask), ce = __popc(emask);
    const unsigned krem = (unsigned)CAP - topk_total(F, cnt, 1, cgw);
    int ig = cg, ie = ce;
#pragma unroll
    for (int off = 1; off < 64; off <<= 1) { const int tg = shi(ig, (lane - off) & 63), te = shi(ie, (lane - off) & 63); if (lane >= off) { ig += tg; ie += te; } }
    if (lane == 63) { cnt[16 + 2 * wid] = (unsigned)ig; cnt[17 + 2 * wid] = (unsigned)ie; }
    __syncthreads();
    int og = 0, oe = 0;
    for (int w_ = 0; w_ < wid; ++w_) { og += (int)cnt[16 + 2 * w_]; oe += (int)cnt[17 + 2 * w_]; }
    const int gbefore = og + ig - cg, ebefore = oe + ie - ce;
    const float* rs2p = RS2 + 32 * tid; int* idxp = IDX + e * CAP; float* gatep = GATE + e * CAP; float* rsgp = RSG + e * CAP;
    int sl[4];
#pragma unroll
    for (int i = 0; i < 32; ++i) { const unsigned low = (1u << i) - 1u;
        const int gb = gbefore + __popc(gmask & low), eb = ebefore + __popc(emask & low);
        const bool isg = (gmask >> i) & 1u, ise = (emask >> i) & 1u;
        const bool sel = isg || (ise && eb < (int)krem);
        const int slot = gb + (eb < (int)krem ? eb : (int)krem);
        sl[i & 3] = sel ? slot : -1;
        if (sel) { idxp[slot] = 32 * tid + i; gatep[slot] = __uint_as_float(key[i]); rsgp[slot] = rs2p[i]; }
        if ((i & 3) == 3) *(GAS v4u*)(SLOTT + (size_t)e * T + 32 * tid + (i - 3)) = (v4u){(unsigned)sl[0], (unsigned)sl[1], (unsigned)sl[2], (unsigned)sl[3]}; }
    __syncthreads();
}

__device__ __forceinline__ void combine_phase(Frame& F, bf16* X, const bf16* Y, const int* SLOT, float* RS1, const float* gfin, float* OUT) {
    const int gw = F.vcu * NWAVES + F.wave, NGW = F.G * NWAVES;
    v4u xn[4]; int slotn = -1;
    if (gw < T) {
#pragma unroll
        for (int j = 0; j < 4; ++j) xn[j] = *(const GAS v4u*)(X + (size_t)gw * DM + j * 512 + F.lane * 8);
        slotn = (F.lane < NE) ? SLOT[(size_t)F.lane * T + gw] : -1; }
    for (int row = gw; row < T; row += NGW) {
        float x[4][8];
#pragma unroll
        for (int j = 0; j < 4; ++j) { x[j][0] = __uint_as_float(xn[j].x << 16); x[j][1] = __uint_as_float(xn[j].x & 0xffff0000u); x[j][2] = __uint_as_float(xn[j].y << 16); x[j][3] = __uint_as_float(xn[j].y & 0xffff0000u);
            x[j][4] = __uint_as_float(xn[j].z << 16); x[j][5] = __uint_as_float(xn[j].z & 0xffff0000u); x[j][6] = __uint_as_float(xn[j].w << 16); x[j][7] = __uint_as_float(xn[j].w & 0xffff0000u); }
        const int myslot = slotn;
        if (row + NGW < T) {
#pragma unroll
            for (int j = 0; j < 4; ++j) xn[j] = *(const GAS v4u*)(X + (size_t)(row + NGW) * DM + j * 512 + F.lane * 8);
            slotn = (F.lane < NE) ? SLOT[(size_t)F.lane * T + row + NGW] : -1; }
#pragma unroll 1
        for (int e = 0; e < NE; ++e) { const int s = shi(myslot, e);
            if (s >= 0) { const bf16* yr = Y + ((size_t)e * CAP + s) * DM;
#pragma unroll
                for (int j = 0; j < 4; ++j) { const v4u w = *(const GAS v4u*)(yr + j * 512 + F.lane * 8);
                    x[j][0] += __uint_as_float(w.x << 16); x[j][1] += __uint_as_float(w.x & 0xffff0000u); x[j][2] += __uint_as_float(w.y << 16); x[j][3] += __uint_as_float(w.y & 0xffff0000u);
                    x[j][4] += __uint_as_float(w.z << 16); x[j][5] += __uint_as_float(w.z & 0xffff0000u); x[j][6] += __uint_as_float(w.w << 16); x[j][7] += __uint_as_float(w.w & 0xffff0000u); } } }
        float ss = 0.f;
#pragma unroll
        for (int j = 0; j < 4; ++j)
#pragma unroll
            for (int k = 0; k < 8; ++k) ss += x[j][k] * x[j][k];
        const float rstd = rsqrtf(wave_sum(ss, F.lane) * (1.f / DM) + EPS);
        if (OUT) {
#pragma unroll
            for (int j = 0; j < 4; ++j) { const f32x4 g0 = *(const f32x4*)(gfin + j * 512 + F.lane * 8), g1 = *(const f32x4*)(gfin + j * 512 + F.lane * 8 + 4);
                *(GAS f32x4*)(OUT + (size_t)row * DM + j * 512 + F.lane * 8) = (f32x4){x[j][0] * rstd * g0.x, x[j][1] * rstd * g0.y, x[j][2] * rstd * g0.z, x[j][3] * rstd * g0.w};
                *(GAS f32x4*)(OUT + (size_t)row * DM + j * 512 + F.lane * 8 + 4) = (f32x4){x[j][4] * rstd * g1.x, x[j][5] * rstd * g1.y, x[j][6] * rstd * g1.z, x[j][7] * rstd * g1.w}; }
        } else {
#pragma unroll
            for (int j = 0; j < 4; ++j) { v4u w; w.x = pk2(x[j][0], x[j][1]); w.y = pk2(x[j][2], x[j][3]); w.z = pk2(x[j][4], x[j][5]); w.w = pk2(x[j][6], x[j][7]); *(GAS v4u*)(X + (size_t)row * DM + j * 512 + F.lane * 8) = w; }
            if (F.lane == 0) RS1[row] = rstd; }
    }
}

__device__ __forceinline__ void vt_transpose(Frame& F, const bf16* V, bf16* VT) {
    LAS bf16* tile = (LAS bf16*)(F.lds + F.wave * 9216);
    const int gw = F.vcu * NWAVES + F.wave, NGW = F.G * NWAVES, lane = F.lane;
    for (int it = gw; it < (T / 64) * 16; it += NGW) { const int t0 = (it >> 4) * 64, c0 = (it & 15) * 64;
#pragma unroll
        for (int i = 0; i < 8; ++i) { const int r = (lane >> 3) + 8 * i; *(LAS v4u*)(tile + r * 72 + (lane & 7) * 8) = *(const GAS v4u*)(V + (size_t)(t0 + r) * 1024 + c0 + (lane & 7) * 8); }
        LDS_WAIT(); asm volatile("" ::: "memory");
        const int g = lane & 7;
#pragma unroll
        for (int i = 0; i < 8; ++i) { const int col = (lane >> 3) + 8 * i; const LAS bf16* s = tile + (8 * g) * 72 + col;
            const LAS bf16* s2 = tile + (16 * (g >> 1) + 4 * (g & 1)) * 72 + col;
            v4u o; o.x = (unsigned)s2[0] | ((unsigned)s2[72] << 16); o.y = (unsigned)s2[144] | ((unsigned)s2[216] << 16); o.z = (unsigned)s2[8 * 72] | ((unsigned)s2[9 * 72] << 16); o.w = (unsigned)s2[10 * 72] | ((unsigned)s2[11 * 72] << 16);
            *(GAS v4u*)(VT + (size_t)(c0 + col) * T + t0 + 8 * g) = o; }
        LDS_WAIT(); asm volatile("" ::: "memory");
    }
}

constexpr int PH_PER_LAYER = 11, N_PHASES = 1 + NL * PH_PER_LAYER;
#ifndef PHMASK
#define PHMASK 0xFFFF
#endif
#define PM(b) ((PHMASK >> (b)) & 1)
#ifndef PROBE_NOSTORE
#define PROBE_NOSTORE 0
#endif
#ifndef REPMASK
#define REPMASK 0
#endif
#define NREP(b) (((REPMASK >> (b)) & 1) ? 2 : 1)
#define PHASE_BEGIN() int wv_ = wave_s; asm volatile("" : "+s"(wv_)); int tid_ = wv_ * 64 + (int)xb_lane(); asm volatile("" : "+v"(tid_)); unsigned char* w = args.ws; asm volatile("" : "+s"(w)); \
    int bx_ = blockIdx.x, gx_ = gridDim.x; asm volatile("" : "+s"(bx_), "+s"(gx_)); \
    Frame F; F.lds = lds0; F.MISC = (volatile LAS unsigned*)(lds0 + MISC_OFF); F.tid = tid_; F.lane = tid_ & 63; F.wave = wv_; F.G = gx_; \
    F.vcu = (gx_ % 8 == 0) ? (bx_ % 8) * (gx_ / 8) + bx_ / 8 : bx_
__global__ void __launch_bounds__(NWAVES * 64, 2) mega_fwd(Args args) {
    extern __shared__ __attribute__((aligned(16))) unsigned char lds_raw[];
    LAS unsigned char* const lds0 = (LAS unsigned char*)lds_raw;
    const int wave_s = __builtin_amdgcn_readfirstlane((int)threadIdx.x >> 6);
    if (wave_s < 2) ((LAS unsigned*)(lds0 + MISC_OFF))[wave_s * 64 + (int)xb_lane()] = 0u;
    __syncthreads();
    XcdBarrier bar; bar.bar = (unsigned*)(args.ws + WS_CTL) + CW_BAR; bar.x = 0; bar.st = nullptr; bar.wv = wave_s;
    if (!MK_PER_PHASE) bar = xcd_barrier_post((unsigned*)(args.ws + WS_CTL) + CW_BAR, (volatile LAS unsigned*)(lds0 + MISC_OFF) + 8, wave_s);
    const int lo = args.ph_lo, hi = args.ph_hi;
#define IN(k) (lo <= (k) && (k) < hi)
#define SEAM(k) do { if (IN(k) && IN((k) + 1)) xcd_barrier(bar); } while (0)

    for (int rep_ = 0; rep_ < NREP(0); ++rep_) if (PM(0) && IN(0)) { if (rep_) xcd_barrier(bar); PHASE_BEGIN(); p0_prologue(F, args, w); }
    SEAM(0);

#pragma unroll 1
    for (int l = 0; l < NL; ++l) {
        const int pb = 1 + l * PH_PER_LAYER;
        for (int rep_ = 0; rep_ < NREP(1); ++rep_) if (PM(1) && IN(pb + 0)) { if (rep_) xcd_barrier(bar); PHASE_BEGIN();
            pg8::Gemm g{(bf16*)(w + WS_X), (bf16*)(w + WS_WIN) + (size_t)l * INC * DM, T, INC, DM, 31, 0, nullptr}; pg8::StaticOrder S; S.init(T, INC, F.G, bx_);
            pg8::EpiInProj E{(bf16*)(w + WS_Q), (bf16*)(w + WS_K), (bf16*)(w + WS_V), (bf16*)(w + WS_HQ), (bf16*)(w + WS_KK), (bf16*)(w + WS_HV), (bf16*)(w + WS_HG), (unsigned short*)(w + WS_LF),
                              (const float*)(w + WS_ROPE), (const float*)(w + WS_LBS) + l * 1024, QSCALE, (unsigned*)(w + WS_CTL) + CW_KMAX + l * 16, (PROBE_NOSTORE && rep_) ? 1 : 0, (const float*)(w + WS_RS1)};
            pg8::gemm_phase<pg8::EpiInProj, pg8::StaticOrder, true, true>(F.lds, g, S, E, F.tid);
        }
        SEAM(pb + 0);
        for (int rep_ = 0; rep_ < NREP(2); ++rep_) if (PM(2) && IN(pb + 1)) { if (rep_) xcd_barrier(bar); PHASE_BEGIN();
            const hg::HgArgs HA{(bf16*)(w + WS_HQ), (bf16*)(w + WS_KK), (unsigned short*)(w + WS_LF), (bf16*)(w + WS_HV), (bf16*)(w + WS_HG), (float*)(w + WS_HS), (float*)(w + WS_GS), (float*)(w + WS_HOF), (bf16*)(w + WS_MIX), (const float*)(w + WS_PAR) + PAR_HGN + l * 128};
            for (int n = F.vcu; n < 512; n += F.G) hg::hgrn_unit<false>(HA, n >> 8, (n >> 5) & 7, n & 31, F.lds, F.tid);
            __syncthreads(); vt_transpose(F, (const bf16*)(w + WS_V), (bf16*)(w + WS_VT));
        }
        SEAM(pb + 1);
        if (PM(4) && IN(pb + 3)) {
            { PHASE_BEGIN(); hg::hgrn_scan((float*)(w + WS_HS), (const float*)(w + WS_GS), F.vcu * 512 + F.tid, F.G * 512);
              asm volatile("s_waitcnt vmcnt(0)" ::: "memory"); __syncthreads();
              if (wv_ == 0 && F.lane == 0) { __builtin_amdgcn_fence(__ATOMIC_RELEASE, "agent"); asm volatile("s_waitcnt vmcnt(0)" ::: "memory");
                  (void)xb_add((unsigned*)(w + WS_CTL) + CW_SCAN + l, 1u); } }
            for (int rep_ = 0; rep_ < NREP(13); ++rep_) if (PM(13)) { if (rep_) xcd_barrier(bar); PHASE_BEGIN();
                const float lam_init = 0.8f - 0.6f * expf(-0.3f * (float)l);
                const float* lv = (const float*)(w + WS_PAR) + PAR_DLAM + l * 256;
                const float s1 = wave_sum(lv[F.lane] * lv[64 + F.lane], F.lane), s2 = wave_sum(lv[128 + F.lane] * lv[192 + F.lane], F.lane);
                const float lam = expf(s1) - expf(s2) + lam_init;
                const att::AttnArgs AA{(bf16*)(w + WS_Q), (bf16*)(w + WS_K), (bf16*)(w + WS_V), (bf16*)(w + WS_VT), (float*)(w + WS_AO1), (bf16*)(w + WS_MIX), (const float*)(w + WS_PAR) + PAR_SUBG + l * 128, (const float*)(w + WS_CTL) + CW_KMAX + l * 16, lam, 1.0f - lam_init};
                #ifdef ATT_OLD_BODY
                for (int n = F.vcu; n < 512; n += F.G) att::attn_unit<0>(AA, (n & 255) >> 5, (n & 31) + 32 * (n >> 8), (AT_LAS char*)F.lds, F.tid);
#else
                { int slot_ = 0; const int cpos = (CVT_HOST && rep_ == 0) ? (int)((unsigned)F.vcu % 6u) : -1; const int ccnt = l < NL - 1 ? PER_LAYER : PER_LAYER - I_IN;
                  for (int n = F.vcu; n < 512; n += F.G, ++slot_) {
                    if (cpos == 2 * slot_) p0_convert<false>(F, args, w, l, I_IN, ccnt);
                    att::attn_unit2<0>(AA, (n & 255) >> 5, (n & 31) + 32 * (n >> 8), (AT_LAS char*)F.lds, F.tid, [&]() { if (cpos == 2 * slot_ + 1) p0_convert<false>(F, args, w, l, I_IN, ccnt); }); } }
#endif
                __syncthreads();
            }
#ifdef HG_PROBE
            { xcd_barrier(bar); PHASE_BEGIN();
                const hg::HgArgs HA{(bf16*)(w + WS_HQ), (bf16*)(w + WS_KK), (unsigned short*)(w + WS_LF), (bf16*)(w + WS_HV), (bf16*)(w + WS_HG), (float*)(w + WS_HS), (float*)(w + WS_GS), (float*)(w + WS_END), (bf16*)(w + WS_END + 64 * MiB), (const float*)(w + WS_PAR) + PAR_HGN + l * 128};
                for (int n = F.vcu; n < 256; n += F.G) { const int h = n >> 5, sc = n & 31;
                    hg::hgrn_unit<true, HG_PROBE>(HA, 0, h, sc, F.lds, F.tid);
                    __threadfence_block(); __syncthreads();
                    hg::hgrn_unit<true, HG_PROBE>(HA, 1, h, sc, F.lds, F.tid); }
            }
#endif
#ifdef ATT_PROBE
            { xcd_barrier(bar); PHASE_BEGIN();
                const att::AttnArgs AA{(bf16*)(w + WS_Q), (bf16*)(w + WS_K), (bf16*)(w + WS_V), (bf16*)(w + WS_VT), (float*)(w + WS_END), (bf16*)(w + WS_END + 64 * MiB), (const float*)(w + WS_PAR) + PAR_SUBG + l * 128, (const float*)(w + WS_CTL) + CW_KMAX + l * 16, 0.5f, 0.5f};
                for (int n = F.vcu; n < 512; n += F.G) att::attn_unit2<ATT_PROBE>(AA, (n & 255) >> 5, (n & 31) + 32 * (n >> 8), (AT_LAS char*)F.lds, F.tid);
                __syncthreads();
            }
#endif
            for (int rep_ = 0; rep_ < NREP(12); ++rep_) if (PM(12)) { if (rep_) xcd_barrier(bar); PHASE_BEGIN();
                if (wv_ == 0 && F.lane == 0) { unsigned* sc_ = (unsigned*)(w + WS_CTL) + CW_SCAN + l; XB_SPIN(xb_ld(sc_) < (unsigned)F.G, (unsigned*)(w + WS_CTL) + CW_BAR);
                    __builtin_amdgcn_fence(__ATOMIC_ACQUIRE, "agent"); asm volatile("s_waitcnt vmcnt(0)" ::: "memory"); }
                __syncthreads();
                const int cpos = (CVT_HOST && rep_ == 0) ? (int)((unsigned)F.vcu % 6u) : -1; const int ccnt = l < NL - 1 ? PER_LAYER : PER_LAYER - I_IN;
                if (cpos == 4) { p0_convert<false>(F, args, w, l, I_IN, ccnt); __syncthreads(); }
                const hg::HgArgs HA{(bf16*)(w + WS_HQ), (bf16*)(w + WS_KK), (unsigned short*)(w + WS_LF), (bf16*)(w + WS_HV), (bf16*)(w + WS_HG), (float*)(w + WS_HS), (float*)(w + WS_GS), (float*)(w + WS_HOF), (bf16*)(w + WS_MIX), (const float*)(w + WS_PAR) + PAR_HGN + l * 128};
                for (int n = F.vcu; n < 256; n += F.G) { const int h = n >> 5, sc = n & 31;
                    hg::hgrn_unit<true>(HA, 0, h, sc, F.lds, F.tid);
                    __threadfence_block(); __syncthreads();
                    hg::hgrn_unit<true>(HA, 1, h, sc, F.lds, F.tid); }
                if (cpos == 5) { __syncthreads(); p0_convert<false>(F, args, w, l, I_IN, ccnt); }
            }
        }
        SEAM(pb + 3);
        for (int rep_ = 0; rep_ < NREP(5); ++rep_) if (PM(5) && IN(pb + 4)) { if (rep_) xcd_barrier(bar); PHASE_BEGIN();
            pg8::Gemm g{(bf16*)(w + WS_MIX), (bf16*)(w + WS_WOUT) + (size_t)l * DM * DM, T, DM, DM, 31, 0, nullptr}; pg8::StaticOrder S; S.init(T, DM, F.G, bx_);
            if (l == 0) { pg8::EpiResidBf<true> E{args.x, (bf16*)(w + WS_X)}; pg8::gemm_phase<pg8::EpiResidBf<true>, pg8::StaticOrder, true, true>(F.lds, g, S, E, F.tid); }
            else { pg8::EpiResidBf<false> E{nullptr, (bf16*)(w + WS_X)}; pg8::gemm_phase<pg8::EpiResidBf<false>, pg8::StaticOrder, true, true>(F.lds, g, S, E, F.tid); }
        }
        SEAM(pb + 4);
        for (int rep_ = 0; rep_ < NREP(6); ++rep_) if (PM(6) && IN(pb + 5)) { if (rep_) xcd_barrier(bar); PHASE_BEGIN(); router_phase(F, (const bf16*)(w + WS_X), (const bf16*)(w + WS_RWS + (size_t)l * RW_IMG), (float*)(w + WS_RS2), (float*)(w + WS_AFF)); }
        SEAM(pb + 5);
        for (int rep_ = 0; rep_ < NREP(7); ++rep_) if (PM(7) && IN(pb + 6)) { if (rep_) xcd_barrier(bar); PHASE_BEGIN(); for (int e = bx_; e < NE; e += F.G) topk_expert(F, e, (const float*)(w + WS_AFF), (const float*)(w + WS_RS2), (int*)(w + WS_IDX), (float*)(w + WS_GATE), (float*)(w + WS_RSG), (int*)(w + WS_SLOT)); }
        SEAM(pb + 6);
        for (int rep_ = 0; rep_ < NREP(9); ++rep_) if (PM(9) && IN(pb + 8)) { if (rep_) xcd_barrier(bar); PHASE_BEGIN();
            pg8::Gemm g{(bf16*)(w + WS_X), (bf16*)(w + WS_WGU) + (size_t)l * NE * 2048 * DM, XR, 2048, DM, 3, (size_t)2048 * DM * 2, (const int*)(w + WS_IDX)}; pg8::StaticOrder S; S.init(XR, 2048, F.G, bx_);
            pg8::EpiSwiGLU E{(bf16*)(w + WS_HM), (const float*)(w + WS_RSG)};
            pg8::gemm_phase<pg8::EpiSwiGLU, pg8::StaticOrder, true, true, true>(F.lds, g, S, E, F.tid);
        }
        SEAM(pb + 8);
        for (int rep_ = 0; rep_ < NREP(10); ++rep_) if (PM(10) && IN(pb + 9)) { if (rep_) xcd_barrier(bar); PHASE_BEGIN();
            pg8::Gemm g{(bf16*)(w + WS_HM), (bf16*)(w + WS_WDN) + (size_t)l * NE * DM * FF, XR, DM, FF, 3, (size_t)DM * FF * 2, nullptr}; pg8::StaticOrder S; S.init(XR, DM, F.G, bx_);
            pg8::EpiDown E{(bf16*)(w + WS_Y), (const float*)(w + WS_GATE)};
            pg8::gemm_phase<pg8::EpiDown, pg8::StaticOrder, true, true>(F.lds, g, S, E, F.tid);
        }
        SEAM(pb + 9);
        for (int rep_ = 0; rep_ < NREP(11); ++rep_) if (PM(11) && IN(pb + 10)) { if (rep_) xcd_barrier(bar); PHASE_BEGIN();
            if (l < NL - 1) combine_phase(F, (bf16*)(w + WS_X), (const bf16*)(w + WS_Y), (const int*)(w + WS_SLOT), (float*)(w + WS_RS1), nullptr, nullptr);
            else combine_phase(F, (bf16*)(w + WS_X), (const bf16*)(w + WS_Y), (const int*)(w + WS_SLOT), nullptr, (const float*)(w + WS_PAR) + PAR_FG, args.out);
        }
        SEAM(pb + 10);
    }
#undef IN
#undef SEAM
}

extern "C" void kernel_launch(void* const* d_in, const int* in_sizes, int n_in, void* d_out, int out_size, void* d_ws, size_t ws_size, hipStream_t stream) {
    static int grid = 0;
    if (grid == 0) {
        if (n_in != 15 || in_sizes[0] != T * DM || out_size != T * DM || ws_size < WS_END) { fprintf(stderr, "kernel_launch: shape/workspace mismatch (n_in %d, ws %zu < %zu)\n", n_in, ws_size, (size_t)WS_END); grid = -1; return; }
        int dev = 0, cus = 0, per_cu = 0;
        if (hipGetDevice(&dev) != hipSuccess || hipDeviceGetAttribute(&cus, hipDeviceAttributeMultiprocessorCount, dev) != hipSuccess) { grid = -1; return; }
        if (hipFuncSetAttribute((const void*)mega_fwd, hipFuncAttributeMaxDynamicSharedMemorySize, LDS_BYTES) != hipSuccess) { fprintf(stderr, "kernel_launch: hipFuncSetAttribute failed\n"); grid = -1; return; }
        if (hipOccupancyMaxActiveBlocksPerMultiprocessor(&per_cu, (const void*)mega_fwd, NWAVES * 64, LDS_BYTES) != hipSuccess || per_cu < 1) fprintf(stderr, "kernel_launch: occupancy query reports %d\n", per_cu);
        (void)hipGetLastError();
        grid = cus;
    }
    if (grid < 0) return;
    if (hipMemsetAsync((char*)d_ws + WS_CTL, 0, CTL_ZERO_BYTES, stream) != hipSuccess) return;
    Args a{};
    a.x = (const float*)d_in[0]; a.pos = (const int*)d_in[1]; a.norm1_g = (const float*)d_in[2]; a.w_in = (const float*)d_in[3]; a.dlam = (const float*)d_in[4]; a.subg = (const float*)d_in[5];
    a.lblog = (const float*)d_in[6]; a.hgn = (const float*)d_in[7]; a.w_out = (const float*)d_in[8]; a.norm2_g = (const float*)d_in[9]; a.router_w = (const float*)d_in[10];
    a.w_gate = (const float*)d_in[11]; a.w_up = (const float*)d_in[12]; a.w_down = (const float*)d_in[13]; a.final_g = (const float*)d_in[14];
    a.out = (float*)d_out; a.ws = (unsigned char*)d_ws;
#if MK_PER_PHASE
    for (int p = 0; p < N_PHASES; ++p) { a.ph_lo = p; a.ph_hi = p + 1; hipLaunchKernelGGL(mega_fwd, dim3(grid), dim3(NWAVES * 64), LDS_BYTES, stream, a); }
#else
    a.ph_lo = 0; a.ph_hi = N_PHASES; hipLaunchKernelGGL(mega_fwd, dim3(grid), dim3(NWAVES * 64), LDS_BYTES, stream, a);
#endif
    const hipError_t le = hipPeekAtLastError();
    if (le != hipSuccess) fprintf(stderr, "kernel_launch: launch failed: %s\n", hipGetErrorName(le));
}
```

```cpp
#include <hip/hip_runtime.h>
#include <hip/hip_bf16.h>
#include <cstdio>
#include <cstdint>
__device__ __forceinline__ float shx(float v, int off, int lane) { return __int_as_float(__builtin_amdgcn_ds_bpermute((lane ^ off) << 2, __float_as_int(v))); }
__device__ __forceinline__ int shi(int v, int src) { return __builtin_amdgcn_ds_bpermute(src << 2, v); }
namespace pg8 {
#define PG8_LAS __attribute__((address_space(3)))
typedef unsigned short bf16_t;
typedef short bf16x8 __attribute__((ext_vector_type(8)));
typedef float f32x4 __attribute__((ext_vector_type(4)));
typedef unsigned u32x4 __attribute__((ext_vector_type(4)));
constexpr int BM = 256, BK = 64, HALF = 128, HTB = HALF * BK * 2  , STAGE_BYTES = 8 * HTB, NXCD = 8, WGM = 8;

__host__ __device__ __forceinline__ int lds_byte(int r, int c) { const int st = (r >> 4) * 2 + (c >> 5), rr = r & 15, cc = c & 31, ob = rr * 64 + cc * 2; return st * 1024 + (ob ^ (((ob >> 9) & 1) << 5)); }
__host__ __device__ __forceinline__ void stage_rc(int b, int& R, int& C) { const int st = b / 1024, sb = b % 1024, swz = sb ^ (((sb >> 9) & 1) << 5); R = (st >> 1) * 16 + swz / 64; C = (st & 1) * 32 + (swz % 64) / 2; }
__host__ __device__ __forceinline__ int perm32(int rho) { const int n = rho >> 4, i = rho & 15; return 8 * (i >> 2) + 4 * n + (i & 3); }

struct Unit { int pm, pn; };
struct Gemm { const bf16_t* A; const bf16_t* Bt; int M, N, K; int gshift; size_t gstride; const int* gidx; };

struct StaticOrder {
    int nM, nN, nwg, G, c;
    __host__ __device__ void init(int M, int N, int G_, int c_) { nM = M / BM; nN = N / BM; nwg = nM * nN; G = G_; c = c_; }
    __host__ __device__ bool next(int i, Unit& u) const {
        const long L = (long)i * G + c; if (L >= nwg) return false;
        int wgid = (int)L; { const int q = nwg / NXCD, r = nwg % NXCD, xcd = wgid % NXCD, off = wgid / NXCD; wgid = (xcd < r ? xcd * (q + 1) : r * (q + 1) + (xcd - r) * q) + off; }
        const int nig = WGM * nN, gid = wgid / nig, fm = gid * WGM, gsz = (nM - fm) < WGM ? (nM - fm) : WGM;
        u.pm = fm + ((wgid % nig) % gsz); u.pn = (wgid % nig) / gsz; return true;
    }
    __device__ __forceinline__ void a_ready(const Unit&) const {}
    __device__ __forceinline__ void done(const Unit&) const {}
};

#define PG8_GAS __attribute__((address_space(1)))
typedef float f32x2 __attribute__((ext_vector_type(2)));
typedef __bf16 bf16x2_t __attribute__((ext_vector_type(2)));
__device__ __forceinline__ unsigned cvt_pk_bf16(float lo, float hi) { f32x2 v = {lo, hi}; bf16x2_t b = __builtin_convertvector(v, bf16x2_t); return __builtin_bit_cast(unsigned, b); }
__device__ __forceinline__ u32x4 pack8(const f32x4 v0, const f32x4 v1) { u32x4 w; w.x = cvt_pk_bf16(v0[0], v0[1]); w.y = cvt_pk_bf16(v0[2], v0[3]); w.z = cvt_pk_bf16(v1[0], v1[1]); w.w = cvt_pk_bf16(v1[2], v1[3]); return w; }
__device__ __forceinline__ float sigmoidf_(float x) { return __builtin_amdgcn_rcpf(1.0f + __expf(-x)); }
__device__ __forceinline__ f32x4 silu4(const f32x4 v) { f32x4 o; o[0] = v[0] * sigmoidf_(v[0]); o[1] = v[1] * sigmoidf_(v[1]); o[2] = v[2] * sigmoidf_(v[2]); o[3] = v[3] * sigmoidf_(v[3]); return o; }

struct EpiInProj {
    static constexpr bool PERM = true, AFTER_DRAIN = false;
    bf16_t *Q, *Kb, *V, *HQ, *KK, *HV, *HG; unsigned short* LF;   const float* rope; const float* lbs;
    float qscale; unsigned* kmax; int nostore; const float* rs;
    __device__ __forceinline__ void operator()(const f32x4 (&acc)[2][2][4][2], const Unit& u, int wr, int wc, int fr, int fq) const {
        const int seg = u.pn >> 2, tp = u.pn & 3;
        const int row0 = u.pm * BM + wr * 64 + fr;
        if (seg < 2) {
            bf16_t* dst = seg == 0 ? Q : Kb; const float sc = seg == 0 ? qscale : 1.0f;
            const int col = (tp * 4 + wc) * 64 + 8 * fq;
            float kmx = 0.f;
#pragma unroll
            for (int ai = 0; ai < 2; ++ai)
#pragma unroll
                for (int m = 0; m < 4; ++m) { const int row = row0 + ai * HALF + m * 16;
                    const float* tb = rope + (size_t)row * 64 + 8 * fq;
                    const f32x4 c0 = *(const PG8_GAS f32x4*)(tb), c1 = *(const PG8_GAS f32x4*)(tb + 4), s0 = *(const PG8_GAS f32x4*)(tb + 32), s1 = *(const PG8_GAS f32x4*)(tb + 36);
                    const float r_ = ((const PG8_GAS float*)rs)[row]; const f32x4 xa = acc[ai][0][m][0] * r_, xb = acc[ai][0][m][1] * r_, ya = acc[ai][1][m][0] * r_, yb = acc[ai][1][m][1] * r_;
                    const f32x4 o1a = (xa * c0 - ya * s0) * sc, o1b = (xb * c1 - yb * s1) * sc, o2a = (ya * c0 + xa * s0) * sc, o2b = (yb * c1 + xb * s1) * sc;
                    bf16_t* rowp = dst + (size_t)row * 1024 + col;
                    if (!nostore) { *(PG8_GAS u32x4*)(rowp) = pack8(o1a, o1b); *(PG8_GAS u32x4*)(rowp + 32) = pack8(o2a, o2b); }
                    if (seg == 1) { const f32x4 q2 = xa * xa + xb * xb + ya * ya + yb * yb; float ss = (q2[0] + q2[1]) + (q2[2] + q2[3]);
                        ss += shx(ss, 16, fq * 16 + fr); ss += shx(ss, 32, fq * 16 + fr); kmx = fmaxf(kmx, ss); } }
            if (seg == 1) {
#pragma unroll
                for (int o_ = 1; o_ < 16; o_ <<= 1) kmx = fmaxf(kmx, shx(kmx, o_, fq * 16 + fr));
                if (fr == 0 && fq == 0) __hip_atomic_fetch_max(kmax + tp * 4 + wc, __float_as_uint(sqrtf(kmx)), __ATOMIC_RELAXED, __HIP_MEMORY_SCOPE_AGENT); }
        } else if (seg == 4 || seg == 5) {
            const int dir = seg - 4;
#pragma unroll
            for (int bj = 0; bj < 2; ++bj) { const int col = tp * 256 + bj * HALF + wc * 32 + 8 * fq;
                const f32x4 lb0 = *(const PG8_GAS f32x4*)(lbs + dir * 4096 + col), lb1 = *(const PG8_GAS f32x4*)(lbs + dir * 4096 + col + 4);
#pragma unroll
                for (int ai = 0; ai < 2; ++ai)
#pragma unroll
                    for (int m = 0; m < 4; ++m) { const int row = row0 + ai * HALF + m * 16;
                        f32x4 lf0, lf1, k0, k1; const float r_ = ((const PG8_GAS float*)rs)[row];
#pragma unroll
                        for (int q = 0; q < 4; ++q) { const float z0 = fminf(fmaxf(acc[ai][bj][m][0][q] * r_, -80.f), 80.f), z1 = fminf(fmaxf(acc[ai][bj][m][1][q] * r_, -80.f), 80.f);
                            const float e0 = __expf(-z0), e1 = __expf(-z1), sg0 = __builtin_amdgcn_rcpf(1.0f + e0), sg1 = __builtin_amdgcn_rcpf(1.0f + e1);
                            lf0[q] = __logf(lb0[q] + (1.0f - lb0[q]) * sg0); lf1[q] = __logf(lb1[q] + (1.0f - lb1[q]) * sg1);
                            k0[q] = (1.0f - lb0[q]) * (e0 * sg0); k1[q] = (1.0f - lb1[q]) * (e1 * sg1); }
                        unsigned short* lfp = LF + (size_t)row * 2048 + dir * 1024 + col; if (!nostore) { typedef _Float16 h2_t __attribute__((ext_vector_type(2))); u32x4 hw_;
                        hw_.x = __builtin_bit_cast(unsigned, __builtin_convertvector((f32x2){lf0[0], lf0[1]}, h2_t)); hw_.y = __builtin_bit_cast(unsigned, __builtin_convertvector((f32x2){lf0[2], lf0[3]}, h2_t));
                        hw_.z = __builtin_bit_cast(unsigned, __builtin_convertvector((f32x2){lf1[0], lf1[1]}, h2_t)); hw_.w = __builtin_bit_cast(unsigned, __builtin_convertvector((f32x2){lf1[2], lf1[3]}, h2_t)); *(u32x4*)lfp = hw_;
                        *(PG8_GAS u32x4*)(KK + (size_t)row * 2048 + dir * 1024 + col) = pack8(k0, k1); } else if (lf0[0] + lf1[1] + k0[2] + k1[3] == 12345.678f) *lfp = 0; }
            }
        } else {
            bf16_t* dst = seg == 2 ? V : seg == 3 ? HQ : seg == 6 ? HV : HG;
#pragma unroll
            for (int bj = 0; bj < 2; ++bj) { const int col = tp * 256 + bj * HALF + wc * 32 + 8 * fq;
#pragma unroll
                for (int ai = 0; ai < 2; ++ai)
#pragma unroll
                    for (int m = 0; m < 4; ++m) { const int row = row0 + ai * HALF + m * 16;
                        const float r_ = ((const PG8_GAS float*)rs)[row]; f32x4 v0 = acc[ai][bj][m][0] * r_, v1 = acc[ai][bj][m][1] * r_;
                        if (seg == 3) { v0 = silu4(v0) * 0.08838834764831845f; v1 = silu4(v1) * 0.08838834764831845f; }
                        else if (seg == 7) { v0 = silu4(v0); v1 = silu4(v1); }
                        if (!nostore) *(PG8_GAS u32x4*)(dst + (size_t)row * 1024 + col) = pack8(v0, v1); else if (v0[0] + v1[1] == 12345.678f) dst[0] = 0; }
            }
        }
    }
};
template <bool F32BASE> struct EpiResidBf {
    static constexpr bool PERM = true, AFTER_DRAIN = false;
    const float* xf; bf16_t* X;
    __device__ __forceinline__ void operator()(const f32x4 (&acc)[2][2][4][2], const Unit& u, int wr, int wc, int fr, int fq) const {
#pragma unroll
        for (int ai = 0; ai < 2; ++ai)
#pragma unroll
            for (int m = 0; m < 4; ++m) { const size_t row = (size_t)(u.pm * BM + ai * HALF + wr * 64 + m * 16 + fr);
#pragma unroll
                for (int bj = 0; bj < 2; ++bj) { const size_t off = row * 2048 + u.pn * BM + bj * HALF + wc * 32 + 8 * fq;
                    f32x4 b0, b1;
                    if (F32BASE) { b0 = *(const PG8_GAS f32x4*)(xf + off); b1 = *(const PG8_GAS f32x4*)(xf + off + 4); }
                    else { const u32x4 w = *(const PG8_GAS u32x4*)(X + off); b0 = (f32x4){__uint_as_float(w.x << 16), __uint_as_float(w.x & 0xffff0000u), __uint_as_float(w.y << 16), __uint_as_float(w.y & 0xffff0000u)};
                           b1 = (f32x4){__uint_as_float(w.z << 16), __uint_as_float(w.z & 0xffff0000u), __uint_as_float(w.w << 16), __uint_as_float(w.w & 0xffff0000u)}; }
                    *(PG8_GAS u32x4*)(X + off) = pack8(b0 + acc[ai][bj][m][0], b1 + acc[ai][bj][m][1]); } }
    }
};
struct EpiSwiGLU {
    static constexpr bool PERM = true, AFTER_DRAIN = false;
    bf16_t* H; const float* rsg;
    __device__ __forceinline__ void operator()(const f32x4 (&acc)[2][2][4][2], const Unit& u, int wr, int wc, int fr, int fq) const {
        const int col = u.pn * HALF + wc * 32 + 8 * fq;
#pragma unroll
        for (int ai = 0; ai < 2; ++ai)
#pragma unroll
            for (int m = 0; m < 4; ++m) { const int row = u.pm * BM + ai * HALF + wr * 64 + m * 16 + fr; const float r_ = ((const PG8_GAS float*)rsg)[row];
                const f32x4 h0 = silu4(acc[ai][0][m][0] * r_) * (acc[ai][1][m][0] * r_), h1 = silu4(acc[ai][0][m][1] * r_) * (acc[ai][1][m][1] * r_);
                *(PG8_GAS u32x4*)(H + (size_t)row * 1024 + col) = pack8(h0, h1); }
    }
};
struct EpiDown {
    static constexpr bool PERM = true, AFTER_DRAIN = false;
    bf16_t* Y; const float* gate;
    __device__ __forceinline__ void operator()(const f32x4 (&acc)[2][2][4][2], const Unit& u, int wr, int wc, int fr, int fq) const {
#pragma unroll
        for (int ai = 0; ai < 2; ++ai)
#pragma unroll
            for (int m = 0; m < 4; ++m) { const int row = u.pm * BM + ai * HALF + wr * 64 + m * 16 + fr; const float g = ((const PG8_GAS float*)gate)[row];
#pragma unroll
                for (int bj = 0; bj < 2; ++bj) { const int col = u.pn * BM + bj * HALF + wc * 32 + 8 * fq;
                    *(PG8_GAS u32x4*)(Y + (size_t)row * 2048 + col) = pack8(acc[ai][bj][m][0] * g, acc[ai][bj][m][1] * g); } }
    }
};
template <class Epi, class Sched, bool ALIGN_EPI = false, bool SP2 = false, bool GATHER = false>
__device__ __forceinline__ void gemm_phase(PG8_LAS unsigned char* lds, const Gemm g, const Sched& S, const Epi& E, const int tid) {
    const int wid = __builtin_amdgcn_readfirstlane(tid >> 6), lane = tid & 63, wr = wid >> 2, wc = wid & 3, fr = lane & 15, fq = lane >> 4;
    const int K = g.K, nt = K / BK;
    unsigned voffA[2], voffB[2];
#pragma unroll
    for (int i = 0; i < 2; ++i) { int R, C; stage_rc(tid * 16 + i * 8192, R, C); const int Rb = Epi::PERM ? ((R & ~31) + perm32(R & 31)) : R;
        voffA[i] = (unsigned)(R * K + C) * 2u; voffB[i] = (unsigned)(Rb * K + C) * 2u; }
    unsigned vgc[2][2], vgn[2][2];
#define PG8_GLOAD(u, v) do { _Pragma("unroll") for (int h_ = 0; h_ < 2; ++h_) _Pragma("unroll") for (int i_ = 0; i_ < 2; ++i_) { int R_, C_; stage_rc(tid * 16 + i_ * 8192, R_, C_); \
        v[h_][i_] = ((unsigned)g.gidx[(u).pm * BM + h_ * HALF + R_] * (unsigned)K + (unsigned)C_) * 2u; } } while (0)
#define PG8_STA(b, h, base, NX) do { if constexpr (GATHER) { const unsigned vv_[2] = {(NX) ? vgn[h][0] : vgc[h][0], (NX) ? vgn[h][1] : vgc[h][1]}; PG8_STAGE(PG8_SA(b, h), base, vv_); } \
        else { PG8_STAGE(PG8_SA(b, h), (base) + (h) * hstep, voffA); } } while (0)
    const size_t kstep = (size_t)(BK * 2);
    const size_t hstep = (size_t)HALF * K * 2;
    const size_t tstep = 2 * hstep;
    const unsigned ldsw = (unsigned)wid * 1024u;
    const int aoff = lds_byte(wr * 64 + fr, fq * 8), boff = lds_byte(wc * 32 + fr, fq * 8);
#define PG8_SA(b, h) (((b) * 2 + (h)) * HTB)
#define PG8_SB(b, h) ((4 + (b) * 2 + (h)) * HTB)
#define PG8_STAGE(bufoff, gbase, voff) do { _Pragma("unroll") for (int _i = 0; _i < 2; ++_i) \
        __builtin_amdgcn_global_load_lds((const unsigned*)((const char*)(gbase) + (voff)[_i]), (PG8_LAS unsigned*)(lds + (bufoff) + ldsw + _i * 8192), 16, 0, 0); } while (0)
#define PG8_LDA(dst, b, h) do { _Pragma("unroll") for (int m = 0; m < 4; ++m) _Pragma("unroll") for (int k = 0; k < 2; ++k) dst[m][k] = *(const PG8_LAS bf16x8*)(lds + PG8_SA(b, h) + aoff + m * 2048 + k * 1024); } while (0)
#define PG8_LDB(dst, b, h) do { _Pragma("unroll") for (int n = 0; n < 2; ++n) _Pragma("unroll") for (int k = 0; k < 2; ++k) dst[n][k] = *(const PG8_LAS bf16x8*)(lds + PG8_SB(b, h) + boff + n * 2048 + k * 1024); } while (0)
#define PG8_MMA(ai, bj, At, Bt) do { __builtin_amdgcn_s_setprio(1); _Pragma("unroll") for (int m = 0; m < 4; ++m) _Pragma("unroll") for (int n = 0; n < 2; ++n) _Pragma("unroll") for (int k = 0; k < 2; ++k) \
        acc[ai][bj][m][n] = __builtin_amdgcn_mfma_f32_16x16x32_bf16(Bt[n][k], At[m][k], acc[ai][bj][m][n], 0, 0, 0); __builtin_amdgcn_s_setprio(0); } while (0)
#define PG8_WAIT_V(n) asm volatile("s_waitcnt vmcnt(" #n ")" ::: "memory")
#define PG8_WAIT_L(n) asm volatile("s_waitcnt lgkmcnt(" #n ")" ::: "memory")
#define PG8_BAR __builtin_amdgcn_s_barrier()
#define PG8_SCHED __builtin_amdgcn_sched_barrier(0)
    Unit cur, nxt; int ui = 0;
    if (!S.next(0, cur)) return;
    f32x4 acc[2][2][4][2];
#pragma unroll
    for (int a = 0; a < 2; ++a)
#pragma unroll
        for (int b = 0; b < 2; ++b)
#pragma unroll
            for (int m = 0; m < 4; ++m)
#pragma unroll
                for (int n = 0; n < 2; ++n) acc[a][b][m][n] = (f32x4){0.f, 0.f, 0.f, 0.f};
    bf16x8 At[4][2], B0[2][2], B1[2][2];
    if constexpr (GATHER) PG8_GLOAD(cur, vgc);
    const char* cA = (const char*)g.A + (GATHER ? (size_t)0 : (size_t)cur.pm * tstep); const char* cB = (const char*)g.Bt + (size_t)(cur.pm >> g.gshift) * g.gstride + (size_t)cur.pn * tstep;
    S.a_ready(cur);
    if constexpr (SP2) {
        PG8_STAGE(PG8_SB(0, 0), cB, voffB); PG8_STAGE(PG8_SB(0, 1), cB + hstep, voffB); PG8_STA(0, 0, cA, false); PG8_STA(0, 1, cA, false);
        if (wr == 1) PG8_BAR;
        PG8_WAIT_V(2); PG8_BAR;
        PG8_STAGE(PG8_SB(1, 0), cB + kstep, voffB); PG8_STA(1, 0, cA + kstep, false); PG8_STAGE(PG8_SB(1, 1), cB + hstep + kstep, voffB);
        PG8_WAIT_V(6); PG8_BAR;
    } else {
        PG8_STAGE(PG8_SB(0, 0), cB, voffB); PG8_STA(0, 0, cA, false); PG8_STAGE(PG8_SB(0, 1), cB + hstep, voffB); PG8_STA(0, 1, cA, false);
        if (wr == 1) PG8_BAR;
        PG8_WAIT_V(4); PG8_BAR;
        PG8_STAGE(PG8_SB(1, 0), cB + kstep, voffB); PG8_STA(1, 0, cA + kstep, false); PG8_STAGE(PG8_SB(1, 1), cB + hstep + kstep, voffB);
        PG8_WAIT_V(6); PG8_BAR;
    }
    for (;;) {
        const bool has_next = S.next(ui + 1, nxt);
        if constexpr (GATHER) { if (has_next) PG8_GLOAD(nxt, vgn); else { vgn[0][0] = vgc[0][0]; vgn[0][1] = vgc[0][1]; vgn[1][0] = vgc[1][0]; vgn[1][1] = vgc[1][1]; } }
        const char* nA = (has_next && !GATHER) ? (const char*)g.A + (size_t)nxt.pm * tstep : cA; const char* nB = has_next ? (const char*)g.Bt + (size_t)(nxt.pm >> g.gshift) * g.gstride + (size_t)nxt.pn * tstep : cB;
        for (int t = 0; t < nt; t += 2) {
            const bool last = (t == nt - 2);
            const char* a1 = cA + (size_t)(t + 1) * kstep;
            const char* a2 = last ? nA : cA + (size_t)(t + 2) * kstep; const char* b2 = last ? nB : cB + (size_t)(t + 2) * kstep;
            const char* a3 = a2 + kstep; const char* b3 = b2 + kstep;
            if (last && has_next) S.a_ready(nxt);
            if constexpr (SP2) {
            PG8_LDB(B0, 0, 0); PG8_LDB(B1, 0, 1); PG8_SCHED; PG8_LDA(At, 0, 0); PG8_STA(1, 1, a1, false);
            PG8_WAIT_V(8); PG8_WAIT_L(0); PG8_BAR; PG8_MMA(0, 0, At, B0); PG8_MMA(0, 1, At, B1); PG8_BAR; PG8_SCHED;
            PG8_LDA(At, 0, 1); PG8_STAGE(PG8_SB(0, 0), b2, voffB); PG8_STAGE(PG8_SB(0, 1), b2 + hstep, voffB); PG8_STA(0, 0, a2, last);
            PG8_WAIT_V(8); PG8_WAIT_L(0); PG8_BAR; PG8_MMA(1, 0, At, B0); PG8_MMA(1, 1, At, B1); PG8_BAR; PG8_SCHED;
            PG8_LDB(B0, 1, 0); PG8_LDB(B1, 1, 1); PG8_SCHED; PG8_LDA(At, 1, 0); PG8_STA(0, 1, a2, last);
            PG8_WAIT_V(8); PG8_WAIT_L(0); PG8_BAR; PG8_MMA(0, 0, At, B0); PG8_MMA(0, 1, At, B1); PG8_BAR; PG8_SCHED;
            PG8_LDA(At, 1, 1); PG8_STAGE(PG8_SB(1, 0), b3, voffB); PG8_STAGE(PG8_SB(1, 1), b3 + hstep, voffB); PG8_STA(1, 0, a3, last);
            PG8_WAIT_V(8); PG8_WAIT_L(0); PG8_BAR; PG8_MMA(1, 0, At, B0); PG8_MMA(1, 1, At, B1); PG8_BAR; PG8_SCHED;
            } else {
            PG8_LDB(B0, 0, 0); PG8_SCHED; PG8_LDA(At, 0, 0); PG8_STA(1, 1, a1, false);
            PG8_WAIT_L(8); PG8_BAR; PG8_WAIT_L(0); PG8_MMA(0, 0, At, B0); PG8_BAR; PG8_SCHED;
            PG8_LDB(B1, 0, 1); PG8_STAGE(PG8_SB(0, 0), b2, voffB);
            PG8_BAR; PG8_WAIT_L(0); PG8_MMA(0, 1, At, B1); PG8_BAR;
            PG8_LDA(At, 0, 1); PG8_STA(0, 0, a2, last);
            PG8_BAR; PG8_WAIT_L(0); PG8_MMA(1, 0, At, B0); PG8_BAR; PG8_SCHED;
            PG8_STAGE(PG8_SB(0, 1), b2 + hstep, voffB);
            PG8_WAIT_V(6); PG8_BAR; PG8_MMA(1, 1, At, B1); PG8_BAR;
            PG8_LDB(B0, 1, 0); PG8_SCHED; PG8_LDA(At, 1, 0); PG8_STA(0, 1, a2, last);
            PG8_WAIT_L(8); PG8_BAR; PG8_WAIT_L(0); PG8_MMA(0, 0, At, B0); PG8_BAR; PG8_SCHED;
            PG8_LDB(B1, 1, 1); PG8_STAGE(PG8_SB(1, 0), b3, voffB);
            PG8_BAR; PG8_WAIT_L(0); PG8_MMA(0, 1, At, B1); PG8_BAR;
            PG8_LDA(At, 1, 1); PG8_STA(1, 0, a3, last);
            PG8_BAR; PG8_WAIT_L(0); PG8_MMA(1, 0, At, B0); PG8_BAR; PG8_SCHED;
            PG8_STAGE(PG8_SB(1, 1), b3 + hstep, voffB);
            PG8_WAIT_V(6); PG8_BAR; PG8_MMA(1, 1, At, B1); PG8_BAR;
            }
        }
        if constexpr (ALIGN_EPI) { if (wr == 0) PG8_BAR; }
        if constexpr (!Epi::AFTER_DRAIN) { E(acc, cur, wr, wc, fr, fq); S.done(cur); }
        if (!has_next) break;
#pragma unroll
        for (int a = 0; a < 2; ++a)
#pragma unroll
            for (int b = 0; b < 2; ++b)
#pragma unroll
                for (int m = 0; m < 4; ++m)
#pragma unroll
                    for (int n = 0; n < 2; ++n) acc[a][b][m][n] = (f32x4){0.f, 0.f, 0.f, 0.f};
        cur = nxt; cA = nA; cB = nB; ++ui;
        if constexpr (GATHER) { vgc[0][0] = vgn[0][0]; vgc[0][1] = vgn[0][1]; vgc[1][0] = vgn[1][0]; vgc[1][1] = vgn[1][1]; }
        if constexpr (ALIGN_EPI) { if (wr == 1) PG8_BAR; }
    }
    PG8_WAIT_V(0);
    if constexpr (!ALIGN_EPI) { if (wr == 0) PG8_BAR; }
    PG8_BAR;
    if constexpr (Epi::AFTER_DRAIN) { E.fused(acc, cur, wr, wc, fr, fq, lds, wid, lane); S.done(cur); }
#undef PG8_SA
#undef PG8_SB
#undef PG8_STAGE
#undef PG8_LDA
#undef PG8_LDB
#undef PG8_MMA
#undef PG8_WAIT_V
#undef PG8_WAIT_L
#undef PG8_BAR
#undef PG8_SCHED
#undef PG8_STA
#undef PG8_GLOAD
}
}

namespace att {
using bf16 = unsigned short;
using bf16x8 = __attribute__((ext_vector_type(8))) short;
using s16x4  = __attribute__((ext_vector_type(4))) short;
using f32x16 = __attribute__((ext_vector_type(16))) float;
using u32x4  = __attribute__((ext_vector_type(4))) unsigned;
constexpr int NW = 8, QBLK = 32, KVBLK = 64, SEQ = 16384, LDQ = 1024, LDMIX = 2048;
constexpr int SHM_V = KVBLK * 128 * 2, SHM_K = KVBLK * 64 * 2;
constexpr int OFF_V = 0, OFF_K = 2 * SHM_V, OFF_WS = OFF_K + 2 * SHM_K, LDS_BYTES = OFF_WS + NW * 64 * 4;
constexpr float THR2 = 11.0f;
#define AT_LAS __attribute__((address_space(3)))
#define AT_KSWZ(row, colB) ((row) * 128 + ((colB) ^ ((((row) >> 1) & 7) << 4)))
#define AT_SBAR() __builtin_amdgcn_sched_barrier(0)
__device__ __forceinline__ int crow(int r, int hi) { return (r & 3) + 8 * (r >> 2) + 4 * hi; }
__device__ __forceinline__ unsigned cvtpk(float lo, float hi) { unsigned r; asm volatile("v_cvt_pk_bf16_f32 %0, %1, %2" : "=v"(r) : "v"(lo), "v"(hi)); return r; }

__device__ __forceinline__ void partialSM(f32x16& p0, f32x16& p1, float& m_reg, float& alpha) {
  float pmax = p0[0];
#pragma unroll
  for (int r = 1; r < 16; ++r) pmax = fmaxf(pmax, p0[r]);
#pragma unroll
  for (int r = 0; r < 16; ++r) pmax = fmaxf(pmax, p1[r]);
  { auto rr = __builtin_amdgcn_permlane32_swap(__float_as_uint(pmax), __float_as_uint(pmax), false, false);
    pmax = fmaxf(__uint_as_float(rr[0]), __uint_as_float(rr[1])); }
  float mn;
  if (__builtin_expect(__all(pmax - m_reg <= THR2), 1)) { mn = m_reg; alpha = 1.f; }
  else { mn = fmaxf(m_reg, pmax); alpha = __builtin_amdgcn_exp2f(m_reg - mn); m_reg = mn; }
#pragma unroll
  for (int r = 0; r < 16; ++r) { p0[r] -= mn; p1[r] -= mn; }
#pragma unroll
  for (int r = 0; r < 16; ++r) p0[r] = __builtin_amdgcn_exp2f(p0[r]);
}
__device__ __forceinline__ void finishSM(f32x16& p0, f32x16& p1, float alpha, float& l_reg, bf16x8& pa0, bf16x8& pa1, bf16x8& pa2, bf16x8& pa3) {
#pragma unroll
  for (int r = 0; r < 16; ++r) p1[r] = __builtin_amdgcn_exp2f(p1[r]);
  float ps = 0;
#pragma unroll
  for (int r = 0; r < 16; ++r) ps += p0[r];
#pragma unroll
  for (int r = 0; r < 16; ++r) ps += p1[r];
  { auto rr = __builtin_amdgcn_permlane32_swap(__float_as_uint(ps), __float_as_uint(ps), false, false);
    ps = __uint_as_float(rr[0]) + __uint_as_float(rr[1]); }
  l_reg = l_reg * alpha + ps;
#define AT_PK4(P, BASE, OUT) do { unsigned a0 = cvtpk(P[BASE + 0], P[BASE + 1]), a1 = cvtpk(P[BASE + 2], P[BASE + 3]);   \
    unsigned b0 = cvtpk(P[BASE + 4], P[BASE + 5]), b1 = cvtpk(P[BASE + 6], P[BASE + 7]);                              \
    auto r0 = __builtin_amdgcn_permlane32_swap(a0, b0, false, false); auto r1 = __builtin_amdgcn_permlane32_swap(a1, b1, false, false); \
    u32x4 w = {r0[0], r1[0], r0[1], r1[1]}; OUT = __builtin_bit_cast(bf16x8, w); } while (0)
  AT_PK4(p0, 0, pa0); AT_PK4(p0, 8, pa1); AT_PK4(p1, 0, pa2); AT_PK4(p1, 8, pa3);
#undef AT_PK4
}
__device__ __forceinline__ void qkt(f32x16& p0, f32x16& p1, const AT_LAS char* Ks, const bf16x8 (&qr)[4], int r32, int hi) {
  p0 = f32x16{}; p1 = f32x16{};
#pragma unroll
  for (int d0 = 0; d0 < 4; ++d0) { const int cb = (d0 * 16 + hi * 8) * 2;
    const bf16x8 b0 = *(const AT_LAS bf16x8*)(Ks + AT_KSWZ(r32, cb));
    const bf16x8 b1 = *(const AT_LAS bf16x8*)(Ks + AT_KSWZ(32 + r32, cb));
    p0 = __builtin_amdgcn_mfma_f32_32x32x16_bf16(b0, qr[d0], p0, 0, 0, 0);
    p1 = __builtin_amdgcn_mfma_f32_32x32x16_bf16(b1, qr[d0], p1, 0, 0, 0); }
}
__device__ __forceinline__ int v_st(int k, int c) { const int kk = (k & ~0xC) | ((k & 4) << 1) | ((k & 8) >> 1); return ((kk >> 3) * 4 + (c >> 5)) * 512 + ((kk & 7) * 32 + (c & 31)) * 2; }
__device__ __forceinline__ int v_rd_base(int lane) { return ((lane & 3) << 3) | (((lane >> 2) & 3) << 6) | (((lane >> 4) & 1) << 5) | (((lane >> 5) & 1) << 8); }
constexpr int v_rd_off(int d0, int ks, int half) { return d0 * 512 + ks * 4096 + half * 2048; }
template <int OFF> __device__ __forceinline__ s16x4 tr_read(int vb) {
  s16x4 r; asm volatile("ds_read_b64_tr_b16 %0, %1 offset:%2" : "=&v"(r) : "v"(vb), "i"(OFF) : "memory"); return r;
}
template <int D0> __device__ __forceinline__ void pv_one(f32x16& od, int vb, bf16x8 pa0, bf16x8 pa1, bf16x8 pa2, bf16x8 pa3) {
  const s16x4 l0 = tr_read<v_rd_off(D0, 0, 0)>(vb), h0 = tr_read<v_rd_off(D0, 0, 1)>(vb), l1 = tr_read<v_rd_off(D0, 1, 0)>(vb), h1 = tr_read<v_rd_off(D0, 1, 1)>(vb);
  const s16x4 l2 = tr_read<v_rd_off(D0, 2, 0)>(vb), h2 = tr_read<v_rd_off(D0, 2, 1)>(vb), l3 = tr_read<v_rd_off(D0, 3, 0)>(vb), h3 = tr_read<v_rd_off(D0, 3, 1)>(vb);
  asm volatile("s_waitcnt lgkmcnt(0)" ::: "memory"); AT_SBAR();
#define AT_PK(L, H) (bf16x8){L[0], L[1], L[2], L[3], H[0], H[1], H[2], H[3]}
  od = __builtin_amdgcn_mfma_f32_32x32x16_bf16(pa0, AT_PK(l0, h0), od, 0, 0, 0);
  od = __builtin_amdgcn_mfma_f32_32x32x16_bf16(pa1, AT_PK(l1, h1), od, 0, 0, 0);
  od = __builtin_amdgcn_mfma_f32_32x32x16_bf16(pa2, AT_PK(l2, h2), od, 0, 0, 0);
  od = __builtin_amdgcn_mfma_f32_32x32x16_bf16(pa3, AT_PK(l3, h3), od, 0, 0, 0);
#undef AT_PK
}
__device__ __forceinline__ void pv_d0(f32x16 (&o)[4], int vb, bf16x8 pa0, bf16x8 pa1, bf16x8 pa2, bf16x8 pa3) {
  pv_one<0>(o[0], vb, pa0, pa1, pa2, pa3); pv_one<1>(o[1], vb, pa0, pa1, pa2, pa3); pv_one<2>(o[2], vb, pa0, pa1, pa2, pa3); pv_one<3>(o[3], vb, pa0, pa1, pa2, pa3);
}

struct AttnArgs { const bf16* Q; const bf16* K; const bf16* V; const bf16* VT; float* AO1; bf16* MIX; const float* subg; const float* kmax; float lam; float outscale; };

#ifndef AT_STAGGER
#define AT_STAGGER 0
#endif
#ifndef AT_PF
#define AT_PF 2
#endif
constexpr int NBUF = 5, BUF_BYTES = SHM_K + SHM_V;
constexpr int OFF_WS2 = NBUF * BUF_BYTES, LDS_BYTES2 = OFF_WS2 + NW * 64 * 4;
__device__ __forceinline__ void glds16(const void* gsrc, unsigned lds_dst) { unsigned keep;
  asm volatile("s_mov_b32 %0, m0\n\ts_mov_b32 m0, %2\n\ts_nop 0\n\tglobal_load_lds_dwordx4 %1, off\n\ts_mov_b32 m0, %0" : "=&s"(keep) : "v"(gsrc), "s"(lds_dst) : "memory"); }
__device__ __forceinline__ void glds16s(const void* sbase, unsigned voff, unsigned lds_dst) { unsigned keep;
  asm volatile("s_mov_b32 %0, m0\n\ts_mov_b32 m0, %3\n\ts_nop 4\n\tglobal_load_lds_dwordx4 %1, %2\n\ts_mov_b32 m0, %0" : "=&s"(keep) : "v"(voff), "s"(sbase), "s"(lds_dst) : "memory"); }
#define AT_WAIT_BAR(N) asm volatile("s_waitcnt vmcnt(" #N ") lgkmcnt(0)\n\ts_barrier" ::: "memory")

template <int VAR>
__device__ __forceinline__ void attn_unit(const AttnArgs& A, int h, int qt, AT_LAS char* lds, const int tid) {
  const int q0 = qt * 256;
  const unsigned lds0 = (unsigned)(uintptr_t)lds;
  constexpr int NT = SEQ / KVBLK;
#pragma unroll 1
  for (int mp = 0; mp < 2; ++mp) {
    int tl = tid; asm volatile("" : "+v"(tl));
    const int lane = tl & 63, r32 = lane & 31, hi = lane >> 5; const int wid = __builtin_amdgcn_readfirstlane(tl >> 6);
    AT_LAS float* li_l = (AT_LAS float*)(lds + OFF_WS2) + wid * 64;
    int koff, voff0, voff1;
    { const int row = 8 * wid + (lane >> 3), cpos = lane & 7; koff = row * LDQ + 8 * (cpos ^ ((row >> 1) & 7)); }
    { const int B = (2 * wid) * 1024 + lane * 16, sub = B >> 9, wel = (B & 511) >> 1, kk = (sub >> 2) * 8 + (wel >> 5), k = (kk & ~0xC) | ((kk & 4) << 1) | ((kk & 8) >> 1); voff0 = k * LDQ + (sub & 3) * 32 + (wel & 31); }
    { const int B = (2 * wid + 1) * 1024 + lane * 16, sub = B >> 9, wel = (B & 511) >> 1, kk = (sub >> 2) * 8 + (wel >> 5), k = (kk & ~0xC) | ((kk & 4) << 1) | ((kk & 8) >> 1); voff1 = k * LDQ + (sub & 3) * 32 + (wel & 31); }
    const unsigned kdst = lds0 + wid * 1024, vdst = lds0 + SHM_K + wid * 2048;
    const int vrd = (int)lds0 + SHM_K + v_rd_base(lane);
    const bf16* Vh = A.V + h * 128;
    const bf16* Kh = A.K + (h * 2 + mp) * 64;
    const bf16* Qw = A.Q + (size_t)(q0 + wid * QBLK + r32) * LDQ + (h * 2 + mp) * 64 + hi * 8;
    const unsigned kob = (unsigned)koff * 2u, vob0 = (unsigned)voff0 * 2u, vob1 = (unsigned)voff1 * 2u;
#define AT_DMA(t, boff) do { const size_t to_ = (size_t)(t) * (KVBLK * LDQ); const unsigned bo_ = (unsigned)__builtin_amdgcn_readfirstlane(boff); \
    glds16s(Kh + to_, kob, (unsigned)__builtin_amdgcn_readfirstlane(kdst + bo_)); glds16s(Vh + to_, vob0, (unsigned)__builtin_amdgcn_readfirstlane(vdst + bo_)); glds16s(Vh + to_, vob1, (unsigned)__builtin_amdgcn_readfirstlane(vdst + bo_ + 1024u)); } while (0)
    __syncthreads();
    AT_DMA(0, 0); AT_DMA(1, BUF_BYTES); if (AT_PF == 3) AT_DMA(2, 2 * BUF_BYTES);
    bf16x8 qr[4];
#pragma unroll
    for (int d0 = 0; d0 < 4; ++d0) qr[d0] = *(const bf16x8*)(Qw + d0 * 16);
    float qss = 0.f;
#pragma unroll
    for (int d0 = 0; d0 < 4; ++d0)
#pragma unroll
      for (int e = 0; e < 8; ++e) { const float v = __uint_as_float(((unsigned)(unsigned short)qr[d0][e]) << 16); qss += v * v; }
    { auto rr = __builtin_amdgcn_permlane32_swap(__float_as_uint(qss), __float_as_uint(qss), false, false); qss = __uint_as_float(rr[0]) + __uint_as_float(rr[1]); }
    const float mref = sqrtf(qss) * A.kmax[h * 2 + mp] * 1.01f + 0.25f;
    f32x16 negm;
#pragma unroll
    for (int r = 0; r < 16; ++r) negm[r] = -mref;
    float l_reg = 0.f; f32x16 o[4]; o[0] = f32x16{}; o[1] = f32x16{}; o[2] = f32x16{}; o[3] = f32x16{};
    f32x16 sA0, sA1, sB0, sB1; bf16x8 pa0, pa1, pa2, pa3;
    if (VAR & 4) { sB0 = negm; sB1 = negm; }
    if (AT_PF == 3) AT_WAIT_BAR(3); else AT_WAIT_BAR(0);
#define AT_QKT_D(P0, P1, kb_, d0) do { const int cb = ((d0) * 16 + hi * 8) * 2; \
      const bf16x8 b0 = *(const AT_LAS bf16x8*)(kb_ + AT_KSWZ(r32, cb)); const bf16x8 b1 = *(const AT_LAS bf16x8*)(kb_ + AT_KSWZ(32 + r32, cb)); \
      if ((d0) == 0) { P0 = __builtin_amdgcn_mfma_f32_32x32x16_bf16(b0, qr[d0], negm, 0, 0, 0); P1 = __builtin_amdgcn_mfma_f32_32x32x16_bf16(b1, qr[d0], negm, 0, 0, 0); } \
      else { P0 = __builtin_amdgcn_mfma_f32_32x32x16_bf16(b0, qr[d0], P0, 0, 0, 0); P1 = __builtin_amdgcn_mfma_f32_32x32x16_bf16(b1, qr[d0], P1, 0, 0, 0); } } while (0)
#define AT_QKT(P0, P1, boff) do { const AT_LAS char* kb_ = lds + (boff); \
    AT_QKT_D(P0, P1, kb_, 0); AT_QKT_D(P0, P1, kb_, 1); AT_SBAR(); AT_QKT_D(P0, P1, kb_, 2); AT_QKT_D(P0, P1, kb_, 3); } while (0)
#define AT_SOFT(P0, P1) do { float ps = 0.f; \
    if (!(VAR & 1)) { _Pragma("unroll") for (int r = 0; r < 16; ++r) { P0[r] = __builtin_amdgcn_exp2f(P0[r]); P1[r] = __builtin_amdgcn_exp2f(P1[r]); } } \
    _Pragma("unroll") for (int r = 0; r < 16; ++r) ps += P0[r]; \
    _Pragma("unroll") for (int r = 0; r < 16; ++r) ps += P1[r]; \
    l_reg += ps; \
    AT_PK4(P0, 0, pa0); AT_PK4(P0, 8, pa1); AT_PK4(P1, 0, pa2); AT_PK4(P1, 8, pa3); } while (0)
#define AT_PK4(P, BASE, OUT) do { unsigned a0 = cvtpk(P[BASE + 0], P[BASE + 1]), a1 = cvtpk(P[BASE + 2], P[BASE + 3]);   \
    unsigned b0 = cvtpk(P[BASE + 4], P[BASE + 5]), b1 = cvtpk(P[BASE + 6], P[BASE + 7]);                              \
    auto r0 = __builtin_amdgcn_permlane32_swap(a0, b0, false, false); auto r1 = __builtin_amdgcn_permlane32_swap(a1, b1, false, false); \
    u32x4 w = {r0[0], r1[0], r0[1], r1[1]}; OUT = __builtin_bit_cast(bf16x8, w); } while (0)
#define AT_STEP(C0, C1, N0, N1, j) do { \
    if (!(VAR & 16) && (j) + AT_PF < NT) AT_DMA((j) + AT_PF, (AT_PF == 3 ? b4 : b3)); \
    AT_SBAR(); if (!(VAR & 2) && late && (j) > 0) pv_d0(o, vrd + b0, pa0, pa1, pa2, pa3); AT_SBAR(); \
    if (!(VAR & 4) && (j) + 1 < NT) AT_QKT(N0, N1, b2); AT_SBAR(); \
    AT_SOFT(C0, C1); AT_SBAR(); \
    if (!(VAR & 2) && !late) pv_d0(o, vrd + b1, pa0, pa1, pa2, pa3); \
    if (VAR & 32) asm volatile("s_waitcnt lgkmcnt(0)\n\ts_barrier" ::: "memory"); else if (AT_PF == 3 && (j) + 3 < NT) AT_WAIT_BAR(3); else AT_WAIT_BAR(0); \
    { const int t_ = b0; b0 = b1; b1 = b2; b2 = b3; b3 = b4; b4 = t_; } } while (0)

    const bool late = AT_STAGGER && wid >= 4;
    int b0 = 4 * BUF_BYTES, b1 = 0, b2 = BUF_BYTES, b3 = 2 * BUF_BYTES, b4 = 3 * BUF_BYTES;
    AT_QKT(sA0, sA1, b1);
    for (int j = 0; j < NT; j += 2) {
      AT_STEP(sA0, sA1, sB0, sB1, j);
      AT_STEP(sB0, sB1, sA0, sA1, j + 1);
    }
    if (late) pv_d0(o, vrd + b0, pa0, pa1, pa2, pa3);
#undef AT_STEP
#undef AT_PK4
#undef AT_SOFT
#undef AT_QKT
#undef AT_QKT_D
#undef AT_DMA
    { auto rr = __builtin_amdgcn_permlane32_swap(__float_as_uint(l_reg), __float_as_uint(l_reg), false, false); l_reg = __uint_as_float(rr[0]) + __uint_as_float(rr[1]); }
    if (hi == 0) li_l[r32] = l_reg; asm volatile("s_waitcnt lgkmcnt(0)" ::: "memory");
    int r32e = r32, hie = hi; asm volatile("" : "+v"(r32e), "+v"(hie));
    const unsigned ebase = (unsigned)((q0 + wid * QBLK + 4 * hie) * 1024 + h * 128 + r32e);
    if (mp == 0) {
#pragma unroll
      for (int r = 0; r < 16; ++r) { float* op = A.AO1 + (ebase + (unsigned)(((r & 3) + 8 * (r >> 2)) * 1024)); const float rl = __builtin_amdgcn_rcpf(li_l[crow(r, hi)]);
#pragma unroll
        for (int d0 = 0; d0 < 4; ++d0) op[d0 * 32] = o[d0][r] * rl;
        if ((r & 3) == 3) asm volatile("" ::: "memory"); }
    } else {
      float sg[4];
#pragma unroll
      for (int d0 = 0; d0 < 4; ++d0) sg[d0] = A.subg[d0 * 32 + r32e] * A.outscale;
#pragma unroll
      for (int r = 0; r < 16; ++r) { const unsigned eo = ebase + (unsigned)(((r & 3) + 8 * (r >> 2)) * 1024); const float* ip = A.AO1 + eo; const float rl = __builtin_amdgcn_rcpf(li_l[crow(r, hi)]) * A.lam;
        float v[4]; float ss = 0.f;
#pragma unroll
        for (int d0 = 0; d0 < 4; ++d0) { v[d0] = ip[d0 * 32] - o[d0][r] * rl; ss += v[d0] * v[d0]; }
#pragma unroll
        for (int off = 1; off < 32; off <<= 1) ss += shx(ss, off, lane);
        const float rs = rsqrtf(ss * (1.0f / 128.0f) + 1e-6f);
        bf16* mp_ = A.MIX + (eo + (eo & ~1023u));
#pragma unroll
        for (int d0 = 0; d0 < 4; ++d0) mp_[d0 * 32] = (bf16)(pg8::cvt_pk_bf16(v[d0] * rs * sg[d0], 0.f) & 0xffffu);
        if ((r & 3) == 3) asm volatile("" ::: "memory"); }
    }
  }
}
#undef AT_SBAR
}

namespace att {
#define A2_SBAR() __builtin_amdgcn_sched_barrier(0)
#ifndef A2_NVF
#define A2_NVF 6
#endif
#ifndef A2_PRIO
#define A2_PRIO 1
#endif
__device__ __forceinline__ void glds3(const void* kbase, unsigned kvo, unsigned kdst, const void* vbase, unsigned vo0, unsigned vo1, unsigned vdst) { unsigned keep;
  asm volatile("s_mov_b32 %0, m0\n\ts_mov_b32 m0, %3\n\ts_nop 4\n\tglobal_load_lds_dwordx4 %1, %2\n\t"
               "s_mov_b32 m0, %7\n\ts_nop 0\n\tglobal_load_lds_dwordx4 %4, %6\n\t"
               "s_add_u32 m0, %7, 0x400\n\ts_nop 0\n\tglobal_load_lds_dwordx4 %5, %6\n\ts_mov_b32 m0, %0"
               : "=&s"(keep) : "v"(kvo), "s"(kbase), "s"(kdst), "v"(vo0), "v"(vo1), "s"(vbase), "s"(vdst) : "memory", "scc"); }
typedef short v4i16_t __attribute__((ext_vector_type(4)));
__device__ __forceinline__ s16x4 vtr(const AT_LAS char* p) { return __builtin_bit_cast(s16x4, __builtin_amdgcn_ds_read_tr16_b64_v4i16((AT_LAS v4i16_t*)p)); }
constexpr int A2_KB = SHM_K, A2_VB = SHM_V, A2_OFF_V = 2 * A2_KB, A2_OFF_WS = A2_OFF_V + 2 * A2_VB, A2_LDS_BYTES = A2_OFF_WS + NW * 64 * 4;
struct NoMid { __device__ __forceinline__ void operator()() const {} };
template <int VAR = 0, class Mid = NoMid>
__device__ __forceinline__ void attn_unit2(const AttnArgs& A, int h, int qt, AT_LAS char* lds, const int tid, const Mid& mid = Mid()) {
  const int q0 = qt * 256;
  const unsigned lds0 = (unsigned)(uintptr_t)lds;
  constexpr int NT = SEQ / KVBLK;
  constexpr size_t TS = (size_t)KVBLK * LDQ;
#pragma unroll 1
  for (int mp = 0; mp < 2; ++mp) {
    if (mp == 1) mid();
    int tl = tid; asm volatile("" : "+v"(tl));
    const int lane = tl & 63, r32 = lane & 31, hi = lane >> 5; const int wid = __builtin_amdgcn_readfirstlane(tl >> 6);
    AT_LAS float* li_l = (AT_LAS float*)(lds + A2_OFF_WS) + wid * 64;
    int koff, voff0, voff1;
    { const int row = 8 * wid + (lane >> 3), cpos = lane & 7; koff = row * LDQ + 8 * (cpos ^ ((row >> 1) & 7)); }
    { const int row = 8 * (2 * wid) + (lane >> 3), cpos = lane & 7; voff0 = row * SEQ + 8 * (cpos ^ ((row >> 1) & 7)); }
    { const int row = 8 * (2 * wid + 1) + (lane >> 3), cpos = lane & 7; voff1 = row * SEQ + 8 * (cpos ^ ((row >> 1) & 7)); }
    const unsigned kob = (unsigned)koff * 2u, vob0 = (unsigned)voff0 * 2u, vob1 = (unsigned)voff1 * 2u;
    const unsigned kdst = lds0 + wid * 1024, vdst = lds0 + A2_OFF_V + wid * 2048;
    const bf16* Vh = A.VT + (size_t)h * 128 * SEQ;
    const bf16* Kh = A.K + (h * 2 + mp) * 64;
    const bf16* Qw = A.Q + (size_t)(q0 + wid * QBLK + r32) * LDQ + (h * 2 + mp) * 64 + hi * 8;
    const AT_LAS char* ksl = lds + r32 * 128;
    const int kswz = ((r32 >> 1) & 7) << 4;
    const AT_LAS char* vsl = lds + A2_OFF_V + r32 * 128;
#define A2_DMAK(t, s) glds16s(Kh + (size_t)(t) * TS, kob, (unsigned)__builtin_amdgcn_readfirstlane(kdst + (s) * A2_KB))
#define A2_DMAV(t, s) do { glds16s(Vh + (size_t)(t) * KVBLK, vob0, (unsigned)__builtin_amdgcn_readfirstlane(vdst + (s) * A2_VB)); glds16s(Vh + (size_t)(t) * KVBLK, vob1, (unsigned)__builtin_amdgcn_readfirstlane(vdst + (s) * A2_VB + 1024u)); } while (0)
#define A2_KRD(g, s) (*(const AT_LAS bf16x8*)(ksl + (s) * A2_KB + ((g) & 1) * 4096 + ((((g) >> 1) * 32 + hi * 16) ^ kswz)))
#define A2_VRD(m, s) do { vf[(m) % A2_NVF] = *(const AT_LAS bf16x8*)(vsl + (s) * A2_VB + ((m) & 3) * 4096 + ((((m) >> 2) * 32 + hi * 16) ^ kswz)); } while (0)
#define A2_VFR(m) vf[(m) % A2_NVF]
    __syncthreads();
    A2_DMAK(0, 0); A2_DMAK(1, 1);
    bf16x8 qr[4];
#pragma unroll
    for (int d0 = 0; d0 < 4; ++d0) qr[d0] = *(const __attribute__((address_space(1))) bf16x8*)(Qw + d0 * 16);
    float qss = 0.f;
#pragma unroll
    for (int d0 = 0; d0 < 4; ++d0)
#pragma unroll
      for (int e = 0; e < 8; ++e) { const float v = __uint_as_float(((unsigned)(unsigned short)qr[d0][e]) << 16); qss += v * v; }
    { auto rr = __builtin_amdgcn_permlane32_swap(__float_as_uint(qss), __float_as_uint(qss), false, false); qss = __uint_as_float(rr[0]) + __uint_as_float(rr[1]); }
    const float mref = sqrtf(qss) * A.kmax[h * 2 + mp] * 1.01f + 0.25f;
    f32x16 negm;
#pragma unroll
    for (int r = 0; r < 16; ++r) negm[r] = -mref;
    float l_reg = 0.f; f32x16 o[4]; o[0] = f32x16{}; o[1] = f32x16{}; o[2] = f32x16{}; o[3] = f32x16{};
    f32x16 cA0, cA1, cB0, cB1; bf16x8 pa[4]; bf16x8 kf[8]; bf16x8 vf[A2_NVF];
    if (VAR) { cA0 = negm; cA1 = negm; cB0 = negm; cB1 = negm; _Pragma("unroll") for (int i_ = 0; i_ < 4; ++i_) { pa[i_] = qr[i_]; vf[i_] = qr[i_]; } }
    AT_WAIT_BAR(0);
#pragma unroll
    for (int g = 0; g < 8; ++g) kf[g] = A2_KRD(g, 0);
    asm volatile("s_waitcnt lgkmcnt(0)\n\ts_barrier" ::: "memory");
#define A2_GA(g, N0, N1, P0, P1, DOQK, DOPREV, VS) do { \
    if ((DOQK) && !(VAR & 8)) { if ((g) & 1) N1 = __builtin_amdgcn_mfma_f32_32x32x16_bf16(kf[g], qr[(g) >> 1], (g) < 2 ? negm : N1, 0, 0, 0); \
                else         N0 = __builtin_amdgcn_mfma_f32_32x32x16_bf16(kf[g], qr[(g) >> 1], (g) < 2 ? negm : N0, 0, 0, 0); } \
    if ((DOPREV) && !(VAR & 128)) { \
        \
      if (((g) & 1) == 0) { pk0 = (g) < 4 ? cvtpk(P0[((g) & 2) * 4 + 0], P0[((g) & 2) * 4 + 1]) : cvtpk(P1[((g) & 2) * 4 + 0], P1[((g) & 2) * 4 + 1]); \
                            pk1 = (g) < 4 ? cvtpk(P0[((g) & 2) * 4 + 2], P0[((g) & 2) * 4 + 3]) : cvtpk(P1[((g) & 2) * 4 + 2], P1[((g) & 2) * 4 + 3]); } \
      else { const unsigned a1_ = (g) < 4 ? cvtpk(P0[((g) & 2) * 4 + 4], P0[((g) & 2) * 4 + 5]) : cvtpk(P1[((g) & 2) * 4 + 4], P1[((g) & 2) * 4 + 5]); \
             const unsigned b1_ = (g) < 4 ? cvtpk(P0[((g) & 2) * 4 + 6], P0[((g) & 2) * 4 + 7]) : cvtpk(P1[((g) & 2) * 4 + 6], P1[((g) & 2) * 4 + 7]); \
             const u32x4 w_ = {pk0, pk1, a1_, b1_}; pa[(g) >> 1] = __builtin_bit_cast(bf16x8, w_); } \
      } if ((DOPREV) && !(VAR & 4) && (g) >= 8 - A2_NVF) { A2_VRD((g) - (8 - A2_NVF), VS); } \
    A2_SBAR(); } while (0)
#define A2_GB(m, N0, N1, DOPREV, DOEXP, DOK, VS, KS) do { \
    if (DOPREV) { if (!(VAR & 2)) o[(m) & 3] = __builtin_amdgcn_mfma_f32_32x32x16_bf16(pa[(m) >> 2], A2_VFR(m), o[(m) & 3], 0, 0, 0); if (!(VAR & 4) && (m) + A2_NVF < 16) A2_VRD((m) + A2_NVF, VS); } \
    if ((DOEXP) && !(VAR & 1)) { if ((m) < 8) { N0[2 * (m)] = __builtin_amdgcn_exp2f(N0[2 * (m)]); N0[2 * (m) + 1] = __builtin_amdgcn_exp2f(N0[2 * (m) + 1]); l_reg += N0[2 * (m)]; l_reg += N0[2 * (m) + 1]; } \
                 else { N1[2 * (m) - 16] = __builtin_amdgcn_exp2f(N1[2 * (m) - 16]); N1[2 * (m) - 15] = __builtin_amdgcn_exp2f(N1[2 * (m) - 15]); l_reg += N1[2 * (m) - 16]; l_reg += N1[2 * (m) - 15]; } } \
    if ((DOK) && !(VAR & 64) && (m) >= 4 && (m) < 12) kf[(m) - 4] = A2_KRD((m) - 4, KS); \
    A2_SBAR(); } while (0)
#define A2_STEP(t, PAR, N0, N1, P0, P1, DOQK, DOPREV, DOEXP) do { unsigned pk0 = 0u, pk1 = 0u; \
    A2_GA(0, N0, N1, P0, P1, DOQK, DOPREV, (PAR) ^ 1); A2_GA(1, N0, N1, P0, P1, DOQK, DOPREV, (PAR) ^ 1); A2_GA(2, N0, N1, P0, P1, DOQK, DOPREV, (PAR) ^ 1); A2_GA(3, N0, N1, P0, P1, DOQK, DOPREV, (PAR) ^ 1); \
    A2_GA(4, N0, N1, P0, P1, DOQK, DOPREV, (PAR) ^ 1); A2_GA(5, N0, N1, P0, P1, DOQK, DOPREV, (PAR) ^ 1); A2_GA(6, N0, N1, P0, P1, DOQK, DOPREV, (PAR) ^ 1); A2_GA(7, N0, N1, P0, P1, DOQK, DOPREV, (PAR) ^ 1); \
    if (!(VAR & 16)) { if ((t) + 2 < NT) glds3(Kh + (size_t)((t) + 2) * TS, kob, (unsigned)__builtin_amdgcn_readfirstlane(kdst + (PAR) * A2_KB), Vh + (size_t)(t) * KVBLK, vob0, vob1, (unsigned)__builtin_amdgcn_readfirstlane(vdst + (PAR) * A2_VB)); \
                       else if ((t) < NT) A2_DMAV((t), PAR); } A2_SBAR(); \
    const bool dok_ = (t) + 1 < NT; \
    A2_GB(0, N0, N1, DOPREV, DOEXP, dok_, (PAR) ^ 1, (PAR) ^ 1); A2_GB(1, N0, N1, DOPREV, DOEXP, dok_, (PAR) ^ 1, (PAR) ^ 1); A2_GB(2, N0, N1, DOPREV, DOEXP, dok_, (PAR) ^ 1, (PAR) ^ 1); A2_GB(3, N0, N1, DOPREV, DOEXP, dok_, (PAR) ^ 1, (PAR) ^ 1); \
    A2_GB(4, N0, N1, DOPREV, DOEXP, dok_, (PAR) ^ 1, (PAR) ^ 1); A2_GB(5, N0, N1, DOPREV, DOEXP, dok_, (PAR) ^ 1, (PAR) ^ 1); A2_GB(6, N0, N1, DOPREV, DOEXP, dok_, (PAR) ^ 1, (PAR) ^ 1); A2_GB(7, N0, N1, DOPREV, DOEXP, dok_, (PAR) ^ 1, (PAR) ^ 1); \
    A2_GB(8, N0, N1, DOPREV, DOEXP, dok_, (PAR) ^ 1, (PAR) ^ 1); A2_GB(9, N0, N1, DOPREV, DOEXP, dok_, (PAR) ^ 1, (PAR) ^ 1); A2_GB(10, N0, N1, DOPREV, DOEXP, dok_, (PAR) ^ 1, (PAR) ^ 1); A2_GB(11, N0, N1, DOPREV, DOEXP, dok_, (PAR) ^ 1, (PAR) ^ 1); \
    A2_GB(12, N0, N1, DOPREV, DOEXP, dok_, (PAR) ^ 1, (PAR) ^ 1); A2_GB(13, N0, N1, DOPREV, DOEXP, dok_, (PAR) ^ 1, (PAR) ^ 1); A2_GB(14, N0, N1, DOPREV, DOEXP, dok_, (PAR) ^ 1, (PAR) ^ 1); A2_GB(15, N0, N1, DOPREV, DOEXP, dok_, (PAR) ^ 1, (PAR) ^ 1); \
    if (VAR & 32) asm volatile("s_waitcnt lgkmcnt(0)" ::: "memory"); else AT_WAIT_BAR(0); } while (0)
    if (A2_PRIO && wid >= 4) __builtin_amdgcn_s_setprio(1);
    A2_STEP(0, 0, cA0, cA1, cB0, cB1, true, false, true);
    for (int t = 1; t + 1 < NT; t += 2) {
      A2_STEP(t, 1, cB0, cB1, cA0, cA1, true, true, true);
      A2_STEP(t + 1, 0, cA0, cA1, cB0, cB1, true, true, true);
    }
    A2_STEP(NT - 1, 1, cB0, cB1, cA0, cA1, true, true, true);
    A2_STEP(NT, 0, cA0, cA1, cB0, cB1, false, true, false);
    if (A2_PRIO) __builtin_amdgcn_s_setprio(0);
#undef A2_STEP
#undef A2_GB
#undef A2_GA
#undef A2_VFR
#undef A2_VRD
#undef A2_KRD
#undef A2_DMAV
#undef A2_DMAK
    { auto rr = __builtin_amdgcn_permlane32_swap(__float_as_uint(l_reg), __float_as_uint(l_reg), false, false); l_reg = __uint_as_float(rr[0]) + __uint_as_float(rr[1]); }
    if (hi == 0) li_l[r32] = l_reg; asm volatile("s_waitcnt lgkmcnt(0)" ::: "memory");
    int r32e = r32, hie = hi; asm volatile("" : "+v"(r32e), "+v"(hie));
    const unsigned ebase = (unsigned)((q0 + wid * QBLK + 4 * hie) * 1024 + h * 128 + r32e);
    if (mp == 0) {
#pragma unroll
      for (int r = 0; r < 16; ++r) { __attribute__((address_space(1))) float* op = (__attribute__((address_space(1))) float*)A.AO1 + (ebase + (unsigned)(((r & 3) + 8 * (r >> 2)) * 1024)); const float rl = __builtin_amdgcn_rcpf(li_l[crow(r, hi)]);
#pragma unroll
        for (int d0 = 0; d0 < 4; ++d0) op[d0 * 32] = o[d0][r] * rl;
        if ((r & 3) == 3) asm volatile("" ::: "memory"); }
    } else {
      float sg[4];
#pragma unroll
      for (int d0 = 0; d0 < 4; ++d0) sg[d0] = A.subg[d0 * 32 + r32e] * A.outscale;
#pragma unroll
      for (int r = 0; r < 16; ++r) { const unsigned eo = ebase + (unsigned)(((r & 3) + 8 * (r >> 2)) * 1024); const __attribute__((address_space(1))) float* ip = (const __attribute__((address_space(1))) float*)A.AO1 + eo; const float rl = __builtin_amdgcn_rcpf(li_l[crow(r, hi)]) * A.lam;
        float v[4]; float ss = 0.f;
#pragma unroll
        for (int d0 = 0; d0 < 4; ++d0) { v[d0] = ip[d0 * 32] - o[d0][r] * rl; ss += v[d0] * v[d0]; }
#pragma unroll
        for (int off = 1; off < 32; off <<= 1) ss += shx(ss, off, lane);
        const float rs = rsqrtf(ss * (1.0f / 128.0f) + 1e-6f);
        __attribute__((address_space(1))) bf16* mp_ = (__attribute__((address_space(1))) bf16*)A.MIX + (eo + (eo & ~1023u));
#pragma unroll
        for (int d0 = 0; d0 < 4; ++d0) mp_[d0 * 32] = (bf16)(pg8::cvt_pk_bf16(v[d0] * rs * sg[d0], 0.f) & 0xffffu);
        if ((r & 3) == 3) asm volatile("" ::: "memory"); }
    }
  }
}
#undef A2_SBAR
}

namespace hg {
using bf16 = unsigned short;
using bf16x8 = __attribute__((ext_vector_type(8))) short;
using f32x16 = __attribute__((ext_vector_type(16))) float;
using u32x4  = __attribute__((ext_vector_type(4))) unsigned;
using u32x2  = __attribute__((ext_vector_type(2))) unsigned;
#define HG_LAS __attribute__((address_space(3)))
constexpr int P128 = 136, P64 = 72;
constexpr int L_QT = 0, L_KT = L_QT + 64 * P128 * 2, L_QB = L_KT + 64 * P128 * 2, L_KH = L_QB + 64 * P128 * 2, L_VT = L_KH + 128 * P64 * 2,
              L_ST = L_VT + 128 * P64 * 2, L_AM = L_ST + 128 * P128 * 2, L_EB = L_AM + 64 * P64 * 2, L_PS = L_EB + 512, L_SSQ = L_PS + 2048, LDS_BYTES = L_SSQ + 1024;
constexpr int SCT = 512, NSC = 32;
__device__ __forceinline__ int crow(int r, int hi) { return (r & 3) + 8 * (r >> 2) + 4 * hi; }
typedef float f32x2_t __attribute__((ext_vector_type(2))); typedef __bf16 bf16x2_t __attribute__((ext_vector_type(2)));
__device__ __forceinline__ unsigned cvtpk(float lo, float hi) { f32x2_t v = {lo, hi}; bf16x2_t b = __builtin_convertvector(v, bf16x2_t); return __builtin_bit_cast(unsigned, b); }
__device__ __forceinline__ float bf2f(unsigned short b) { return __uint_as_float((unsigned)b << 16); }
template <int CTRL> __device__ __forceinline__ float dppf(float v) { return __int_as_float(__builtin_amdgcn_update_dpp(0, __float_as_int(v), CTRL, 0xf, 0xf, true)); }
#define HG_EXP(x) ((VAR & 2) ? (x) : __expf(x))
#define HG_BAR() do { asm volatile("s_waitcnt lgkmcnt(0)" ::: "memory"); __builtin_amdgcn_s_barrier(); asm volatile("" ::: "memory"); } while (0)

struct HgArgs { const bf16* HQ; const bf16* KK; const unsigned short* LF; const bf16* HV; const bf16* HGt; float* HS; float* GS; float* HOF; bf16* MIX; const float* gn; };

template <bool OUT, int VAR = 0>
__device__ __forceinline__ void hgrn_unit(const HgArgs& A, int dir, int h, int sc, HG_LAS unsigned char* lds, const int tid) {
  const int lane = tid & 63, r32 = lane & 31, hi = lane >> 5; const int wid = __builtin_amdgcn_readfirstlane(tid >> 6);
  const int d = tid & 127, qt = tid >> 7;
  typedef __attribute__((address_space(1))) const unsigned short gcus; typedef __attribute__((address_space(1))) float gfl; typedef __attribute__((address_space(1))) unsigned short gus;
  gcus* gLF = (gcus*)A.LF; gcus* gKK = (gcus*)A.KK; gcus* gHV = (gcus*)A.HV; gcus* gHQ = (gcus*)A.HQ; gcus* gHG = (gcus*)A.HGt; gus* gHOF = (gus*)A.HOF;     gus* gMIX = (gus*)A.MIX; gfl* gHS = (gfl*)A.HS; gfl* gGS = (gfl*)A.GS;
  HG_LAS bf16* QT = (HG_LAS bf16*)(lds + L_QT); HG_LAS bf16* KT = (HG_LAS bf16*)(lds + L_KT); HG_LAS bf16* QB = (HG_LAS bf16*)(lds + L_QB);
  HG_LAS bf16* KH = (HG_LAS bf16*)(lds + L_KH); HG_LAS bf16* VT = (HG_LAS bf16*)(lds + L_VT); HG_LAS bf16* ST = (HG_LAS bf16*)(lds + L_ST);
  HG_LAS bf16* AM = (HG_LAS bf16*)(lds + L_AM); HG_LAS float* EB = (HG_LAS float*)(lds + L_EB); HG_LAS float* PS = (HG_LAS float*)(lds + L_PS);
  HG_LAS float* SSQ = (HG_LAS float*)(lds + L_SSQ);
  const int db = wid >> 1, eb0 = (wid & 1) * 2;
  const int jb = wid & 1, eb = wid >> 1;
  const size_t unit = (size_t)(dir * 8 + h) * NSC + sc;
  gfl* HSu = gHS + unit * 16384;
  f32x16 S0, S1;
  if (OUT) {
#pragma unroll
    for (int r = 0; r < 16; ++r) { const gfl* p = HSu + (32 * db + crow(r, hi)) * 128 + 32 * eb0 + r32; S0[r] = p[0]; S1[r] = p[32]; }
#pragma unroll
    for (int rg = 0; rg < 4; ++rg) { u32x2 w0, w1; w0.x = cvtpk(S0[4 * rg], S0[4 * rg + 1]); w0.y = cvtpk(S0[4 * rg + 2], S0[4 * rg + 3]); w1.x = cvtpk(S1[4 * rg], S1[4 * rg + 1]); w1.y = cvtpk(S1[4 * rg + 2], S1[4 * rg + 3]);
      *(HG_LAS u32x2*)(ST + (32 * eb0 + r32) * P128 + 32 * db + 8 * rg + 4 * hi) = w0; *(HG_LAS u32x2*)(ST + (32 * (eb0 + 1) + r32) * P128 + 32 * db + 8 * rg + 4 * hi) = w1; }
  } else { S0 = f32x16{}; S1 = f32x16{}; }
  float gtot = 0.f;
  const float gnv = (OUT && dir != 0) ? ((__attribute__((address_space(1))) const float*)A.gn)[32 * eb + r32] : 0.f;
  const int cofs = h * 128 + d;
  unsigned short rl[16]; unsigned short kkv[16], qv[16], vv[16];
#define HG_LOAD(cc) do { _Pragma("unroll") for (int jj = 0; jj < 16; ++jj) { const int p = (cc) * 64 + qt * 16 + jj; const size_t tok = (size_t)(dir ? sc * SCT + (SCT - 1) - p : sc * SCT + p); \
      rl[jj] = gLF[tok * 2048 + dir * 1024 + cofs]; kkv[jj] = gKK[tok * 2048 + dir * 1024 + cofs]; vv[jj] = gHV[tok * 1024 + cofs]; \
      if (OUT) qv[jj] = gHQ[tok * 1024 + cofs]; } } while (0)
  HG_LOAD(0);
#pragma unroll 1
  for (int c = 0; c < 8; ++c) {
    float lf[16]; unsigned short hofv[16]; unsigned short hgv[16];
    float run = 0.f;
#pragma unroll
    for (int jj = 0; jj < 16; ++jj) { run += (float)__builtin_bit_cast(_Float16, rl[jj]); lf[jj] = run; }
    PS[qt * 128 + d] = run;
    HG_BAR();
    const float p0 = PS[d], p1 = PS[128 + d], p2 = PS[256 + d], p3 = PS[384 + d];
    const float off = qt == 0 ? 0.f : qt == 1 ? p0 : qt == 2 ? p0 + p1 : p0 + p1 + p2;
    const float b63 = (p0 + p1) + (p2 + p3), rmid = p0 + p1;
    gtot += b63;
    if (qt == 0) EB[d] = HG_EXP(b63);
    unsigned kh[8];
#pragma unroll
    for (int jj = 0; jj < 16; jj += 2) {
      const float b0 = off + lf[jj], b1 = off + lf[jj + 1]; const float k0 = bf2f(kkv[jj]), k1 = bf2f(kkv[jj + 1]);
      kh[jj >> 1] = cvtpk(k0 * HG_EXP(b63 - b0), k1 * HG_EXP(b63 - b1));
      if (OUT) { const float q0 = bf2f(qv[jj]), q1 = bf2f(qv[jj + 1]);
        const unsigned qt_ = cvtpk(q0 * HG_EXP(b0 - rmid), q1 * HG_EXP(b1 - rmid)), kt_ = cvtpk(k0 * HG_EXP(rmid - b0), k1 * HG_EXP(rmid - b1)), qb_ = cvtpk(q0 * HG_EXP(b0), q1 * HG_EXP(b1));
        const int j0 = qt * 16 + jj;
        if (!(VAR & 1)) {
          const unsigned xq = (unsigned)__builtin_amdgcn_update_dpp(0, (int)qt_, 0xB1, 0xf, 0xf, true), xk = (unsigned)__builtin_amdgcn_update_dpp(0, (int)kt_, 0xB1, 0xf, 0xf, true), xb = (unsigned)__builtin_amdgcn_update_dpp(0, (int)qb_, 0xB1, 0xf, 0xf, true);
          const bool odd = d & 1; const int wofs = (odd ? (j0 + 1) * P128 + d - 1 : j0 * P128 + d);
          *(HG_LAS unsigned*)(QT + wofs) = odd ? ((xq >> 16) | (qt_ & 0xffff0000u)) : ((qt_ & 0xffffu) | (xq << 16));
          *(HG_LAS unsigned*)(KT + wofs) = odd ? ((xk >> 16) | (kt_ & 0xffff0000u)) : ((kt_ & 0xffffu) | (xk << 16));
          *(HG_LAS unsigned*)(QB + wofs) = odd ? ((xb >> 16) | (qb_ & 0xffff0000u)) : ((qb_ & 0xffffu) | (xb << 16)); } }
    }
    *(HG_LAS u32x4*)(KH + d * P64 + qt * 16) = (u32x4){kh[0], kh[1], kh[2], kh[3]}; *(HG_LAS u32x4*)(KH + d * P64 + qt * 16 + 8) = (u32x4){kh[4], kh[5], kh[6], kh[7]};
    { u32x4 w0, w1;
      w0.x = (unsigned)vv[0] | ((unsigned)vv[1] << 16); w0.y = (unsigned)vv[2] | ((unsigned)vv[3] << 16); w0.z = (unsigned)vv[4] | ((unsigned)vv[5] << 16); w0.w = (unsigned)vv[6] | ((unsigned)vv[7] << 16);
      w1.x = (unsigned)vv[8] | ((unsigned)vv[9] << 16); w1.y = (unsigned)vv[10] | ((unsigned)vv[11] << 16); w1.z = (unsigned)vv[12] | ((unsigned)vv[13] << 16); w1.w = (unsigned)vv[14] | ((unsigned)vv[15] << 16);
      *(HG_LAS u32x4*)(VT + d * P64 + qt * 16) = w0; *(HG_LAS u32x4*)(VT + d * P64 + qt * 16 + 8) = w1; }
    if (OUT && dir != 0) {
#pragma unroll
      for (int r = 0; r < 16; ++r) { const int p = c * 64 + 32 * jb + crow(r, hi); const size_t tok = (size_t)(sc * SCT + (SCT - 1) - p);
        hofv[r] = gHOF[tok * 1024 + h * 128 + 32 * eb + r32]; hgv[r] = gHG[tok * 1024 + h * 128 + 32 * eb + r32]; } }
    if (!(VAR & 16) && c + 1 < 8) HG_LOAD(c + 1);
    HG_BAR();
    f32x16 oacc = f32x16{};
    if (OUT) {
      if (!(VAR & 4)) {
#pragma unroll
      for (int ks = 0; ks < 8; ++ks) { const bf16x8 a = *(const HG_LAS bf16x8*)(QB + (32 * jb + r32) * P128 + 16 * ks + 8 * hi), b = *(const HG_LAS bf16x8*)(ST + (32 * eb + r32) * P128 + 16 * ks + 8 * hi);
        oacc = __builtin_amdgcn_mfma_f32_32x32x16_bf16(a, b, oacc, 0, 0, 0); }
      if (wid < 4) { const int jb2 = wid & 1, sb = wid >> 1;
        if (sb <= jb2) { f32x16 aacc = f32x16{};
#pragma unroll
          for (int ks = 0; ks < 8; ++ks) { const bf16x8 a = *(const HG_LAS bf16x8*)(QT + (32 * jb2 + r32) * P128 + 16 * ks + 8 * hi), b = *(const HG_LAS bf16x8*)(KT + (32 * sb + r32) * P128 + 16 * ks + 8 * hi);
            aacc = __builtin_amdgcn_mfma_f32_32x32x16_bf16(a, b, aacc, 0, 0, 0); }
#pragma unroll
          for (int r = 0; r < 16; ++r) { const int j = 32 * jb2 + crow(r, hi), s = 32 * sb + r32; AM[j * P64 + s] = (bf16)(cvtpk(s <= j ? aacc[r] : 0.f, 0.f) & 0xffffu); }
        } else {
#pragma unroll
          for (int r = 0; r < 16; ++r) AM[(32 * jb2 + crow(r, hi)) * P64 + 32 * sb + r32] = (bf16)0;
        }
      }
      }
      HG_BAR();
      if (!(VAR & 4))
#pragma unroll
      for (int ks = 0; ks < 4; ++ks) { const bf16x8 a = *(const HG_LAS bf16x8*)(AM + (32 * jb + r32) * P64 + 16 * ks + 8 * hi), b = *(const HG_LAS bf16x8*)(VT + (32 * eb + r32) * P64 + 16 * ks + 8 * hi);
        oacc = __builtin_amdgcn_mfma_f32_32x32x16_bf16(a, b, oacc, 0, 0, 0); }
    }
    if (!(VAR & 8)) {
#pragma unroll
    for (int r = 0; r < 16; ++r) { const float g = EB[32 * db + crow(r, hi)]; S0[r] *= g; S1[r] *= g; }
#pragma unroll
    for (int ks = 0; ks < 4; ++ks) { const bf16x8 a = *(const HG_LAS bf16x8*)(KH + (32 * db + r32) * P64 + 16 * ks + 8 * hi);
      const bf16x8 b0 = *(const HG_LAS bf16x8*)(VT + (32 * eb0 + r32) * P64 + 16 * ks + 8 * hi), b1 = *(const HG_LAS bf16x8*)(VT + (32 * (eb0 + 1) + r32) * P64 + 16 * ks + 8 * hi);
      S0 = __builtin_amdgcn_mfma_f32_32x32x16_bf16(a, b0, S0, 0, 0, 0); S1 = __builtin_amdgcn_mfma_f32_32x32x16_bf16(a, b1, S1, 0, 0, 0); }
    }
    if (OUT) {
      if (!(VAR & 8))
#pragma unroll
      for (int rg = 0; rg < 4; ++rg) { u32x2 w0, w1; w0.x = cvtpk(S0[4 * rg], S0[4 * rg + 1]); w0.y = cvtpk(S0[4 * rg + 2], S0[4 * rg + 3]); w1.x = cvtpk(S1[4 * rg], S1[4 * rg + 1]); w1.y = cvtpk(S1[4 * rg + 2], S1[4 * rg + 3]);
        *(HG_LAS u32x2*)(ST + (32 * eb0 + r32) * P128 + 32 * db + 8 * rg + 4 * hi) = w0; *(HG_LAS u32x2*)(ST + (32 * (eb0 + 1) + r32) * P128 + 32 * db + 8 * rg + 4 * hi) = w1; }
      const int ecol = h * 128 + 32 * eb + r32;
      if (VAR & 32) { if (oacc[0] == 123.456f) gHOF[ecol] = (bf16)1; }
      else if (dir == 0) {
#pragma unroll
        for (int r = 0; r < 16; ++r) { const int p = c * 64 + 32 * jb + crow(r, hi); gHOF[(size_t)(sc * SCT + p) * 1024 + ecol] = (bf16)(cvtpk(oacc[r], 0.f) & 0xffffu); }
      } else {
        float tot[16];
#pragma unroll
        for (int r = 0; r < 16; ++r) { const int p = c * 64 + 32 * jb + crow(r, hi); const size_t tok = (size_t)(sc * SCT + (SCT - 1) - p);
          tot[r] = oacc[r] + bf2f(hofv[r]); float ss = tot[r] * tot[r];
          ss += dppf<0xB1>(ss); ss += dppf<0x4E>(ss); ss += dppf<0x141>(ss); ss += dppf<0x140>(ss);
          ss += shx(ss, 16, lane);
          if (r32 == 0) SSQ[(32 * jb + crow(r, hi)) * 4 + eb] = ss; }
        HG_BAR();
#pragma unroll
        for (int r = 0; r < 16; ++r) { const int j = 32 * jb + crow(r, hi); const int p = c * 64 + j; const size_t tok = (size_t)(sc * SCT + (SCT - 1) - p);
          const float ssum = (SSQ[j * 4] + SSQ[j * 4 + 1]) + (SSQ[j * 4 + 2] + SSQ[j * 4 + 3]);
          const float rs = rsqrtf(ssum * (1.0f / 128.0f) + 1e-6f);
          const float g = bf2f(hgv[r]);
          gMIX[tok * 2048 + 1024 + ecol] = (bf16)(cvtpk(tot[r] * rs * gnv * g, 0.f) & 0xffffu); }
      }
    }
  }
  if (!OUT) {
#pragma unroll
    for (int r = 0; r < 16; ++r) { gfl* p = HSu + (32 * db + crow(r, hi)) * 128 + 32 * eb0 + r32; p[0] = S0[r]; p[32] = S1[r]; }
    if (qt == 0) gGS[unit * 128 + d] = gtot;
  }
  HG_BAR();
}

__device__ __forceinline__ void hgrn_scan(float* HS, const float* GS, int gtid, int nthr) {
  for (int p = gtid; p < 16 * 16384; p += nthr) { const int dh = p >> 14, idx = p & 16383, dd = idx >> 7, dir = dh >> 3;
    float* base = HS + (size_t)dh * NSC * 16384 + idx; const float* g = GS + dh * NSC * 128 + dd;
    float v[NSC], ge[NSC];
#pragma unroll
    for (int k = 0; k < NSC; ++k) { const int s = dir ? NSC - 1 - k : k; v[k] = base[(size_t)s * 16384]; ge[k] = g[s * 128]; }
    float carry = 0.f;
#pragma unroll
    for (int k = 0; k < NSC; ++k) { const int s = dir ? NSC - 1 - k : k; base[(size_t)s * 16384] = carry; carry = __expf(ge[k]) * carry + v[k]; }
  }
}
#undef HG_BAR
#undef HG_LOAD
}

constexpr int NWAVES = 8;
#ifndef MK_PER_PHASE
#define MK_PER_PHASE 0
#endif
#ifndef CVT_HOST
#define CVT_HOST 1
#endif
constexpr int T = 16384, DM = 2048, NL = 4, INC = 8192, NE = 16, CAP = 2048, FF = 1024, XR = NE * CAP;
constexpr float EPS = 1e-6f;
constexpr float QSCALE = 0.125f * 1.4426950408889634f;
constexpr size_t MiB = 1u << 20;
constexpr size_t WS_CTL = 0, CTL_ZERO_BYTES = 32 * 1024;
constexpr size_t WS_ROPE = 1 * MiB, WS_LBS = 5 * MiB, WS_AFF = 6 * MiB, WS_SLOT = 7 * MiB, WS_IDX = 8 * MiB, WS_GATE = 8 * MiB + 512 * 1024, WS_GS = 9 * MiB, WS_PAR = 10 * MiB;
constexpr int PAR_N1 = 0, PAR_N2 = PAR_N1 + NL * DM, PAR_FG = PAR_N2 + NL * DM, PAR_DLAM = PAR_FG + DM, PAR_SUBG = PAR_DLAM + NL * 256, PAR_HGN = PAR_SUBG + NL * 128, PAR_RW = PAR_HGN + NL * 128, PAR_END = PAR_RW + NL * DM * NE;
constexpr size_t WS_WIN = 16 * MiB, WS_WOUT = 144 * MiB, WS_WGU = 176 * MiB, WS_WDN = 688 * MiB;
constexpr size_t WS_X = 944 * MiB, WS_MIX = 1264 * MiB;
constexpr int RW_PITCH = 2056, RW_IMG = 2 * NE * RW_PITCH * 2;
constexpr size_t WS_RWS = 12 * MiB;
constexpr size_t WS_RS1 = 11 * MiB, WS_RS2 = 11 * MiB + 64 * 1024, WS_RSG = 11 * MiB + 128 * 1024;
constexpr size_t WS_Q = 1328 * MiB, WS_K = 1360 * MiB, WS_V = 1392 * MiB, WS_HQ = 1424 * MiB, WS_LF = 1456 * MiB, WS_KK = 1584 * MiB, WS_HV = 1648 * MiB, WS_HG = 1680 * MiB,
                 WS_AO1 = 1712 * MiB, WS_HS = 1776 * MiB, WS_HOF = 1808 * MiB;
constexpr size_t WS_VT = 1072 * MiB;
constexpr size_t WS_XG = 1328 * MiB, WS_HM = 1456 * MiB, WS_Y = 1520 * MiB;
constexpr size_t WS_END = 1872 * MiB;
constexpr int CW_BAR = 4096, CW_KMAX = 2048, CW_SCAN = 3072;
constexpr int RING_BYTES = 131072, LDS_BYTES = 147456, MISC_OFF = LDS_BYTES - 512;
static_assert(hg::LDS_BYTES <= MISC_OFF && att::LDS_BYTES2 <= RING_BYTES, "LDS map");

#define GAS __attribute__((address_space(1)))
#define LAS __attribute__((address_space(3)))
typedef unsigned short bf16;
typedef unsigned v4u __attribute__((ext_vector_type(4)));
typedef unsigned v2u __attribute__((ext_vector_type(2)));
typedef float f32x4 __attribute__((ext_vector_type(4)));
typedef GAS unsigned gu32;
#define RLX_AGENT __ATOMIC_RELAXED, __HIP_MEMORY_SCOPE_AGENT
#define LDS_WAIT() asm volatile("s_waitcnt lgkmcnt(0)" ::: "memory")
#define VM_WAIT() asm volatile("s_waitcnt vmcnt(0)" ::: "memory")
__device__ __forceinline__ unsigned pk2(float lo, float hi) { return pg8::cvt_pk_bf16(lo, hi); }
__device__ __forceinline__ float bf2f(unsigned short b) { return __uint_as_float((unsigned)b << 16); }

#define XB_TMO      128
#define XB_XCNT(j)  (256  + 64 * (j))
#define XB_XSUB(j)  (1280 + 64 * (j))
#define XB_XGEN(j)  (2304 + 64 * (j))
#define XB_TOP      3328
#define XB_TOPGEN   3392
#define XCD_BAR_WORDS 3456
#define XB_SPIN_CAP (1u << 18)

__device__ __forceinline__ unsigned xb_ld(unsigned* p)              { return __hip_atomic_load(p, __ATOMIC_RELAXED, __HIP_MEMORY_SCOPE_AGENT); }
__device__ __forceinline__ unsigned xb_add(unsigned* p, unsigned v) { return __hip_atomic_fetch_add(p, v, __ATOMIC_RELAXED, __HIP_MEMORY_SCOPE_AGENT); }
__device__ __forceinline__ unsigned xb_xcc_id() { return (unsigned)__builtin_amdgcn_s_getreg((3 << 11) | 20) & 0xFu; }
#define XB_SPIN(cond, bar) do { unsigned _sp = 0; while (cond) { __builtin_amdgcn_s_sleep(1); \
    if ((++_sp & 255u) == 0u) { if (xb_ld(&(bar)[XB_TMO])) break; if (_sp > XB_SPIN_CAP) { atomicAdd(&(bar)[XB_TMO], 1u); break; } } } } while (0)

__device__ __forceinline__ unsigned xb_lane() { unsigned z = 0u; asm volatile("" : "+s"(z)); return __builtin_amdgcn_mbcnt_hi(~0u, __builtin_amdgcn_mbcnt_lo(~0u, z)); }
struct XcdBarrier {
    int wv;
    unsigned* bar; unsigned x;
    volatile LAS unsigned* st;
};

__device__ __forceinline__ XcdBarrier xcd_barrier_post(unsigned* bar, volatile LAS unsigned* st, int wv) {
    XcdBarrier b; b.bar = bar; b.x = xb_xcc_id(); b.st = st; b.wv = wv;
    if (wv == 0 && xb_lane() == 0u) (void)xb_add(&bar[XB_XCNT(b.x)], 1u);
    return b;
}
__device__ __forceinline__ void xcd_barrier_complete(unsigned* bar, unsigned x, unsigned& nloc, unsigned& nx) {
    const unsigned G = gridDim.x * gridDim.y * gridDim.z;
    unsigned sum, cnt, mine, sp = 0u;
    for (;;) {
        sum = 0u; cnt = 0u; mine = 0u;
#pragma unroll
        for (unsigned j = 0; j < 16; ++j) { const unsigned c = xb_ld(&bar[XB_XCNT(j)]); sum += c; cnt += (c > 0u) ? 1u : 0u; mine = (j == x) ? c : mine; }
        if (sum == G) break;
        __builtin_amdgcn_s_sleep(1);
        if ((++sp & 255u) == 0u) { if (xb_ld(&bar[XB_TMO])) break; if (sp > XB_SPIN_CAP) { atomicAdd(&bar[XB_TMO], 1u); break; } }
    }
    nloc = mine > 0u ? mine : 1u; nx = cnt > 0u ? cnt : 1u;
}

__device__ __forceinline__ void xcd_barrier(const XcdBarrier& b) {
    asm volatile("s_waitcnt vmcnt(0)" ::: "memory");
    __syncthreads();
    if (b.wv == 0 && xb_lane() == 0u) {
        unsigned* bar = b.bar; unsigned bx = b.x; asm volatile("" : "+s"(bar), "+s"(bx));
        __builtin_amdgcn_s_waitcnt(0);
        unsigned nloc = b.st[0], nx = b.st[1];
        if (nloc == 0u) { xcd_barrier_complete(bar, bx, nloc, nx); b.st[0] = nloc; b.st[1] = nx; }
        const unsigned old = xb_add(&bar[XB_XSUB(bx)], 1u);
        const unsigned gen = old / nloc;
        if (old + 1u == (gen + 1u) * nloc) {
            __builtin_amdgcn_fence(__ATOMIC_RELEASE, "agent");
            asm volatile("s_waitcnt vmcnt(0)" ::: "memory");
            const unsigned og = xb_add(&bar[XB_TOP], 1u);
            const unsigned tg = og / nx;
            if (og + 1u == (tg + 1u) * nx) xb_add(&bar[XB_TOPGEN], 1u);
            else XB_SPIN(xb_ld(&bar[XB_TOPGEN]) == tg, bar);
            __builtin_amdgcn_fence(__ATOMIC_ACQUIRE, "agent");
            xb_add(&bar[XB_XGEN(bx)], 1u);
            asm volatile("s_waitcnt vmcnt(0)" ::: "memory");
        } else {
            XB_SPIN(xb_ld(&bar[XB_XGEN(bx)]) == gen, bar);
            __builtin_amdgcn_fence(__ATOMIC_ACQUIRE, "agent");
            asm volatile("s_waitcnt vmcnt(0)" ::: "memory");
        }
    }
    __syncthreads();
}


struct Args {
    const float* x; const int* pos; const float* norm1_g; const float* w_in; const float* dlam; const float* subg; const float* lblog; const float* hgn;
    const float* w_out; const float* norm2_g; const float* router_w; const float* w_gate; const float* w_up; const float* w_down; const float* final_g;
    float* out; unsigned char* ws; int ph_lo, ph_hi;
};
struct Frame { LAS unsigned char* lds; volatile LAS unsigned* MISC; int tid, lane, wave, vcu, G; };

__device__ __forceinline__ float wave_sum(float v, int lane) {
#pragma unroll
    for (int o = 1; o < 64; o <<= 1) v += shx(v, o, lane);
    return v;
}
__device__ __forceinline__ float wave_max(float v, int lane) {
#pragma unroll
    for (int o = 1; o < 64; o <<= 1) v = fmaxf(v, shx(v, o, lane));
    return v;
}
constexpr int I_IN = 32 * 256, I_OUT = 32 * 64, I_G = 32 * 32, I_D = 16 * 64, PER_LAYER = I_IN + I_OUT + 2 * NE * I_G + NE * I_D;
constexpr int CVT_LDS_OFF = 65536, CVT_SCR = 64 * 33 * 4;
#ifndef CVT_NS
#define CVT_NS 4
#endif
struct CvtItem { const float* src; bf16* dst; const float* gk; int N, K; };
struct CvtSrc { const float* w_in; const float* w_out; const float* w_gate; const float* w_up; const float* w_down; const float* norm1_g; const float* norm2_g; };
constexpr size_t WS_PTAB = 10 * MiB + 768 * 1024;
__device__ __forceinline__ size_t inproj_colmap(int n0);
__device__ __forceinline__ CvtItem cvt_item(const CvtSrc& a, unsigned char* ws, int l, int r) {
    CvtItem c;
    if (r < I_IN) { const int kb = r >> 8, nb = r & 255; c.N = INC; c.K = DM;
        c.src = a.w_in + (size_t)l * DM * INC + (size_t)(kb * 64) * INC + nb * 32; c.dst = (bf16*)(ws + WS_WIN) + (size_t)l * INC * DM + inproj_colmap(nb * 32) * DM + kb * 64; c.gk = a.norm1_g + l * DM + kb * 64; return c; }
    r -= I_IN;
    if (r < I_OUT) { const int kb = r >> 6, nb = r & 63; c.N = DM; c.K = DM;
        c.src = a.w_out + (size_t)l * DM * DM + (size_t)(kb * 64) * DM + nb * 32; c.dst = (bf16*)(ws + WS_WOUT) + (size_t)l * DM * DM + (size_t)(nb * 32) * DM + kb * 64; c.gk = nullptr; return c; }
    r -= I_OUT;
    if (r < 2 * NE * I_G) { const int up = r >= NE * I_G; if (up) r -= NE * I_G; const int le = l * NE + (r >> 10), i = r & 1023, kb = i >> 5, f0 = (i & 31) * 32; c.N = FF; c.K = DM;
        c.src = (up ? a.w_up : a.w_gate) + (size_t)le * DM * FF + (size_t)(kb * 64) * FF + f0; c.dst = (bf16*)(ws + WS_WGU) + (size_t)le * 2048 * DM + (size_t)((f0 >> 7) * 256 + up * 128 + (f0 & 127)) * DM + kb * 64;
        c.gk = a.norm2_g + l * DM + kb * 64; return c; }
    r -= 2 * NE * I_G;
    { const int le = l * NE + (r >> 10), i = r & 1023, kb = i >> 6, nb = i & 63; c.N = DM; c.K = FF;
        c.src = a.w_down + (size_t)le * FF * DM + (size_t)(kb * 64) * DM + nb * 32; c.dst = (bf16*)(ws + WS_WDN) + (size_t)le * DM * FF + (size_t)(nb * 32) * FF + kb * 64; c.gk = nullptr; }
    return c;
}
__device__ __forceinline__ void cvt_load(const CvtItem& c, float (&v)[32], f32x4& g0, f32x4& g1, int lane) {
#pragma unroll
    for (int i = 0; i < 32; ++i) v[i] = __builtin_nontemporal_load((const GAS float*)(c.src + (size_t)(2 * i) * c.N) + ((lane >> 5) * c.N + (lane & 31)));
    g0 = (f32x4){1.f, 1.f, 1.f, 1.f}; g1 = g0;
    if (c.gk) { g0 = *(const GAS f32x4*)(c.gk + 8 * (lane & 7)); g1 = *(const GAS f32x4*)(c.gk + 8 * (lane & 7) + 4); }
}
__device__ __forceinline__ void cvt_process(bf16* dst, int K, float (&v)[32], f32x4& g0, f32x4& g1, const CvtItem& cn, bool hn, LAS float* scr, int lane) {
#pragma unroll
    for (int i = 0; i < 32; ++i) scr[(2 * i + (lane >> 5)) * 33 + (lane & 31)] = v[i];
    const f32x4 h0 = g0, h1 = g1;
    if (hn) cvt_load(cn, v, g0, g1, lane);
    LDS_WAIT(); asm volatile("" ::: "memory");
    const int cc = lane & 7;
#pragma unroll
    for (int j = 0; j < 4; ++j) { const int n = (lane >> 3) + 8 * j; const LAS float* s = scr + (8 * cc) * 33 + n;
        v4u o; o.x = pk2(s[0 * 33] * h0.x, s[1 * 33] * h0.y); o.y = pk2(s[2 * 33] * h0.z, s[3 * 33] * h0.w); o.z = pk2(s[4 * 33] * h1.x, s[5 * 33] * h1.y); o.w = pk2(s[6 * 33] * h1.z, s[7 * 33] * h1.w);
        __builtin_nontemporal_store(o, (GAS v4u*)(dst + (size_t)n * K + 8 * cc)); }
    LDS_WAIT(); asm volatile("" ::: "memory");
}
template <bool FROM_ARGS>
__device__ __forceinline__ void p0_convert(Frame& F, const Args& args, unsigned char* ws_in, int l0, int r0, int count) {
    LAS float* scr = (LAS float*)(F.lds + CVT_LDS_OFF + F.wave * CVT_SCR);
    const int NGW = F.G * NWAVES; int lane = F.lane;
    int v = F.vcu * NWAVES + F.wave; unsigned char* ws = ws_in; asm volatile("" : "+s"(v), "+s"(ws), "+v"(lane));
    if (v >= count) return;
    CvtSrc a;
    if (FROM_ARGS) a = CvtSrc{args.w_in, args.w_out, args.w_gate, args.w_up, args.w_down, args.norm1_g, args.norm2_g};
    else { const int tv = (int)((const GAS unsigned*)(ws + WS_PTAB))[lane & 15];
#define CVT_PTR(i) ((const float*)(((unsigned long long)(unsigned)__builtin_amdgcn_readlane(tv, 2 * (i) + 1) << 32) | (unsigned long long)(unsigned)__builtin_amdgcn_readlane(tv, 2 * (i))))
        a = CvtSrc{CVT_PTR(0), CVT_PTR(1), CVT_PTR(2), CVT_PTR(3), CVT_PTR(4), CVT_PTR(5), CVT_PTR(6)};
#undef CVT_PTR
    }
#define CVT_ITEM(vv) cvt_item(a, ws, (r0 + (vv) >= PER_LAYER) ? l0 + 1 : l0, (r0 + (vv) >= PER_LAYER) ? r0 + (vv) - PER_LAYER : r0 + (vv))
    constexpr int NS = CVT_NS;
    float vv[NS][32]; f32x4 g0[NS], g1[NS]; bf16* dd[NS]; int kk[NS]; bool has[NS];
#pragma unroll
    for (int s_ = 0; s_ < NS; ++s_) { has[s_] = v + s_ * NGW < count; dd[s_] = nullptr; kk[s_] = 0;
        if (has[s_]) { const CvtItem c = CVT_ITEM(v + s_ * NGW); dd[s_] = c.dst; kk[s_] = c.K; cvt_load(c, vv[s_], g0[s_], g1[s_], lane); } }
#pragma unroll 1
    for (bool more = true; more; v += NS * NGW) {
#pragma unroll
        for (int s_ = 0; s_ < NS; ++s_) {
            if (more && has[s_]) {
                const bool hn = v + (s_ + NS) * NGW < count; CvtItem cn{}; if (hn) cn = CVT_ITEM(v + (s_ + NS) * NGW);
                cvt_process(dd[s_], kk[s_], vv[s_], g0[s_], g1[s_], cn, hn, scr, lane); dd[s_] = cn.dst; kk[s_] = cn.K; has[s_] = hn;
            } else more = false;
        }
    }
#undef CVT_ITEM
}
__device__ __forceinline__ void rms_row(const f32x4 (&v)[8], const float* g, bf16* obf, float* of32, int lane) {
    float s = 0.f;
#pragma unroll
    for (int j = 0; j < 8; ++j) s += (v[j].x * v[j].x + v[j].y * v[j].y) + (v[j].z * v[j].z + v[j].w * v[j].w);
    const float rstd = rsqrtf(wave_sum(s, lane) * (1.f / DM) + EPS);
#pragma unroll
    for (int j = 0; j < 8; ++j) { const f32x4 gv = *(const f32x4*)(g + j * 256 + lane * 4); const f32x4 y = v[j] * rstd * gv;
        if (obf) { v2u w; w.x = pk2(y.x, y.y); w.y = pk2(y.z, y.w); *(GAS v2u*)(obf + j * 256 + lane * 4) = w; }
        else *(GAS f32x4*)(of32 + j * 256 + lane * 4) = y; }
}

__device__ __forceinline__ size_t inproj_colmap(int n0) {
    const int seg = n0 >> 10;
    if (seg >= 2) return (size_t)n0;
    const int w = n0 & 1023, hm = w >> 6, half = (w >> 5) & 1;
    return (size_t)(seg * 1024 + (hm >> 2) * 256 + half * 128 + (hm & 3) * 32);
}
__device__ __forceinline__ void p0_prologue(Frame& F, const Args& a, unsigned char* ws) {
    const int gw = F.vcu * NWAVES + F.wave, NGW = F.G * NWAVES;
#if CVT_HOST
    p0_convert<true>(F, a, ws, 0, 0, I_IN);
    if (gw == 0 && F.lane < 7) { const float* pv = F.lane == 0 ? a.w_in : F.lane == 1 ? a.w_out : F.lane == 2 ? a.w_gate : F.lane == 3 ? a.w_up : F.lane == 4 ? a.w_down : F.lane == 5 ? a.norm1_g : a.norm2_g;
        ((GAS unsigned long long*)(ws + WS_PTAB))[F.lane] = (unsigned long long)(uintptr_t)pv; }
#else
    for (int l = 0; l < NL; ++l) p0_convert<true>(F, a, ws, l, 0, PER_LAYER);
#endif
    { float* rope = (float*)(ws + WS_ROPE); const int gt = F.vcu * 512 + F.tid, NGT = F.G * 512;
      for (int e = gt; e < T * 32; e += NGT) { const int t = e >> 5, i = e & 31;
          const double inv = exp2(-(double)i * (13.287712379549449 / 32.0));
          const double ang = (double)((float)a.pos[t] * (float)inv);
          const double n = rint(ang * 0.6366197723675814);
          const double f = (ang - n * 1.5707963267948966) - n * 6.123233995736766e-17;
          const double f2 = f * f;
          const double sn = f * (1.0 + f2 * (-1.0 / 6 + f2 * (1.0 / 120 + f2 * (-1.0 / 5040 + f2 * (1.0 / 362880 + f2 * (-1.0 / 39916800))))));
          const double cs = 1.0 + f2 * (-0.5 + f2 * (1.0 / 24 + f2 * (-1.0 / 720 + f2 * (1.0 / 40320 + f2 * (-1.0 / 3628800 + f2 * (1.0 / 479001600))))));
          const int q = ((int)(long long)n) & 3;
          const double c_ = (q == 0) ? cs : (q == 1) ? -sn : (q == 2) ? -cs : sn;
          const double s_ = (q == 0) ? sn : (q == 1) ? cs : (q == 2) ? -sn : -cs;
          rope[(size_t)t * 64 + i] = (float)c_; rope[(size_t)t * 64 + 32 + i] = (float)s_; }
      float* lbs = (float*)(ws + WS_LBS);
      for (int e = gt; e < 2 * 1024; e += NGT) { const int dir = e >> 10, c = e & 1023; const float* lg = a.lblog + (size_t)dir * NL * 1024 + c;
          const float l0 = lg[0], l1 = lg[1024], l2 = lg[2048], l3 = lg[3072]; const float mx = fmaxf(fmaxf(l0, l1), fmaxf(l2, l3));
          const float e0 = expf(l0 - mx), e1 = expf(l1 - mx), e2 = expf(l2 - mx), e3 = expf(l3 - mx); const float inv = 1.0f / (e0 + e1 + e2 + e3);
          float* o = lbs + (size_t)dir * NL * 1024 + c; o[0] = 0.f; o[1024] = e1 * inv; o[2048] = (e1 + e2) * inv; o[3072] = (e1 + e2 + e3) * inv; }
    }
    { float* par = (float*)(ws + WS_PAR); const int gt = F.vcu * 512 + F.tid, NGT = F.G * 512;
      for (int e = gt; e < PAR_END; e += NGT) { float v;
          if (e < PAR_N2) v = a.norm1_g[e - PAR_N1]; else if (e < PAR_FG) v = a.norm2_g[e - PAR_N2]; else if (e < PAR_DLAM) v = a.final_g[e - PAR_FG]; else if (e < PAR_SUBG) v = a.dlam[e - PAR_DLAM];
          else if (e < PAR_HGN) v = a.subg[e - PAR_SUBG]; else if (e < PAR_RW) v = a.hgn[e - PAR_HGN]; else v = a.router_w[e - PAR_RW];
          par[e] = v; } }
    { bf16* RWS = (bf16*)(ws + WS_RWS); const int gt = F.vcu * 512 + F.tid, NGT = F.G * 512;
      for (int i = gt; i < NL * DM * NE; i += NGT) { const int l = i / (DM * NE), r = i % (DM * NE), dd = r >> 4, e = r & 15;
          const float wv = a.router_w[i] * a.norm2_g[l * DM + dd]; const unsigned hi_ = pk2(wv, 0.f) & 0xffffu; const float lo_f = wv - __uint_as_float(hi_ << 16);
          bf16* img = RWS + (size_t)l * (RW_IMG / 2); img[e * RW_PITCH + dd] = (bf16)hi_; img[NE * RW_PITCH + e * RW_PITCH + dd] = (bf16)(pk2(lo_f, 0.f) & 0xffffu); } }
    { bf16* X = (bf16*)(ws + WS_X); float* RS1 = (float*)(ws + WS_RS1);
      for (int m = gw; m < T; m += NGW) { float ss = 0.f;
#pragma unroll
          for (int j = 0; j < 8; ++j) { const f32x4 v = *(const GAS f32x4*)(a.x + (size_t)m * DM + j * 256 + F.lane * 4); ss += (v.x * v.x + v.y * v.y) + (v.z * v.z + v.w * v.w);
              v2u w; w.x = pk2(v.x, v.y); w.y = pk2(v.z, v.w); *(GAS v2u*)(X + (size_t)m * DM + j * 256 + F.lane * 4) = w; }
          ss = wave_sum(ss, F.lane); if (F.lane == 0) RS1[m] = rsqrtf(ss * (1.f / DM) + EPS); } }
}

__device__ __forceinline__ void router_phase(Frame& F, const bf16* X, const bf16* RWimg, float* RS2, float* AFFT) {
    typedef short bf16x8r __attribute__((ext_vector_type(8)));
    { const GAS v4u* s = (const GAS v4u*)RWimg; LAS v4u* d = (LAS v4u*)F.lds;
      for (int i = F.tid; i < RW_IMG / 16; i += 512) d[i] = s[i]; }
    __syncthreads();
    const int lane = F.lane, r16 = lane & 15, q = lane >> 4;
    const LAS unsigned char* bhi = F.lds + (r16 * RW_PITCH + 512 * q) * 2; const LAS unsigned char* blo = bhi + NE * RW_PITCH * 2;
    if (F.wave < 4) {
        for (int tile = F.vcu * 4 + F.wave; tile < T / 16; tile += F.G * 4) {
            const bf16* xr = X + (size_t)(tile * 16 + r16) * DM + 512 * q;
            f32x4 acc = (f32x4){0.f, 0.f, 0.f, 0.f}; float ss = 0.f;
#pragma unroll 8
            for (int s = 0; s < 64; ++s) { const bf16x8r a = *(const GAS bf16x8r*)(xr + 8 * s);
                const bf16x8r b0 = *(const LAS bf16x8r*)(bhi + 16 * s), b1 = *(const LAS bf16x8r*)(blo + 16 * s);
                acc = __builtin_amdgcn_mfma_f32_16x16x32_bf16(a, b0, acc, 0, 0, 0); acc = __builtin_amdgcn_mfma_f32_16x16x32_bf16(a, b1, acc, 0, 0, 0);
#pragma unroll
                for (int j = 0; j < 8; ++j) { const float v = __uint_as_float(((unsigned)(unsigned short)a[j]) << 16); ss += v * v; } }
            ss += shx(ss, 16, lane); ss += shx(ss, 32, lane);
            const float rstd = rsqrtf(ss * (1.f / DM) + EPS);
            if (q == 0) RS2[tile * 16 + r16] = rstd;
#pragma unroll
            for (int r = 0; r < 4; ++r) { const float rr = __int_as_float(shi(__float_as_int(rstd), 4 * q + r)); float lg = acc[r] * rr; float mx = lg;
#pragma unroll
                for (int o = 1; o < 16; o <<= 1) mx = fmaxf(mx, shx(mx, o, lane));
                const float ex = expf(lg - mx); float sum = ex;
#pragma unroll
                for (int o = 1; o < 16; o <<= 1) sum += shx(sum, o, lane);
                AFFT[(size_t)r16 * T + tile * 16 + 4 * q + r] = ex / sum; }
        }
    }
    __syncthreads();
}

__device__ __forceinline__ unsigned topk_total(Frame& F, LAS unsigned* cnt, int par, unsigned wave_count) {
    if (F.lane == 0) cnt[par * 8 + F.wave] = wave_count;
    __syncthreads();
    unsigned tot = 0;
#pragma unroll
    for (int w_ = 0; w_ < 8; ++w_) tot += cnt[par * 8 + w_];
    return tot;
}
__device__ __forceinline__ void topk_expert(Frame& F, int e, const float* AFFT, const float* RS2, int* IDX, float* GATE, float* RSG, int* SLOTT) {
    LAS unsigned* cnt = (LAS unsigned*)F.lds;
    const int tid = F.tid, lane = F.lane, wid = F.wave;
    unsigned key[32];
#pragma unroll
    for (int i = 0; i < 8; ++i) { const v4u k4 = *(const GAS v4u*)(AFFT + (size_t)e * T + 32 * tid + 4 * i); key[4 * i] = k4.x; key[4 * i + 1] = k4.y; key[4 * i + 2] = k4.z; key[4 * i + 3] = k4.w; }
    unsigned tkey = 0u;
#pragma unroll 1
    for (int b = 30; b >= 0; --b) {
        const unsigned cand = tkey | (1u << b); unsigned c = 0u;
#pragma unroll
        for (int i = 0; i < 32; ++i) c += (unsigned)__popcll(__ballot(key[i] >= cand));
        if (topk_total(F, cnt, b & 1, c) >= (unsigned)CAP) tkey = cand;
    }
    unsigned gmask = 0u, emask = 0u, cgw = 0u;
#pragma unroll
    for (int i = 0; i < 32; ++i) { gmask |= (key[i] > tkey ? 1u : 0u) << i; emask |= (key[i] == tkey ? 1u : 0u) << i; cgw += (unsigned)__popcll(__ballot(key[i] > tkey)); }
    const int cg = __popc(gmask), ce = __popc(emask);
    const unsigned krem = (unsigned)CAP - topk_total(F, cnt, 1, cgw);
    int ig = cg, ie = ce;
#pragma unroll
    for (int off = 1; off < 64; off <<= 1) { const int tg = shi(ig, (lane - off) & 63), te = shi(ie, (lane - off) & 63); if (lane >= off) { ig += tg; ie += te; } }
    if (lane == 63) { cnt[16 + 2 * wid] = (unsigned)ig; cnt[17 + 2 * wid] = (unsigned)ie; }
    __syncthreads();
    int og = 0, oe = 0;
    for (int w_ = 0; w_ < wid; ++w_) { og += (int)cnt[16 + 2 * w_]; oe += (int)cnt[17 + 2 * w_]; }
    const int gbefore = og + ig - cg, ebefore = oe + ie - ce;
    const float* rs2p = RS2 + 32 * tid; int* idxp = IDX + e * CAP; float* gatep = GATE + e * CAP; float* rsgp = RSG + e * CAP;
    int sl[4];
#pragma unroll
    for (int i = 0; i < 32; ++i) { const unsigned low = (1u << i) - 1u;
        const int gb = gbefore + __popc(gmask & low), eb = ebefore + __popc(emask & low);
        const bool isg = (gmask >> i) & 1u, ise = (emask >> i) & 1u;
        const bool sel = isg || (ise && eb < (int)krem);
        const int slot = gb + (eb < (int)krem ? eb : (int)krem);
        sl[i & 3] = sel ? slot : -1;
        if (sel) { idxp[slot] = 32 * tid + i; gatep[slot] = __uint_as_float(key[i]); rsgp[slot] = rs2p[i]; }
        if ((i & 3) == 3) *(GAS v4u*)(SLOTT + (size_t)e * T + 32 * tid + (i - 3)) = (v4u){(unsigned)sl[0], (unsigned)sl[1], (unsigned)sl[2], (unsigned)sl[3]}; }
    __syncthreads();
}

__device__ __forceinline__ void combine_phase(Frame& F, bf16* X, const bf16* Y, const int* SLOT, float* RS1, const float* gfin, float* OUT) {
    const int gw = F.vcu * NWAVES + F.wave, NGW = F.G * NWAVES;
    v4u xn[4]; int slotn = -1;
    if (gw < T) {
#pragma unroll
        for (int j = 0; j < 4; ++j) xn[j] = *(const GAS v4u*)(X + (size_t)gw * DM + j * 512 + F.lane * 8);
        slotn = (F.lane < NE) ? SLOT[(size_t)F.lane * T + gw] : -1; }
    for (int row = gw; row < T; row += NGW) {
        float x[4][8];
#pragma unroll
        for (int j = 0; j < 4; ++j) { x[j][0] = __uint_as_float(xn[j].x << 16); x[j][1] = __uint_as_float(xn[j].x & 0xffff0000u); x[j][2] = __uint_as_float(xn[j].y << 16); x[j][3] = __uint_as_float(xn[j].y & 0xffff0000u);
            x[j][4] = __uint_as_float(xn[j].z << 16); x[j][5] = __uint_as_float(xn[j].z & 0xffff0000u); x[j][6] = __uint_as_float(xn[j].w << 16); x[j][7] = __uint_as_float(xn[j].w & 0xffff0000u); }
        const int myslot = slotn;
        if (row + NGW < T) {
#pragma unroll
            for (int j = 0; j < 4; ++j) xn[j] = *(const GAS v4u*)(X + (size_t)(row + NGW) * DM + j * 512 + F.lane * 8);
            slotn = (F.lane < NE) ? SLOT[(size_t)F.lane * T + row + NGW] : -1; }
#pragma unroll 1
        for (int e = 0; e < NE; ++e) { const int s = shi(myslot, e);
            if (s >= 0) { const bf16* yr = Y + ((size_t)e * CAP + s) * DM;
#pragma unroll
                for (int j = 0; j < 4; ++j) { const v4u w = *(const GAS v4u*)(yr + j * 512 + F.lane * 8);
                    x[j][0] += __uint_as_float(w.x << 16); x[j][1] += __uint_as_float(w.x & 0xffff0000u); x[j][2] += __uint_as_float(w.y << 16); x[j][3] += __uint_as_float(w.y & 0xffff0000u);
                    x[j][4] += __uint_as_float(w.z << 16); x[j][5] += __uint_as_float(w.z & 0xffff0000u); x[j][6] += __uint_as_float(w.w << 16); x[j][7] += __uint_as_float(w.w & 0xffff0000u); } } }
        float ss = 0.f;
#pragma unroll
        for (int j = 0; j < 4; ++j)
#pragma unroll
            for (int k = 0; k < 8; ++k) ss += x[j][k] * x[j][k];
        const float rstd = rsqrtf(wave_sum(ss, F.lane) * (1.f / DM) + EPS);
        if (OUT) {
#pragma unroll
            for (int j = 0; j < 4; ++j) { const f32x4 g0 = *(const f32x4*)(gfin + j * 512 + F.lane * 8), g1 = *(const f32x4*)(gfin + j * 512 + F.lane * 8 + 4);
                *(GAS f32x4*)(OUT + (size_t)row * DM + j * 512 + F.lane * 8) = (f32x4){x[j][0] * rstd * g0.x, x[j][1] * rstd * g0.y, x[j][2] * rstd * g0.z, x[j][3] * rstd * g0.w};
                *(GAS f32x4*)(OUT + (size_t)row * DM + j * 512 + F.lane * 8 + 4) = (f32x4){x[j][4] * rstd * g1.x, x[j][5] * rstd * g1.y, x[j][6] * rstd * g1.z, x[j][7] * rstd * g1.w}; }
        } else {
#pragma unroll
            for (int j = 0; j < 4; ++j) { v4u w; w.x = pk2(x[j][0], x[j][1]); w.y = pk2(x[j][2], x[j][3]); w.z = pk2(x[j][4], x[j][5]); w.w = pk2(x[j][6], x[j][7]); *(GAS v4u*)(X + (size_t)row * DM + j * 512 + F.lane * 8) = w; }
            if (F.lane == 0) RS1[row] = rstd; }
    }
}

__device__ __forceinline__ void vt_transpose(Frame& F, const bf16* V, bf16* VT) {
    LAS bf16* tile = (LAS bf16*)(F.lds + F.wave * 9216);
    const int gw = F.vcu * NWAVES + F.wave, NGW = F.G * NWAVES, lane = F.lane;
    for (int it = gw; it < (T / 64) * 16; it += NGW) { const int t0 = (it >> 4) * 64, c0 = (it & 15) * 64;
#pragma unroll
        for (int i = 0; i < 8; ++i) { const int r = (lane >> 3) + 8 * i; *(LAS v4u*)(tile + r * 72 + (lane & 7) * 8) = *(const GAS v4u*)(V + (size_t)(t0 + r) * 1024 + c0 + (lane & 7) * 8); }
        LDS_WAIT(); asm volatile("" ::: "memory");
        const int g = lane & 7;
#pragma unroll
        for (int i = 0; i < 8; ++i) { const int col = (lane >> 3) + 8 * i; const LAS bf16* s = tile + (8 * g) * 72 + col;
            const LAS bf16* s2 = tile + (16 * (g >> 1) + 4 * (g & 1)) * 72 + col;
            v4u o; o.x = (unsigned)s2[0] | ((unsigned)s2[72] << 16); o.y = (unsigned)s2[144] | ((unsigned)s2[216] << 16); o.z = (unsigned)s2[8 * 72] | ((unsigned)s2[9 * 72] << 16); o.w = (unsigned)s2[10 * 72] | ((unsigned)s2[11 * 72] << 16);
            *(GAS v4u*)(VT + (size_t)(c0 + col) * T + t0 + 8 * g) = o; }
        LDS_WAIT(); asm volatile("" ::: "memory");
    }
}

constexpr int PH_PER_LAYER = 11, N_PHASES = 1 + NL * PH_PER_LAYER;
#ifndef PHMASK
#define PHMASK 0xFFFF
#endif
#define PM(b) ((PHMASK >> (b)) & 1)
#ifndef PROBE_NOSTORE
#define PROBE_NOSTORE 0
#endif
#ifndef REPMASK
#define REPMASK 0
#endif
#ifndef STG_IN
#define STG_IN 4
#endif
#ifndef STG_OUT
#define STG_OUT 0
#endif
#ifndef STG_GU
#define STG_GU 0
#endif
#ifndef STG_DN
#define STG_DN 0
#endif
#define GEMM_STAGGER(n) do { if (F.vcu & 1) { for (int i_ = 0; i_ < (n); ++i_) __builtin_amdgcn_s_sleep(32); } } while (0)
#define NREP(b) (((REPMASK >> (b)) & 1) ? 2 : 1)
#define PHASE_BEGIN() int wv_ = wave_s; asm volatile("" : "+s"(wv_)); int tid_ = wv_ * 64 + (int)xb_lane(); asm volatile("" : "+v"(tid_)); unsigned char* w = args.ws; asm volatile("" : "+s"(w)); \
    int bx_ = blockIdx.x, gx_ = gridDim.x; asm volatile("" : "+s"(bx_), "+s"(gx_)); \
    Frame F; F.lds = lds0; F.MISC = (volatile LAS unsigned*)(lds0 + MISC_OFF); F.tid = tid_; F.lane = tid_ & 63; F.wave = wv_; F.G = gx_; \
    F.vcu = (gx_ % 8 == 0) ? (bx_ % 8) * (gx_ / 8) + bx_ / 8 : bx_
__global__ void __launch_bounds__(NWAVES * 64, 2) mega_fwd(Args args) {
    extern __shared__ __attribute__((aligned(16))) unsigned char lds_raw[];
    LAS unsigned char* const lds0 = (LAS unsigned char*)lds_raw;
    const int wave_s = __builtin_amdgcn_readfirstlane((int)threadIdx.x >> 6);
    if (wave_s < 2) ((LAS unsigned*)(lds0 + MISC_OFF))[wave_s * 64 + (int)xb_lane()] = 0u;
    __syncthreads();
    XcdBarrier bar; bar.bar = (unsigned*)(args.ws + WS_CTL) + CW_BAR; bar.x = 0; bar.st = nullptr; bar.wv = wave_s;
    if (!MK_PER_PHASE) bar = xcd_barrier_post((unsigned*)(args.ws + WS_CTL) + CW_BAR, (volatile LAS unsigned*)(lds0 + MISC_OFF) + 8, wave_s);
    const int lo = args.ph_lo, hi = args.ph_hi;
#define IN(k) (lo <= (k) && (k) < hi)
#define SEAM(k) do { if (IN(k) && IN((k) + 1)) xcd_barrier(bar); } while (0)

    for (int rep_ = 0; rep_ < NREP(0); ++rep_) if (PM(0) && IN(0)) { if (rep_) xcd_barrier(bar); PHASE_BEGIN(); p0_prologue(F, args, w); }
    SEAM(0);

#pragma unroll 1
    for (int l = 0; l < NL; ++l) {
        const int pb = 1 + l * PH_PER_LAYER;
        for (int rep_ = 0; rep_ < NREP(1); ++rep_) if (PM(1) && IN(pb + 0)) { if (rep_) xcd_barrier(bar); PHASE_BEGIN();
            pg8::Gemm g{(bf16*)(w + WS_X), (bf16*)(w + WS_WIN) + (size_t)l * INC * DM, T, INC, DM, 31, 0, nullptr}; pg8::StaticOrder S; S.init(T, INC, F.G, bx_);
            pg8::EpiInProj E{(bf16*)(w + WS_Q), (bf16*)(w + WS_K), (bf16*)(w + WS_V), (bf16*)(w + WS_HQ), (bf16*)(w + WS_KK), (bf16*)(w + WS_HV), (bf16*)(w + WS_HG), (unsigned short*)(w + WS_LF),
                              (const float*)(w + WS_ROPE), (const float*)(w + WS_LBS) + l * 1024, QSCALE, (unsigned*)(w + WS_CTL) + CW_KMAX + l * 16, (PROBE_NOSTORE && rep_) ? 1 : 0, (const float*)(w + WS_RS1)};
            GEMM_STAGGER(STG_IN);
            pg8::gemm_phase<pg8::EpiInProj, pg8::StaticOrder, true, true>(F.lds, g, S, E, F.tid);
        }
        SEAM(pb + 0);
        for (int rep_ = 0; rep_ < NREP(2); ++rep_) if (PM(2) && IN(pb + 1)) { if (rep_) xcd_barrier(bar); PHASE_BEGIN();
            const hg::HgArgs HA{(bf16*)(w + WS_HQ), (bf16*)(w + WS_KK), (unsigned short*)(w + WS_LF), (bf16*)(w + WS_HV), (bf16*)(w + WS_HG), (float*)(w + WS_HS), (float*)(w + WS_GS), (float*)(w + WS_HOF), (bf16*)(w + WS_MIX), (const float*)(w + WS_PAR) + PAR_HGN + l * 128};
            for (int n = F.vcu; n < 512; n += F.G) hg::hgrn_unit<false>(HA, n >> 8, (n >> 5) & 7, n & 31, F.lds, F.tid);
            __syncthreads(); vt_transpose(F, (const bf16*)(w + WS_V), (bf16*)(w + WS_VT));
        }
        SEAM(pb + 1);
        if (PM(4) && IN(pb + 3)) {
            { PHASE_BEGIN(); hg::hgrn_scan((float*)(w + WS_HS), (const float*)(w + WS_GS), F.vcu * 512 + F.tid, F.G * 512);
              asm volatile("s_waitcnt vmcnt(0)" ::: "memory"); __syncthreads();
              if (wv_ == 0 && F.lane == 0) { __builtin_amdgcn_fence(__ATOMIC_RELEASE, "agent"); asm volatile("s_waitcnt vmcnt(0)" ::: "memory");
                  (void)xb_add((unsigned*)(w + WS_CTL) + CW_SCAN + l, 1u); } }
            for (int rep_ = 0; rep_ < NREP(13); ++rep_) if (PM(13)) { if (rep_) xcd_barrier(bar); PHASE_BEGIN();
                const float lam_init = 0.8f - 0.6f * expf(-0.3f * (float)l);
                const float* lv = (const float*)(w + WS_PAR) + PAR_DLAM + l * 256;
                const float s1 = wave_sum(lv[F.lane] * lv[64 + F.lane], F.lane), s2 = wave_sum(lv[128 + F.lane] * lv[192 + F.lane], F.lane);
                const float lam = expf(s1) - expf(s2) + lam_init;
                const att::AttnArgs AA{(bf16*)(w + WS_Q), (bf16*)(w + WS_K), (bf16*)(w + WS_V), (bf16*)(w + WS_VT), (float*)(w + WS_AO1), (bf16*)(w + WS_MIX), (const float*)(w + WS_PAR) + PAR_SUBG + l * 128, (const float*)(w + WS_CTL) + CW_KMAX + l * 16, lam, 1.0f - lam_init};
                #ifdef ATT_OLD_BODY
                for (int n = F.vcu; n < 512; n += F.G) att::attn_unit<0>(AA, (n & 255) >> 5, (n & 31) + 32 * (n >> 8), (AT_LAS char*)F.lds, F.tid);
#else
                { int slot_ = 0; const int cpos = (CVT_HOST && rep_ == 0) ? (int)((unsigned)F.vcu % 6u) : -1; const int ccnt = l < NL - 1 ? PER_LAYER : PER_LAYER - I_IN;
                  for (int n = F.vcu; n < 512; n += F.G, ++slot_) {
                    if (cpos == 2 * slot_) p0_convert<false>(F, args, w, l, I_IN, ccnt);
                    att::attn_unit2<0>(AA, (n & 255) >> 5, (n & 31) + 32 * (n >> 8), (AT_LAS char*)F.lds, F.tid, [&]() { if (cpos == 2 * slot_ + 1) p0_convert<false>(F, args, w, l, I_IN, ccnt); }); } }
#endif
                __syncthreads();
            }
#ifdef HG_PROBE
            { xcd_barrier(bar); PHASE_BEGIN();
                const hg::HgArgs HA{(bf16*)(w + WS_HQ), (bf16*)(w + WS_KK), (unsigned short*)(w + WS_LF), (bf16*)(w + WS_HV), (bf16*)(w + WS_HG), (float*)(w + WS_HS), (float*)(w + WS_GS), (float*)(w + WS_END), (bf16*)(w + WS_END + 64 * MiB), (const float*)(w + WS_PAR) + PAR_HGN + l * 128};
                for (int n = F.vcu; n < 256; n += F.G) { const int h = n >> 5, sc = n & 31;
                    hg::hgrn_unit<true, HG_PROBE>(HA, 0, h, sc, F.lds, F.tid);
                    __threadfence_block(); __syncthreads();
                    hg::hgrn_unit<true, HG_PROBE>(HA, 1, h, sc, F.lds, F.tid); }
            }
#endif
#ifdef ATT_PROBE
            { xcd_barrier(bar); PHASE_BEGIN();
                const att::AttnArgs AA{(bf16*)(w + WS_Q), (bf16*)(w + WS_K), (bf16*)(w + WS_V), (bf16*)(w + WS_VT), (float*)(w + WS_END), (bf16*)(w + WS_END + 64 * MiB), (const float*)(w + WS_PAR) + PAR_SUBG + l * 128, (const float*)(w + WS_CTL) + CW_KMAX + l * 16, 0.5f, 0.5f};
                for (int n = F.vcu; n < 512; n += F.G) att::attn_unit2<ATT_PROBE>(AA, (n & 255) >> 5, (n & 31) + 32 * (n >> 8), (AT_LAS char*)F.lds, F.tid);
                __syncthreads();
            }
#endif
            for (int rep_ = 0; rep_ < NREP(12); ++rep_) if (PM(12)) { if (rep_) xcd_barrier(bar); PHASE_BEGIN();
                if (wv_ == 0 && F.lane == 0) { unsigned* sc_ = (unsigned*)(w + WS_CTL) + CW_SCAN + l; XB_SPIN(xb_ld(sc_) < (unsigned)F.G, (unsigned*)(w + WS_CTL) + CW_BAR);
                    __builtin_amdgcn_fence(__ATOMIC_ACQUIRE, "agent"); asm volatile("s_waitcnt vmcnt(0)" ::: "memory"); }
                __syncthreads();
                const int cpos = (CVT_HOST && rep_ == 0) ? (int)((unsigned)F.vcu % 6u) : -1; const int ccnt = l < NL - 1 ? PER_LAYER : PER_LAYER - I_IN;
                if (cpos == 4) { p0_convert<false>(F, args, w, l, I_IN, ccnt); __syncthreads(); }
                const hg::HgArgs HA{(bf16*)(w + WS_HQ), (bf16*)(w + WS_KK), (unsigned short*)(w + WS_LF), (bf16*)(w + WS_HV), (bf16*)(w + WS_HG), (float*)(w + WS_HS), (float*)(w + WS_GS), (float*)(w + WS_HOF), (bf16*)(w + WS_MIX), (const float*)(w + WS_PAR) + PAR_HGN + l * 128};
                for (int n = F.vcu; n < 256; n += F.G) { const int h = n >> 5, sc = n & 31;
                    hg::hgrn_unit<true>(HA, 0, h, sc, F.lds, F.tid);
                    __threadfence_block(); __syncthreads();
                    hg::hgrn_unit<true>(HA, 1, h, sc, F.lds, F.tid); }
                if (cpos == 5) { __syncthreads(); p0_convert<false>(F, args, w, l, I_IN, ccnt); }
            }
        }
        SEAM(pb + 3);
        for (int rep_ = 0; rep_ < NREP(5); ++rep_) if (PM(5) && IN(pb + 4)) { if (rep_) xcd_barrier(bar); PHASE_BEGIN();
            pg8::Gemm g{(bf16*)(w + WS_MIX), (bf16*)(w + WS_WOUT) + (size_t)l * DM * DM, T, DM, DM, 31, 0, nullptr}; pg8::StaticOrder S; S.init(T, DM, F.G, bx_);
            GEMM_STAGGER(STG_OUT);
            if (l == 0) { pg8::EpiResidBf<true> E{args.x, (bf16*)(w + WS_X)}; pg8::gemm_phase<pg8::EpiResidBf<true>, pg8::StaticOrder, true, true>(F.lds, g, S, E, F.tid); }
            else { pg8::EpiResidBf<false> E{nullptr, (bf16*)(w + WS_X)}; pg8::gemm_phase<pg8::EpiResidBf<false>, pg8::StaticOrder, true, true>(F.lds, g, S, E, F.tid); }
        }
        SEAM(pb + 4);
        for (int rep_ = 0; rep_ < NREP(6); ++rep_) if (PM(6) && IN(pb + 5)) { if (rep_) xcd_barrier(bar); PHASE_BEGIN(); router_phase(F, (const bf16*)(w + WS_X), (const bf16*)(w + WS_RWS + (size_t)l * RW_IMG), (float*)(w + WS_RS2), (float*)(w + WS_AFF)); }
        SEAM(pb + 5);
        for (int rep_ = 0; rep_ < NREP(7); ++rep_) if (PM(7) && IN(pb + 6)) { if (rep_) xcd_barrier(bar); PHASE_BEGIN(); for (int e = bx_; e < NE; e += F.G) topk_expert(F, e, (const float*)(w + WS_AFF), (const float*)(w + WS_RS2), (int*)(w + WS_IDX), (float*)(w + WS_GATE), (float*)(w + WS_RSG), (int*)(w + WS_SLOT)); }
        SEAM(pb + 6);
        for (int rep_ = 0; rep_ < NREP(9); ++rep_) if (PM(9) && IN(pb + 8)) { if (rep_) xcd_barrier(bar); PHASE_BEGIN();
            pg8::Gemm g{(bf16*)(w + WS_X), (bf16*)(w + WS_WGU) + (size_t)l * NE * 2048 * DM, XR, 2048, DM, 3, (size_t)2048 * DM * 2, (const int*)(w + WS_IDX)}; pg8::StaticOrder S; S.init(XR, 2048, F.G, bx_);
            GEMM_STAGGER(STG_GU);
            pg8::EpiSwiGLU E{(bf16*)(w + WS_HM), (const float*)(w + WS_RSG)};
            pg8::gemm_phase<pg8::EpiSwiGLU, pg8::StaticOrder, true, true, true>(F.lds, g, S, E, F.tid);
        }
        SEAM(pb + 8);
        for (int rep_ = 0; rep_ < NREP(10); ++rep_) if (PM(10) && IN(pb + 9)) { if (rep_) xcd_barrier(bar); PHASE_BEGIN();
            pg8::Gemm g{(bf16*)(w + WS_HM), (bf16*)(w + WS_WDN) + (size_t)l * NE * DM * FF, XR, DM, FF, 3, (size_t)DM * FF * 2, nullptr}; pg8::StaticOrder S; S.init(XR, DM, F.G, bx_);
            GEMM_STAGGER(STG_DN);
            pg8::EpiDown E{(bf16*)(w + WS_Y), (const float*)(w + WS_GATE)};
            pg8::gemm_phase<pg8::EpiDown, pg8::StaticOrder, true, true>(F.lds, g, S, E, F.tid);
        }
        SEAM(pb + 9);
        for (int rep_ = 0; rep_ < NREP(11); ++rep_) if (PM(11) && IN(pb + 10)) { if (rep_) xcd_barrier(bar); PHASE_BEGIN();
            if (l < NL - 1) combine_phase(F, (bf16*)(w + WS_X), (const bf16*)(w + WS_Y), (const int*)(w + WS_SLOT), (float*)(w + WS_RS1), nullptr, nullptr);
            else combine_phase(F, (bf16*)(w + WS_X), (const bf16*)(w + WS_Y), (const int*)(w + WS_SLOT), nullptr, (const float*)(w + WS_PAR) + PAR_FG, args.out);
        }
        SEAM(pb + 10);
    }
#undef IN
#undef SEAM
}

extern "C" void kernel_launch(void* const* d_in, const int* in_sizes, int n_in, void* d_out, int out_size, void* d_ws, size_t ws_size, hipStream_t stream) {
    static int grid = 0;
    if (grid == 0) {
        if (n_in != 15 || in_sizes[0] != T * DM || out_size != T * DM || ws_size < WS_END) { fprintf(stderr, "kernel_launch: shape/workspace mismatch (n_in %d, ws %zu < %zu)\n", n_in, ws_size, (size_t)WS_END); grid = -1; return; }
        int dev = 0, cus = 0, per_cu = 0;
        if (hipGetDevice(&dev) != hipSuccess || hipDeviceGetAttribute(&cus, hipDeviceAttributeMultiprocessorCount, dev) != hipSuccess) { grid = -1; return; }
        if (hipFuncSetAttribute((const void*)mega_fwd, hipFuncAttributeMaxDynamicSharedMemorySize, LDS_BYTES) != hipSuccess) { fprintf(stderr, "kernel_launch: hipFuncSetAttribute failed\n"); grid = -1; return; }
        if (hipOccupancyMaxActiveBlocksPerMultiprocessor(&per_cu, (const void*)mega_fwd, NWAVES * 64, LDS_BYTES) != hipSuccess || per_cu < 1) fprintf(stderr, "kernel_launch: occupancy query reports %d\n", per_cu);
        (void)hipGetLastError();
        grid = cus;
    }
    if (grid < 0) return;
    if (hipMemsetAsync((char*)d_ws + WS_CTL, 0, CTL_ZERO_BYTES, stream) != hipSuccess) return;
    Args a{};
    a.x = (const float*)d_in[0]; a.pos = (const int*)d_in[1]; a.norm1_g = (const float*)d_in[2]; a.w_in = (const float*)d_in[3]; a.dlam = (const float*)d_in[4]; a.subg = (const float*)d_in[5];
    a.lblog = (const float*)d_in[6]; a.hgn = (const float*)d_in[7]; a.w_out = (const float*)d_in[8]; a.norm2_g = (const float*)d_in[9]; a.router_w = (const float*)d_in[10];
    a.w_gate = (const float*)d_in[11]; a.w_up = (const float*)d_in[12]; a.w_down = (const float*)d_in[13]; a.final_g = (const float*)d_in[14];
    a.out = (float*)d_out; a.ws = (unsigned char*)d_ws;
#if MK_PER_PHASE
    for (int p = 0; p < N_PHASES; ++p) { a.ph_lo = p; a.ph_hi = p + 1; hipLaunchKernelGGL(mega_fwd, dim3(grid), dim3(NWAVES * 64), LDS_BYTES, stream, a); }
#else
    a.ph_lo = 0; a.ph_hi = N_PHASES; hipLaunchKernelGGL(mega_fwd, dim3(grid), dim3(NWAVES * 64), LDS_BYTES, stream, a);
#endif
    const hipError_t le = hipPeekAtLastError();
    if (le != hipSuccess) fprintf(stderr, "kernel_launch: launch failed: %s\n", hipGetErrorName(le));
}
```
